# Optimizing an MI355X kernel written in HIP

```python
import jax
import jax.numpy as jnp
from jax import lax
import numpy as np

D_MODEL = 1024
BATCH = 8
SEQ = 2048
DEPTH = 2

GRID_W = 64
CTX_LEN = 256
EPS = 1e-6
N_MOD = 6

SSD_HEADS = 16
SSD_HEAD_DIM = 64
SSD_INNER = SSD_HEADS * SSD_HEAD_DIM
SSD_GROUPS = 4
SSD_STATE = 128
SSD_CONV = 5
SSD_CHUNK = 128
SSD_BC = SSD_GROUPS * SSD_STATE
SSD_CONV_DIM = SSD_INNER + 2 * SSD_BC
SSD_STATE_COLS = SSD_CONV_DIM + 2 * SSD_HEADS

CF_CH = 1024
CF_KERNEL = 31

AB_IN = SSD_INNER + SSD_STATE_COLS + 2 * CF_CH
AB_OUT = SSD_INNER + CF_CH

HG_HEADS = 8
HG_DK = 128
HG_DV = D_MODEL // HG_HEADS
HG_KEY = HG_HEADS * HG_DK
HG_VAL = HG_HEADS * HG_DV
HG_CHUNK = 64
HG_IN = HG_KEY + 2 * HG_VAL + 2 * HG_KEY

N_EXPERTS = 16
N_EXPERT_GROUPS = 4
EXPERTS_PER_GROUP = N_EXPERTS // N_EXPERT_GROUPS
TOP_K = 2
D_EXPERT = 512

N_EVEN = (DEPTH + 1) // 2
N_ODD = DEPTH // 2

kernel_name = "hybrid_ssd_conformer_hgrn2_moe_dit"


def rmsnorm(x, g):
    xf = x.astype(jnp.float32)
    y = xf * lax.rsqrt(jnp.mean(xf * xf, axis=-1, keepdims=True) + EPS)
    return (y * g.astype(jnp.float32)).astype(x.dtype)


def layernorm(x, g, b):
    xf = x.astype(jnp.float32)
    mu = jnp.mean(xf, axis=-1, keepdims=True)
    xc = xf - mu
    var = jnp.mean(xc * xc, axis=-1, keepdims=True)
    return (xc * lax.rsqrt(var + EPS) * g.astype(jnp.float32) + b.astype(jnp.float32)).astype(x.dtype)


def modulation(cond, w, b):
    m = jax.nn.silu(cond) @ w + b
    return m.reshape(cond.shape[:-1] + (N_MOD, D_MODEL))


def dwconv(x, w, b):
    k = w.shape[0]
    y = lax.conv_general_dilated(x, w[:, None, :].astype(x.dtype), window_strides=(1,),
                                 padding=[(k // 2, k // 2)], dimension_numbers=("NWC", "WIO", "NWC"),
                                 feature_group_count=x.shape[-1])
    return y + b.astype(y.dtype)


def _flip(t):
    return jnp.flip(t, axis=1)


def _same(t):
    return t


def to_col_major(t, rows):
    b, _, ch = t.shape
    return t.reshape(b, rows, GRID_W, ch).transpose(0, 2, 1, 3).reshape(b, rows * GRID_W, ch)


def from_col_major(t, rows):
    b, _, ch = t.shape
    return t.reshape(b, GRID_W, rows, ch).transpose(0, 2, 1, 3).reshape(b, rows * GRID_W, ch)


def _carry_step(s, inp):
    dec, st = inp
    return dec * s + st, s


def ssd_scan(xs, dt, a_neg, bm, cm, s0, with_output):
    bsz, seqlen, nh, hp = xs.shape
    ng, ns = bm.shape[2], bm.shape[3]
    rep = nh // ng
    nc = seqlen // SSD_CHUNK
    la = (dt * a_neg).reshape(bsz, nc, SSD_CHUNK, ng, rep)
    acum = jnp.cumsum(la, axis=2)
    xdt = (xs.astype(jnp.float32) * dt[..., None]).reshape(bsz, nc, SSD_CHUNK, ng, rep, hp)
    bc = bm.astype(jnp.float32).reshape(bsz, nc, SSD_CHUNK, ng, ns)
    to_end = jnp.exp(acum[:, :, -1:] - acum)
    chunk_states = jnp.einsum("bcsgn,bcsgr,bcsgrp->bcgrpn", bc, to_end, xdt).reshape(bsz, nc, nh, hp, ns)
    chunk_decay = jnp.exp(acum[:, :, -1]).reshape(bsz, nc, nh)[..., None, None]
    s_final, s_in = lax.scan(_carry_step, s0, (jnp.moveaxis(chunk_decay, 1, 0), jnp.moveaxis(chunk_states, 1, 0)))
    if not with_output:
        return None, s_final
    s_in = jnp.moveaxis(s_in, 0, 1).reshape(bsz, nc, ng, rep, hp, ns)
    cc = cm.astype(jnp.float32).reshape(bsz, nc, SSD_CHUNK, ng, ns)
    causal = jnp.tril(jnp.ones((SSD_CHUNK, SSD_CHUNK), dtype=bool))[:, :, None, None]
    seg = acum[:, :, :, None] - acum[:, :, None, :]
    decay = jnp.exp(jnp.where(causal, seg, -jnp.inf))
    cb = jnp.einsum("bclgn,bcsgn->bclsg", cc, bc)
    y_diag = jnp.einsum("bclsg,bclsgr,bcsgrp->bclgrp", cb, decay, xdt)
    y_off = jnp.einsum("bclgn,bcgrpn,bclgr->bclgrp", cc, s_in, jnp.exp(acum))
    return (y_diag + y_off).reshape(bsz, seqlen, nh, hp), s_final


def ssd_inputs(p_state, conv_w, conv_b, dt_bias):
    b, n, _ = p_state.shape
    xbc = jax.nn.silu(dwconv(p_state[..., :SSD_CONV_DIM], conv_w, conv_b))
    xs = xbc[..., :SSD_INNER].reshape(b, n, SSD_HEADS, SSD_HEAD_DIM)
    bm = xbc[..., SSD_INNER:SSD_INNER + SSD_BC].reshape(b, n, SSD_GROUPS, SSD_STATE)
    cm = xbc[..., SSD_INNER + SSD_BC:].reshape(b, n, SSD_GROUPS, SSD_STATE)
    dt_raw = p_state[..., SSD_CONV_DIM:].astype(jnp.float32).reshape(b, n, 2, SSD_HEADS)
    dt = jax.nn.softplus(dt_raw + dt_bias.astype(jnp.float32))
    return xs, bm, cm, dt


def ssd_readout(y, xs, z, d_skip, norm_g):
    b, n = y.shape[0], y.shape[1]
    y = y + d_skip.astype(jnp.float32)[:, None] * xs.astype(jnp.float32)
    y = y.reshape(b, n, SSD_INNER) * jax.nn.silu(z.astype(jnp.float32))
    return rmsnorm(y, norm_g)


def conformer_conv(v, gate, dw_w, dw_b, ln_g, ln_b, rows):
    u = v * jax.nn.sigmoid(gate)
    b, n, ch = u.shape
    if rows is not None:
        u = u.reshape(b * rows, GRID_W, ch)
    u = dwconv(u, dw_w, dw_b).reshape(b, n, ch)
    return jax.nn.silu(layernorm(u, ln_g, ln_b))


def even_mixer(hc, hl, w_in, conv_w, conv_b, dt_bias, a_log, d_skip, ssd_g,
               cf_w, cf_b, cf_lng, cf_lnb, w_out, rows, need_ctx):
    a_neg = -jnp.exp(a_log.astype(jnp.float32))
    s_lo, s_hi = SSD_INNER, SSD_INNER + SSD_STATE_COLS
    pl = hl @ w_in
    if need_ctx:
        pc = hc @ w_in
        pc_state = pc[..., s_lo:s_hi]
    else:
        pc_state = hc @ w_in[:, s_lo:s_hi]
    xs_l, b_l, c_l, dt_l = ssd_inputs(pl[..., s_lo:s_hi], conv_w, conv_b, dt_bias)
    xs_c, b_c, c_c, dt_c = ssd_inputs(pc_state, conv_w, conv_b, dt_bias)
    bsz = hl.shape[0]
    ys_c, ys_l = [], []
    for d in range(2):
        flip = _flip if d else _same
        s0 = jnp.zeros((bsz, SSD_HEADS, SSD_HEAD_DIM, SSD_STATE), jnp.float32)
        y_c, s_ctx = ssd_scan(flip(xs_c), flip(dt_c[:, :, d]), a_neg[d], flip(b_c), flip(c_c), s0, need_ctx)
        y_l, _ = ssd_scan(flip(xs_l), flip(dt_l[:, :, d]), a_neg[d], flip(b_l), flip(c_l), s_ctx, True)
        ys_l.append(flip(y_l))
        if need_ctx:
            ys_c.append(flip(y_c))
    cf0 = SSD_INNER + SSD_STATE_COLS
    o_ssd = ssd_readout(ys_l[0] + ys_l[1], xs_l, pl[..., :SSD_INNER], d_skip, ssd_g)
    o_cf = conformer_conv(pl[..., cf0:cf0 + CF_CH], pl[..., cf0 + CF_CH:], cf_w, cf_b, cf_lng, cf_lnb, rows)
    y_lat = (jnp.concatenate([o_ssd, o_cf.astype(o_ssd.dtype)], axis=-1) @ w_out).astype(hl.dtype)
    y_ctx = None
    if need_ctx:
        oc_ssd = ssd_readout(ys_c[0] + ys_c[1], xs_c, pc[..., :SSD_INNER], d_skip, ssd_g)
        oc_cf = conformer_conv(pc[..., cf0:cf0 + CF_CH], pc[..., cf0 + CF_CH:], cf_w, cf_b, cf_lng, cf_lnb, None)
        y_ctx = (jnp.concatenate([oc_ssd, oc_cf.astype(oc_ssd.dtype)], axis=-1) @ w_out).astype(hc.dtype)
    return y_ctx, y_lat


def hgrn2_scan(q, k, v, logf, s0, with_output):
    bsz, seqlen, nh, dk = k.shape
    dv = v.shape[-1]
    nc = seqlen // HG_CHUNK

    def chunks(t):
        return t.astype(jnp.float32).reshape(bsz, nc, HG_CHUNK, nh, t.shape[-1])

    kc, vc = chunks(k), chunks(v)
    gcum = jnp.cumsum(chunks(logf), axis=2)
    g_end = gcum[:, :, -1]
    k_end = kc * jnp.exp(g_end[:, :, None] - gcum)
    chunk_states = jnp.einsum("bcshk,bcshv->bchkv", k_end, vc)
    s_final, s_in = lax.scan(_carry_step, s0, (jnp.moveaxis(jnp.exp(g_end)[..., None], 1, 0),
                                               jnp.moveaxis(chunk_states, 1, 0)))
    if not with_output:
        return None, s_final
    s_in = jnp.moveaxis(s_in, 0, 1)
    qc = chunks(q)
    g_mid = gcum[:, :, HG_CHUNK // 2 - 1:HG_CHUNK // 2]
    q_rel = qc * jnp.exp(gcum - g_mid)
    k_rel = kc * jnp.exp(g_mid - gcum)
    causal = jnp.tril(jnp.ones((HG_CHUNK, HG_CHUNK), dtype=bool))
    att = jnp.where(causal, jnp.einsum("bclhk,bcshk->bchls", q_rel, k_rel), 0.0)
    o_intra = jnp.einsum("bchls,bcshv->bclhv", att, vc)
    o_inter = jnp.einsum("bclhk,bchkv->bclhv", qc * jnp.exp(gcum), s_in)
    return (o_intra + o_inter).reshape(bsz, seqlen, nh, dv), s_final


def hgrn2_gates(p_state, lb):
    b, n, _ = p_state.shape
    v = p_state[..., :HG_VAL].reshape(b, n, HG_HEADS, HG_DV)
    f_raw = p_state[..., HG_VAL:].astype(jnp.float32).reshape(b, n, 2, HG_HEADS, HG_DK)
    lbh = lb.reshape(HG_HEADS, HG_DK)
    f = lbh + (1.0 - lbh) * jax.nn.sigmoid(f_raw)
    return v, 1.0 - f, jnp.log(f)


def hgrn2_readout(o, g, norm_g):
    b, n = o.shape[0], o.shape[1]
    return rmsnorm(o, norm_g).reshape(b, n, HG_VAL) * jax.nn.silu(g.astype(jnp.float32))


def odd_mixer(hc, hl, w_in, lb, norm_g, w_out, rows, need_ctx):
    st0 = HG_KEY + HG_VAL
    bsz, n_lat = hl.shape[0], hl.shape[1]
    pl = to_col_major(hl, rows) @ w_in
    q_l = jax.nn.silu(pl[..., :HG_KEY]).reshape(bsz, n_lat, HG_HEADS, HG_DK)
    v_l, k_l, lf_l = hgrn2_gates(pl[..., st0:], lb)
    if need_ctx:
        pc = hc @ w_in
        q_c = jax.nn.silu(pc[..., :HG_KEY]).reshape(bsz, hc.shape[1], HG_HEADS, HG_DK)
        pc_state = pc[..., st0:]
    else:
        pc_state = hc @ w_in[:, st0:]
    v_c, k_c, lf_c = hgrn2_gates(pc_state, lb)
    os_c, os_l = [], []
    for d in range(2):
        flip = _flip if d else _same
        s0 = jnp.zeros((bsz, HG_HEADS, HG_DK, HG_DV), jnp.float32)
        qc_d = flip(q_c) if need_ctx else None
        o_c, s_ctx = hgrn2_scan(qc_d, flip(k_c[:, :, d]), flip(v_c), flip(lf_c[:, :, d]), s0, need_ctx)
        o_l, _ = hgrn2_scan(flip(q_l), flip(k_l[:, :, d]), flip(v_l), flip(lf_l[:, :, d]), s_ctx, True)
        os_l.append(flip(o_l))
        if need_ctx:
            os_c.append(flip(o_c))
    y_lat = from_col_major(hgrn2_readout(os_l[0] + os_l[1], pl[..., HG_KEY:st0], norm_g) @ w_out, rows).astype(hl.dtype)
    y_ctx = None
    if need_ctx:
        y_ctx = (hgrn2_readout(os_c[0] + os_c[1], pc[..., HG_KEY:st0], norm_g) @ w_out).astype(hc.dtype)
    return y_ctx, y_lat


def moe(h, router_w, router_b, w_gate, w_up, w_down):
    shp = h.shape
    t = h.reshape(-1, D_MODEL)
    scores = jax.nn.sigmoid((t @ router_w).astype(jnp.float32))
    sel = scores + router_b.astype(jnp.float32)
    grouped = sel.reshape(-1, N_EXPERT_GROUPS, EXPERTS_PER_GROUP)
    group_score = lax.top_k(grouped, TOP_K)[0].sum(-1)
    g_idx = jnp.argmax(group_score, axis=-1)
    idx = jnp.broadcast_to(g_idx[:, None, None], (t.shape[0], 1, EXPERTS_PER_GROUP))
    in_group = jnp.take_along_axis(grouped, idx, axis=1)[:, 0]
    _, local = lax.top_k(in_group, TOP_K)
    expert_idx = g_idx[:, None] * EXPERTS_PER_GROUP + local
    wts = jnp.take_along_axis(scores, expert_idx, axis=1)
    wts = wts / jnp.sum(wts, axis=-1, keepdims=True)
    combine = jnp.sum(jax.nn.one_hot(expert_idx, N_EXPERTS, dtype=jnp.float32) * wts[..., None], axis=1)

    def expert(acc, p):
        wg, wu, wd, gate_col = p
        y = (jax.nn.silu(t @ wg) * (t @ wu)) @ wd
        return acc + gate_col[:, None] * y, None

    out, _ = lax.scan(expert, jnp.zeros(t.shape, jnp.float32), (w_gate, w_up, w_down, combine.T))
    return out.reshape(shp).astype(h.dtype)


def setup_inputs(seed: int = 0) -> dict:
    key = jax.random.key(seed)
    ks = jax.random.split(key, 32)
    f32 = jnp.float32

    def dense(k, shape, fan_in, scale=1.0):
        return scale * fan_in ** -0.5 * jax.random.normal(k, shape, f32)

    def gain(k, shape):
        return 1.0 + 0.1 * jax.random.normal(k, shape, f32)

    def small(k, shape, s=0.02):
        return s * jax.random.normal(k, shape, f32)

    dt0 = jnp.exp(jax.random.uniform(ks[14], (N_EVEN, 2, SSD_HEADS), f32, np.log(1e-3), np.log(1e-1)))
    return {
        "x": jax.random.normal(ks[0], (BATCH, SEQ, D_MODEL), f32),
        "c": jax.random.normal(ks[1], (BATCH, D_MODEL), f32),
        "ctx": jax.random.normal(ks[2], (BATCH, CTX_LEN, D_MODEL), f32),
        "c_ctx": jax.random.normal(ks[3], (D_MODEL,), f32),
        "mod_w": dense(ks[4], (DEPTH, D_MODEL, N_MOD * D_MODEL), D_MODEL, 0.5),
        "mod_b": small(ks[5], (DEPTH, N_MOD * D_MODEL)),
        "norm_mix_g": gain(ks[6], (DEPTH, D_MODEL)),
        "norm_ffn_g": gain(ks[7], (DEPTH, D_MODEL)),
        "router_w": dense(ks[8], (D_MODEL, N_EXPERTS), D_MODEL),
        "router_b": small(ks[9], (N_EXPERTS,), 0.01),
        "moe_w_gate": dense(ks[10], (DEPTH, N_EXPERTS, D_MODEL, D_EXPERT), D_MODEL),
        "moe_w_up": dense(ks[11], (DEPTH, N_EXPERTS, D_MODEL, D_EXPERT), D_MODEL),
        "moe_w_down": dense(ks[12], (DEPTH, N_EXPERTS, D_EXPERT, D_MODEL), D_EXPERT),
        "ab_w_in": dense(ks[13], (N_EVEN, D_MODEL, AB_IN), D_MODEL),
        "ssd_conv_w": dense(ks[15], (N_EVEN, SSD_CONV, SSD_CONV_DIM), SSD_CONV),
        "ssd_conv_b": small(ks[16], (N_EVEN, SSD_CONV_DIM)),
        "ssd_dt_bias": dt0 + jnp.log(-jnp.expm1(-dt0)),
        "ssd_a_log": jnp.log(jax.random.uniform(ks[17], (N_EVEN, 2, SSD_HEADS), f32, 1.0, 16.0)),
        "ssd_d": gain(ks[18], (N_EVEN, SSD_HEADS)),
        "ssd_norm_g": gain(ks[19], (N_EVEN, SSD_INNER)),
        "cf_dw_w": dense(ks[20], (N_EVEN, CF_KERNEL, CF_CH), CF_KERNEL),
        "cf_dw_b": small(ks[21], (N_EVEN, CF_CH)),
        "cf_ln_g": gain(ks[22], (N_EVEN, CF_CH)),
        "cf_ln_b": small(ks[23], (N_EVEN, CF_CH)),
        "ab_w_out": dense(ks[24], (N_EVEN, AB_OUT, D_MODEL), AB_OUT),
        "hg_w_in": dense(ks[25], (N_ODD, D_MODEL, HG_IN), D_MODEL),
        "hg_lb": small(ks[26], (DEPTH, HG_KEY), 0.1),
        "hg_norm_g": gain(ks[27], (N_ODD, HG_DV)),
        "hg_w_out": dense(ks[28], (N_ODD, HG_VAL, D_MODEL), HG_VAL),
        "final_norm_g": gain(ks[29], (D_MODEL,)),
    }


def reference(x, c, ctx, c_ctx, mod_w, mod_b, norm_mix_g, norm_ffn_g, router_w, router_b,
              moe_w_gate, moe_w_up, moe_w_down, ab_w_in, ssd_conv_w, ssd_conv_b, ssd_dt_bias,
              ssd_a_log, ssd_d, ssd_norm_g, cf_dw_w, cf_dw_b, cf_ln_g, cf_ln_b, ab_w_out,
              hg_w_in, hg_lb, hg_norm_g, hg_w_out, final_norm_g):
    rows = x.shape[1] // GRID_W
    lb_all = jnp.cumsum(jax.nn.softmax(hg_lb.astype(jnp.float32), axis=0), axis=0)
    lb_all = lb_all - lb_all[0]
    xl, xc = x, ctx
    for l in range(DEPTH):
        last = l == DEPTH - 1
        j = l // 2
        m_l = modulation(c, mod_w[l], mod_b[l])[:, :, None, :]
        m_c = modulation(c_ctx, mod_w[l], mod_b[l])
        hl = rmsnorm(xl, norm_mix_g[l]) * (1.0 + m_l[:, 1]) + m_l[:, 0]
        hc = rmsnorm(xc, norm_mix_g[l]) * (1.0 + m_c[1]) + m_c[0]
        if l % 2 == 0:
            y_c, y_l = even_mixer(hc, hl, ab_w_in[j], ssd_conv_w[j], ssd_conv_b[j], ssd_dt_bias[j],
                                  ssd_a_log[j], ssd_d[j], ssd_norm_g[j], cf_dw_w[j], cf_dw_b[j],
                                  cf_ln_g[j], cf_ln_b[j], ab_w_out[j], rows, not last)
        else:
            y_c, y_l = odd_mixer(hc, hl, hg_w_in[j], lb_all[l], hg_norm_g[j], hg_w_out[j], rows, not last)
        xl = xl + m_l[:, 2] * y_l
        hl = rmsnorm(xl, norm_ffn_g[l]) * (1.0 + m_l[:, 4]) + m_l[:, 3]
        xl = xl + m_l[:, 5] * moe(hl, router_w, router_b, moe_w_gate[l], moe_w_up[l], moe_w_down[l])
        if not last:
            xc = xc + m_c[2] * y_c
            hc = rmsnorm(xc, norm_ffn_g[l]) * (1.0 + m_c[4]) + m_c[3]
            xc = xc + m_c[5] * moe(hc, router_w, router_b, moe_w_gate[l], moe_w_up[l], moe_w_down[l])
    return rmsnorm(xl, final_norm_g)
```

```cpp
#ifndef CPU_TEST
#include <hip/hip_runtime.h>
#include <hip/hip_cooperative_groups.h>
namespace cg = cooperative_groups;
#define HD __host__ __device__ __forceinline__
#else
#define HD inline
#endif
#include <cstdio>
#include <cstdint>
#include <cmath>

#ifndef CFG_B
#define CFG_B 8
#define CFG_SEQ 2048
#define CFG_CTX 256
#endif
constexpr int NB = CFG_B, SEQ = CFG_SEQ, CTX = CFG_CTX, DM = 1024, GW = 64, ROWS = SEQ / GW;
constexpr int TL = NB * SEQ, TC = NB * CTX, TT = TL + TC;
constexpr int AB_IN = 5152, HG_IN = 5120, NE = 16, DE = 512;
constexpr float EPS = 1e-6f;
constexpr int NT = 512;
constexpr int LDS_BYTES = 147456;

typedef unsigned short bf16_t;
HD float bf2f(bf16_t h) { unsigned u = (unsigned)h << 16; return __builtin_bit_cast(float, u); }
HD bf16_t f2bf(float f) { unsigned u = __builtin_bit_cast(unsigned, f); return (bf16_t)((u + 0x7fffu + ((u >> 16) & 1u)) >> 16); }
struct alignas(16) u32x4_t { unsigned x, y, z, w; };
HD float bflo(unsigned w) { return __builtin_bit_cast(float, w << 16); }
HD float bfhi(unsigned w) { return __builtin_bit_cast(float, w & 0xffff0000u); }
#ifndef CPU_TEST
#define CHUNK_FENCE() asm volatile("" ::: "memory")
#else
#define CHUNK_FENCE()
#endif
HD float sigmoidf_(float x) { return 1.f / (1.f + expf(-x)); }
HD float siluf_(float x) { return x / (1.f + expf(-x)); }
HD float softplusf_(float x) { return x > 20.f ? x : log1pf(expf(x)); }

enum { I_X, I_C, I_CTX, I_CCTX, I_MODW, I_MODB, I_NMIXG, I_NFFNG, I_RW, I_RB, I_WG, I_WU, I_WD, I_ABIN, I_SCW, I_SCB, I_DTB, I_ALOG, I_SSDD, I_SSDG,
       I_CFW, I_CFB, I_CFLG, I_CFLB, I_ABOUT, I_HGIN, I_HGLB, I_HGNG, I_HGOUT, I_FNG, N_IN };

constexpr size_t al256(size_t x) { return (x + 255) & ~(size_t)255; }
constexpr size_t WS_MODV = 0;
constexpr size_t WS_DT = al256(WS_MODV + (size_t)2 * (NB + 1) * 6144 * 4);
constexpr size_t WS_XC = al256(WS_DT + (size_t)TT * 32 * 4);
constexpr size_t WS_EIDX = al256(WS_XC + (size_t)TC * DM * 4);
constexpr size_t WS_EW = al256(WS_EIDX + (size_t)TT * 2 * 4);
constexpr size_t WS_H = al256(WS_EW + (size_t)TT * 2 * 4);
constexpr size_t WS_R = al256(WS_H + (size_t)TT * DM * 2);
constexpr size_t WS_Z = WS_R;
constexpr size_t WS_XR = al256(WS_Z + (size_t)TT * 1024 * 2);
constexpr size_t WS_U = al256(WS_XR + (size_t)TT * 2048 * 2);
constexpr size_t WS_XBC = al256(WS_U + (size_t)TT * 1024 * 2);
constexpr size_t WS_Y = al256(WS_XBC + (size_t)TT * 2048 * 2);
constexpr size_t WS_END0 = al256(WS_Y + (size_t)TT * 1024 * 4);
constexpr size_t WS_ACT = WS_Z;
constexpr size_t WS_P1 = al256(WS_ACT + (size_t)TT * 2 * 512 * 2);
constexpr size_t WS_O = al256(WS_P1 + (size_t)TT * 5120 * 2);
constexpr size_t WS_END1 = al256(WS_O + (size_t)TL * 1024 * 4);
constexpr size_t WS_NEED = WS_END0 > WS_END1 ? WS_END0 : WS_END1;

struct P { const float* in[N_IN]; float* out; unsigned char* ws; };

HD int tok_modrow(int r) { return r < TL ? r / SEQ : NB; }
HD const float* xin_row(const P& p, int r) { return r < TL ? p.in[I_X] + (size_t)r * DM : p.in[I_CTX] + (size_t)(r - TL) * DM; }
HD float* xcur_row(const P& p, int r) { return r < TL ? p.out + (size_t)r * DM : (float*)(p.ws + WS_XC) + (size_t)(r - TL) * DM; }
HD const float* modv(const P& p, int l, int row, int m) { return (const float*)(p.ws + WS_MODV) + ((size_t)(l * (NB + 1) + row) * 6 + m) * DM; }

HD void ph_mod(const P& p, long tid, long nth) {
  float* MV = (float*)(p.ws + WS_MODV);
  for (long i = tid; i < 2 * 6144; i += nth) {
    const int l = (int)(i / 6144), j = (int)(i % 6144);
    float acc[NB + 1];
    for (int r = 0; r <= NB; ++r) acc[r] = 0.f;
    const float* w = p.in[I_MODW] + (size_t)l * DM * 6144 + j;
    for (int k = 0; k < DM; ++k) {
      const float wv = w[(size_t)k * 6144];
#pragma unroll
      for (int r = 0; r <= NB; ++r) { const float cv = r < NB ? p.in[I_C][r * DM + k] : p.in[I_CCTX][k]; acc[r] += siluf_(cv) * wv; }
    }
#pragma unroll
    for (int r = 0; r <= NB; ++r) MV[(size_t)(l * (NB + 1) + r) * 6144 + j] = acc[r] + p.in[I_MODB][l * 6144 + j];
  }
}

HD void ph_norm(const P& p, int l, int mb, bool from_input, int ntok, bool route, long tid, long nth) {
  bf16_t* H = (bf16_t*)(p.ws + WS_H);
  const float* g = p.in[mb == 0 ? I_NMIXG : I_NFFNG] + l * DM;
  for (long r = tid; r < ntok; r += nth) {
    const float* x = from_input ? xin_row(p, (int)r) : xcur_row(p, (int)r);
    const int mr = tok_modrow((int)r);
    const float* sh = modv(p, l, mr, mb), *sc = modv(p, l, mr, mb + 1);
    float ss = 0.f;
    for (int k = 0; k < DM; ++k) ss += x[k] * x[k];
    const float rstd = 1.f / sqrtf(ss / DM + EPS);
    float lg[NE];
    for (int e = 0; e < NE; ++e) lg[e] = 0.f;
    for (int k = 0; k < DM; ++k) {
      const float h = x[k] * rstd * g[k] * (1.f + sc[k]) + sh[k];
      H[(size_t)r * DM + k] = f2bf(h);
      if (route) {
#pragma unroll
        for (int e = 0; e < NE; ++e) lg[e] += h * p.in[I_RW][k * NE + e];
      }
    }
    if (route) {
      float s[NE], sel[NE];
#pragma unroll
      for (int e = 0; e < NE; ++e) { s[e] = sigmoidf_(lg[e]); sel[e] = s[e] + p.in[I_RB][e]; }
      int bg = 0; float bgs = -1e30f;
#pragma unroll
      for (int gq = 0; gq < 4; ++gq) {
        float m1 = -1e30f, m2 = -1e30f;
#pragma unroll
        for (int i = 0; i < 4; ++i) { const float v = sel[gq * 4 + i]; if (v > m1) { m2 = m1; m1 = v; } else if (v > m2) m2 = v; }
        const float gs = m1 + m2;
        if (gs > bgs) { bgs = gs; bg = gq; }
      }
      int i1 = 0, i2 = 0; float v1 = -1e30f, v2 = -1e30f; float s1 = 0.f, s2 = 0.f;
#pragma unroll
      for (int gq = 0; gq < 4; ++gq) if (gq == bg) {
#pragma unroll
        for (int i = 0; i < 4; ++i) { const float v = sel[gq * 4 + i]; if (v > v1) { v1 = v; i1 = i; s1 = s[gq * 4 + i]; } }
#pragma unroll
        for (int i = 0; i < 4; ++i) { const float v = sel[gq * 4 + i]; if (i != i1 && v > v2) { v2 = v; i2 = i; s2 = s[gq * 4 + i]; } }
      }
      int* EI = (int*)(p.ws + WS_EIDX); float* EW = (float*)(p.ws + WS_EW);
      EI[r * 2] = bg * 4 + i1; EI[r * 2 + 1] = bg * 4 + i2;
      const float inv = 1.f / (s1 + s2);
      EW[r * 2] = s1 * inv; EW[r * 2 + 1] = s2 * inv;
    }
  }
}

HD void ph_dt(const P& p, long tid, long nth) {
  const bf16_t* H = (const bf16_t*)(p.ws + WS_H); float* DT = (float*)(p.ws + WS_DT);
  for (long i = tid; i < (long)TT * 32; i += nth) {
    const int r = (int)(i / 32), j = (int)(i % 32);
    float acc = 0.f;
    for (int k = 0; k < DM; ++k) acc += bf2f(H[(size_t)r * DM + k]) * p.in[I_ABIN][(size_t)k * AB_IN + 3072 + j];
    DT[i] = softplusf_(acc + p.in[I_DTB][j]);
  }
}

template <class Epi> HD void gemm_naive(const bf16_t* A, int lda, int r0, int M, const float* W, int ldw, int K, int N, const Epi& epi, long tid, long nth) {
  const long items = (long)(M / 8) * N;
  for (long it = tid; it < items; it += nth) {
    const int rb = (int)(it / N), n = (int)(it % N);
    float acc[8];
#pragma unroll
    for (int i = 0; i < 8; ++i) acc[i] = 0.f;
    const bf16_t* a = A + (size_t)(r0 + rb * 8) * lda;
    for (int k = 0; k < K; ++k) {
      const float w = W[(size_t)k * ldw + n];
#pragma unroll
      for (int i = 0; i < 8; ++i) acc[i] += bf2f(a[(size_t)i * lda + k]) * w;
    }
#pragma unroll
    for (int i = 0; i < 8; ++i) epi(r0 + rb * 8 + i, n, acc[i]);
  }
}
template <class Epi> HD void gemm_naive2(const bf16_t* A, int lda, int r0, int M, const float* W1, const float* W2, int ldw, int K, int N, const Epi& epi, long tid, long nth) {
  const long items = (long)(M / 8) * N;
  for (long it = tid; it < items; it += nth) {
    const int rb = (int)(it / N), n = (int)(it % N);
    float a1[8], a2[8];
#pragma unroll
    for (int i = 0; i < 8; ++i) { a1[i] = 0.f; a2[i] = 0.f; }
    const bf16_t* a = A + (size_t)(r0 + rb * 8) * lda;
    for (int k = 0; k < K; ++k) {
      const float w1 = W1[(size_t)k * ldw + n], w2 = W2[(size_t)k * ldw + n];
#pragma unroll
      for (int i = 0; i < 8; ++i) { const float av = bf2f(a[(size_t)i * lda + k]); a1[i] += av * w1; a2[i] += av * w2; }
    }
#pragma unroll
    for (int i = 0; i < 8; ++i) epi(r0 + rb * 8 + i, n, a1[i], a2[i]);
  }
}

struct EpiStore { bf16_t* O; int ldo; HD void operator()(int r, int n, float v) const { O[(size_t)r * ldo + n] = f2bf(v); } };
struct EpiGlu { bf16_t* O; int ldo; HD void operator()(int r, int n, float v, float g) const { O[(size_t)r * ldo + n] = f2bf(v * sigmoidf_(g)); } };

HD void ph_inproj0(const P& p, long tid, long nth) {
  const bf16_t* H = (const bf16_t*)(p.ws + WS_H);
  const float* W = p.in[I_ABIN];
  gemm_naive(H, DM, 0, TT, W, AB_IN, DM, 1024, EpiStore{(bf16_t*)(p.ws + WS_Z), 1024}, tid, nth);
  gemm_naive(H, DM, 0, TT, W + 1024, AB_IN, DM, 2048, EpiStore{(bf16_t*)(p.ws + WS_XR), 2048}, tid, nth);
  gemm_naive2(H, DM, 0, TT, W + 3104, W + 4128, AB_IN, DM, 1024, EpiGlu{(bf16_t*)(p.ws + WS_U), 1024}, tid, nth);
}

HD void tok_pos(int r, int& t, int& L) { if (r < TL) { t = r % SEQ; L = SEQ; } else { t = (r - TL) % CTX; L = CTX; } }

HD void ph_conv5(const P& p, long tid, long nth) {
  const bf16_t* XR = (const bf16_t*)(p.ws + WS_XR); bf16_t* XBC = (bf16_t*)(p.ws + WS_XBC);
  for (long i = tid; i < (long)TT * 2048; i += nth) {
    const int r = (int)(i / 2048), c = (int)(i % 2048);
    int t, L; tok_pos(r, t, L);
    float acc = p.in[I_SCB][c];
#pragma unroll
    for (int k = 0; k < 5; ++k) { const int tt = t + k - 2; if (tt >= 0 && tt < L) acc += bf2f(XR[(size_t)(r + k - 2) * 2048 + c]) * p.in[I_SCW][k * 2048 + c]; }
    XBC[i] = f2bf(siluf_(acc));
  }
}

HD void ph_ssd_scan(const P& p, long tid, long nth) {
  const bf16_t* XBC = (const bf16_t*)(p.ws + WS_XBC); const float* DT = (const float*)(p.ws + WS_DT); float* Y = (float*)(p.ws + WS_Y);
  for (long it = tid; it < (long)NB * 16 * 64; it += nth) {
    const int b = (int)(it / 1024), h = (int)((it / 64) % 16), pp = (int)(it % 64), g = h / 4;
    const float Dk = p.in[I_SSDD][h];
    for (int dir = 0; dir < 2; ++dir) {
      const float a = -expf(p.in[I_ALOG][dir * 16 + h]);
      float S[128];
#pragma unroll
      for (int n = 0; n < 128; ++n) S[n] = 0.f;
      for (int s = 0; s < CTX + SEQ; ++s) {
        int r;
        if (s < CTX) r = TL + b * CTX + (dir ? CTX - 1 - s : s);
        else { const int t = s - CTX; r = b * SEQ + (dir ? SEQ - 1 - t : t); }
        const float dt = DT[(size_t)r * 32 + dir * 16 + h];
        const float xv = bf2f(XBC[(size_t)r * 2048 + h * 64 + pp]);
        const float dec = expf(dt * a), xdt = xv * dt;
        const bf16_t* Bp = XBC + (size_t)r * 2048 + 1024 + g * 128, *Cp = XBC + (size_t)r * 2048 + 1536 + g * 128;
        float y = 0.f;
#pragma unroll
        for (int c8 = 0; c8 < 16; ++c8) {
          const u32x4_t bv = *(const u32x4_t*)(Bp + c8 * 8), cv = *(const u32x4_t*)(Cp + c8 * 8);
          CHUNK_FENCE();
#pragma unroll
          for (int j = 0; j < 4; ++j) {
            const unsigned bw = j == 0 ? bv.x : j == 1 ? bv.y : j == 2 ? bv.z : bv.w, cw = j == 0 ? cv.x : j == 1 ? cv.y : j == 2 ? cv.z : cv.w;
            S[c8 * 8 + 2 * j] = dec * S[c8 * 8 + 2 * j] + xdt * bflo(bw); y += S[c8 * 8 + 2 * j] * bflo(cw);
            S[c8 * 8 + 2 * j + 1] = dec * S[c8 * 8 + 2 * j + 1] + xdt * bfhi(bw); y += S[c8 * 8 + 2 * j + 1] * bfhi(cw);
          }
        }
        float* yo = Y + (size_t)r * 1024 + h * 64 + pp;
        if (dir == 0) *yo = y + Dk * xv; else *yo += y;
      }
    }
  }
}

HD void ph_ssd_readout(const P& p, long tid, long nth) {
  const float* Y = (const float*)(p.ws + WS_Y); const bf16_t* Z = (const bf16_t*)(p.ws + WS_Z); bf16_t* OC = (bf16_t*)(p.ws + WS_XR);
  for (long r = tid; r < TT; r += nth) {
    float ss = 0.f;
    for (int k = 0; k < 1024; ++k) { const float v = Y[(size_t)r * 1024 + k] * siluf_(bf2f(Z[(size_t)r * 1024 + k])); ss += v * v; }
    const float rstd = 1.f / sqrtf(ss / 1024.f + EPS);
    for (int k = 0; k < 1024; ++k) { const float v = Y[(size_t)r * 1024 + k] * siluf_(bf2f(Z[(size_t)r * 1024 + k])); OC[(size_t)r * 2048 + k] = f2bf(v * rstd * p.in[I_SSDG][k]); }
  }
}
HD void ph_cf_conv(const P& p, long tid, long nth) {
  const bf16_t* U = (const bf16_t*)(p.ws + WS_U); bf16_t* CT = (bf16_t*)(p.ws + WS_H);
  for (long i = tid; i < (long)TT * 1024; i += nth) {
    const int r = (int)(i / 1024), c = (int)(i % 1024);
    int t, L;
    if (r < TL) { t = r % GW; L = GW; } else { t = (r - TL) % CTX; L = CTX; }
    float acc = p.in[I_CFB][c];
    for (int j = 0; j < 31; ++j) { const int tt = t + j - 15; if (tt >= 0 && tt < L) acc += bf2f(U[(size_t)(r + j - 15) * 1024 + c]) * p.in[I_CFW][j * 1024 + c]; }
    CT[i] = f2bf(acc);
  }
}
HD void ph_cf_ln(const P& p, long tid, long nth) {
  const bf16_t* CT = (const bf16_t*)(p.ws + WS_H); bf16_t* OC = (bf16_t*)(p.ws + WS_XR);
  for (long r = tid; r < TT; r += nth) {
    float s = 0.f;
    for (int k = 0; k < 1024; ++k) s += bf2f(CT[(size_t)r * 1024 + k]);
    const float mu = s / 1024.f; float q = 0.f;
    for (int k = 0; k < 1024; ++k) { const float d = bf2f(CT[(size_t)r * 1024 + k]) - mu; q += d * d; }
    const float rstd = 1.f / sqrtf(q / 1024.f + EPS);
    for (int k = 0; k < 1024; ++k) { const float v = (bf2f(CT[(size_t)r * 1024 + k]) - mu) * rstd * p.in[I_CFLG][k] + p.in[I_CFLB][k]; OC[(size_t)r * 2048 + 1024 + k] = f2bf(siluf_(v)); }
  }
}

struct EpiResid { const P* p; int l, m; bool from_input;
  HD void operator()(int r, int n, float v) const { const float base = from_input ? xin_row(*p, r)[n] : xcur_row(*p, r)[n]; xcur_row(*p, r)[n] = base + modv(*p, l, tok_modrow(r), m)[n] * v; } };

HD void ph_outproj0(const P& p, long tid, long nth) {
  gemm_naive((const bf16_t*)(p.ws + WS_XR), 2048, 0, TT, p.in[I_ABOUT], 1024, 2048, 1024, EpiResid{&p, 0, 2, true}, tid, nth);
}

HD void ph_moe_act(const P& p, int l, int ntok, long tid, long nth) {
  const bf16_t* H = (const bf16_t*)(p.ws + WS_H); bf16_t* ACT = (bf16_t*)(p.ws + WS_ACT); const int* EI = (const int*)(p.ws + WS_EIDX);
  for (long i = tid; i < (long)ntok * 2 * DE; i += nth) {
    const int s = (int)(i / DE), j = (int)(i % DE), r = s >> 1, e = EI[s];
    const float* wg = p.in[I_WG] + (size_t)(l * NE + e) * DM * DE + j, *wu = p.in[I_WU] + (size_t)(l * NE + e) * DM * DE + j;
    float ag = 0.f, au = 0.f;
    for (int k = 0; k < DM; ++k) { const float hv = bf2f(H[(size_t)r * DM + k]); ag += hv * wg[(size_t)k * DE]; au += hv * wu[(size_t)k * DE]; }
    ACT[i] = f2bf(siluf_(ag) * au);
  }
}
HD void ph_moe_down(const P& p, int l, int ntok, long tid, long nth) {
  const bf16_t* ACT = (const bf16_t*)(p.ws + WS_ACT); const int* EI = (const int*)(p.ws + WS_EIDX); const float* EW = (const float*)(p.ws + WS_EW);
  for (long i = tid; i < (long)ntok * DM; i += nth) {
    const int r = (int)(i / DM), n = (int)(i % DM);
    float tot = 0.f;
    for (int k2 = 0; k2 < 2; ++k2) {
      const int e = EI[r * 2 + k2]; const float* wd = p.in[I_WD] + (size_t)(l * NE + e) * DE * DM + n;
      float acc = 0.f;
      for (int j = 0; j < DE; ++j) acc += bf2f(ACT[(size_t)(r * 2 + k2) * DE + j]) * wd[(size_t)j * DM];
      tot += EW[r * 2 + k2] * acc;
    }
    float* x = xcur_row(p, r);
    x[n] += modv(p, l, tok_modrow(r), 5)[n] * tot;
  }
}

struct EpiHgQ { bf16_t* O; HD void operator()(int r, int n, float v) const { O[(size_t)r * 5120 + n] = f2bf(siluf_(v)); } };
struct EpiHgRaw { bf16_t* O; int c0; HD void operator()(int r, int n, float v) const { O[(size_t)r * 5120 + c0 + n] = f2bf(v); } };
struct EpiHgF { bf16_t* O; const float* lbraw; HD void operator()(int r, int n, float v) const {
    const int c = n & 1023; const float lb = 1.f / (1.f + expf(lbraw[c] - lbraw[1024 + c]));
    O[(size_t)r * 5120 + 3072 + n] = f2bf(logf(lb + (1.f - lb) * sigmoidf_(v))); } };
HD void ph_inproj1(const P& p, long tid, long nth) {
  const bf16_t* H = (const bf16_t*)(p.ws + WS_H); bf16_t* P1 = (bf16_t*)(p.ws + WS_P1); const float* W = p.in[I_HGIN];
  gemm_naive(H, DM, 0, TL, W, HG_IN, DM, 1024, EpiHgQ{P1}, tid, nth);
  gemm_naive(H, DM, 0, TL, W + 1024, HG_IN, DM, 1024, EpiHgRaw{P1, 1024}, tid, nth);
  gemm_naive(H, DM, 0, TT, W + 2048, HG_IN, DM, 1024, EpiHgRaw{P1, 2048}, tid, nth);
  gemm_naive(H, DM, 0, TT, W + 3072, HG_IN, DM, 2048, EpiHgF{P1, p.in[I_HGLB]}, tid, nth);
}
HD void ph_hg_scan(const P& p, long tid, long nth) {
  const bf16_t* P1 = (const bf16_t*)(p.ws + WS_P1); float* O = (float*)(p.ws + WS_O);
  for (long it = tid; it < (long)NB * 8 * 128; it += nth) {
    const int b = (int)(it / 1024), h = (int)((it / 128) % 8), v = (int)(it % 128);
    for (int dir = 0; dir < 2; ++dir) {
      float S[128];
#pragma unroll
      for (int k = 0; k < 128; ++k) S[k] = 0.f;
      for (int s = 0; s < CTX + SEQ; ++s) {
        int r; const bool isctx = s < CTX;
        if (isctx) r = TL + b * CTX + (dir ? CTX - 1 - s : s);
        else { int tp = s - CTX; tp = dir ? SEQ - 1 - tp : tp; const int col = tp / ROWS, row = tp % ROWS; r = b * SEQ + row * GW + col; }
        const bf16_t* pr = P1 + (size_t)r * 5120;
        const float vv = bf2f(pr[2048 + h * 128 + v]);
        const bf16_t* lf = pr + 3072 + dir * 1024 + h * 128, *q = pr + h * 128;
        float o = 0.f;
#pragma unroll
        for (int c8 = 0; c8 < 16; ++c8) {
          const u32x4_t fv = *(const u32x4_t*)(lf + c8 * 8), qv = *(const u32x4_t*)(q + c8 * 8);
          CHUNK_FENCE();
#pragma unroll
          for (int j = 0; j < 4; ++j) {
            const unsigned fw = j == 0 ? fv.x : j == 1 ? fv.y : j == 2 ? fv.z : fv.w, qw = j == 0 ? qv.x : j == 1 ? qv.y : j == 2 ? qv.z : qv.w;
            const float f0 = expf(bflo(fw)), f1 = expf(bfhi(fw));
            S[c8 * 8 + 2 * j] = f0 * S[c8 * 8 + 2 * j] + (1.f - f0) * vv; o += isctx ? 0.f : S[c8 * 8 + 2 * j] * bflo(qw);
            S[c8 * 8 + 2 * j + 1] = f1 * S[c8 * 8 + 2 * j + 1] + (1.f - f1) * vv; o += isctx ? 0.f : S[c8 * 8 + 2 * j + 1] * bfhi(qw);
          }
        }
        if (!isctx) { float* op = O + (size_t)r * 1024 + h * 128 + v; if (dir == 0) *op = o; else *op += o; }
      }
    }
  }
}
HD void ph_hg_readout(const P& p, long tid, long nth) {
  const float* O = (const float*)(p.ws + WS_O); const bf16_t* P1 = (const bf16_t*)(p.ws + WS_P1); bf16_t* RO = (bf16_t*)(p.ws + WS_H);
  for (long i = tid; i < (long)TL * 8; i += nth) {
    const int r = (int)(i / 8), h = (int)(i % 8);
    float ss = 0.f;
    for (int v = 0; v < 128; ++v) { const float o = O[(size_t)r * 1024 + h * 128 + v]; ss += o * o; }
    const float rstd = 1.f / sqrtf(ss / 128.f + EPS);
    for (int v = 0; v < 128; ++v) {
      const float o = O[(size_t)r * 1024 + h * 128 + v] * rstd * p.in[I_HGNG][v];
      RO[(size_t)r * 1024 + h * 128 + v] = f2bf(o * siluf_(bf2f(P1[(size_t)r * 5120 + 1024 + h * 128 + v])));
    }
  }
}
HD void ph_outproj1(const P& p, long tid, long nth) {
  gemm_naive((const bf16_t*)(p.ws + WS_H), 1024, 0, TL, p.in[I_HGOUT], 1024, 1024, 1024, EpiResid{&p, 1, 2, false}, tid, nth);
}
HD void ph_final(const P& p, long tid, long nth) {
  for (long r = tid; r < TL; r += nth) {
    float* x = p.out + (size_t)r * DM; float ss = 0.f;
    for (int k = 0; k < DM; ++k) ss += x[k] * x[k];
    const float rstd = 1.f / sqrtf(ss / DM + EPS);
    for (int k = 0; k < DM; ++k) x[k] = x[k] * rstd * p.in[I_FNG][k];
  }
}

#define PHASES(SYNC) \
  ph_mod(p, tid, nth); SYNC; \
  ph_norm(p, 0, 0, true, TT, false, tid, nth); SYNC; \
  ph_dt(p, tid, nth); ph_inproj0(p, tid, nth); SYNC; \
  ph_conv5(p, tid, nth); SYNC; \
  ph_ssd_scan(p, tid, nth); ph_cf_conv(p, tid, nth); SYNC; \
  ph_ssd_readout(p, tid, nth); ph_cf_ln(p, tid, nth); SYNC; \
  ph_outproj0(p, tid, nth); SYNC; \
  ph_norm(p, 0, 3, false, TT, true, tid, nth); SYNC; \
  ph_moe_act(p, 0, TT, tid, nth); SYNC; \
  ph_moe_down(p, 0, TT, tid, nth); SYNC; \
  ph_norm(p, 1, 0, false, TT, false, tid, nth); SYNC; \
  ph_inproj1(p, tid, nth); SYNC; \
  ph_hg_scan(p, tid, nth); SYNC; \
  ph_hg_readout(p, tid, nth); SYNC; \
  ph_outproj1(p, tid, nth); SYNC; \
  ph_norm(p, 1, 3, false, TL, true, tid, nth); SYNC; \
  ph_moe_act(p, 1, TL, tid, nth); SYNC; \
  ph_moe_down(p, 1, TL, tid, nth); SYNC; \
  ph_final(p, tid, nth);

#ifndef CPU_TEST
__global__ void __launch_bounds__(NT) mega(P p) {
  cg::grid_group grid = cg::this_grid();
  const long tid = (long)blockIdx.x * NT + threadIdx.x, nth = (long)gridDim.x * NT;
  PHASES(grid.sync())
}

extern "C" void kernel_launch(void* const* d_in, const int* in_sizes, int n_in, void* d_out, int out_size,
                              void* d_ws, size_t ws_size, hipStream_t stream) {
  static int grid_blocks = 0;
  if (!grid_blocks) {
    int dev = 0, cus = 0, per_cu = 0;
    (void)hipGetDevice(&dev);
    (void)hipDeviceGetAttribute(&cus, hipDeviceAttributeMultiprocessorCount, dev);
    (void)hipFuncSetAttribute((const void*)mega, hipFuncAttributeMaxDynamicSharedMemorySize, LDS_BYTES);
    (void)hipOccupancyMaxActiveBlocksPerMultiprocessor(&per_cu, (const void*)mega, NT, LDS_BYTES);
    if (per_cu < 1) per_cu = 1;
    grid_blocks = cus * per_cu;
    if (n_in != N_IN || out_size != TL * DM || ws_size < WS_NEED) { fprintf(stderr, "kernel_launch: bad sizes n_in=%d out=%d ws=%zu need=%zu\n", n_in, out_size, ws_size, (size_t)WS_NEED); grid_blocks = -1; }
  }
  if (grid_blocks < 0) return;
  P p{};
  for (int i = 0; i < N_IN; ++i) p.in[i] = (const float*)d_in[i];
  p.out = (float*)d_out; p.ws = (unsigned char*)d_ws;
  void* args[] = {&p};
  hipError_t e = hipLaunchCooperativeKernel((const void*)mega, dim3(grid_blocks), dim3(NT), args, LDS_BYTES, stream);
  if (e != hipSuccess) fprintf(stderr, "cooperative launch failed: %s (grid %d)\n", hipGetErrorString(e), grid_blocks);
}
#endif
```

```cpp
#ifndef CPU_TEST
#include <hip/hip_runtime.h>
#include <hip/hip_cooperative_groups.h>
namespace cg = cooperative_groups;
#define HD __host__ __device__ __forceinline__
#define DEV __device__ __forceinline__
#else
#define HD inline
#define DEV inline
#endif
#include <cstdio>
#include <cstdint>
#include <cmath>

#ifndef CFG_B
#define CFG_B 8
#define CFG_SEQ 2048
#define CFG_CTX 256
#endif
constexpr int NB = CFG_B, SEQ = CFG_SEQ, CTX = CFG_CTX, DM = 1024, GW = 64, ROWS = SEQ / GW;
constexpr int TL = NB * SEQ, TC = NB * CTX, TT = TL + TC;
constexpr int AB_IN = 5152, HG_IN = 5120, NE = 16, DE = 512;
constexpr float EPS = 1e-6f;
constexpr int NT = 512;
constexpr int LDS_BYTES = 147456;
static_assert(SEQ % 256 == 0 && CTX % 256 == 0, "token tiles of 256 must not straddle sequences");

typedef unsigned short bf16_t;
typedef float f32x4 __attribute__((ext_vector_type(4)));
typedef unsigned u32x4 __attribute__((ext_vector_type(4)));
HD float bf2f(bf16_t h) { unsigned u = (unsigned)h << 16; return __builtin_bit_cast(float, u); }
HD unsigned f2bfu(float f) { unsigned u = __builtin_bit_cast(unsigned, f); return (u + 0x7fffu + ((u >> 16) & 1u)) >> 16; }
HD bf16_t f2bf(float f) { return (bf16_t)f2bfu(f); }
HD unsigned pk2(float lo, float hi) { return f2bfu(lo) | (f2bfu(hi) << 16); }
HD float bflo(unsigned w) { return __builtin_bit_cast(float, w << 16); }
HD float bfhi(unsigned w) { return __builtin_bit_cast(float, w & 0xffff0000u); }
HD void store_bf16x8(bf16_t* dst, f32x4 a, f32x4 b) { u32x4 w; w.x = pk2(a[0], a[1]); w.y = pk2(a[2], a[3]); w.z = pk2(b[0], b[1]); w.w = pk2(b[2], b[3]); *(u32x4*)dst = w; }
#ifndef CPU_TEST
#define CHUNK_FENCE() asm volatile("" ::: "memory")
constexpr int LW = 64;
DEV int tidx() { int t = threadIdx.x; asm volatile("" : "+v"(t)); return t; }
#define LANE (tidx() & 63)
DEV float wsum(float v) { for (int o = 32; o; o >>= 1) v += __shfl_xor(v, o); return v; }
DEV int atomic_inc_int(int* p) { return atomicAdd(p, 1); }
#else
inline int tidx() { return emu_tid(); }
#define CHUNK_FENCE()
constexpr int LW = 1;
#define LANE 0
inline float wsum(float v) { return v; }
inline int atomic_inc_int(int* p) { return __atomic_fetch_add(p, 1, __ATOMIC_RELAXED); }
#endif
HD float sigmoidf_(float x) { return 1.f / (1.f + expf(-x)); }
HD float siluf_(float x) { return x / (1.f + expf(-x)); }
HD float softplusf_(float x) { return x > 20.f ? x : log1pf(expf(x)); }

enum { I_X, I_C, I_CTX, I_CCTX, I_MODW, I_MODB, I_NMIXG, I_NFFNG, I_RW, I_RB, I_WG, I_WU, I_WD, I_ABIN, I_SCW, I_SCB, I_DTB, I_ALOG, I_SSDD, I_SSDG,
       I_CFW, I_CFB, I_CFLG, I_CFLB, I_ABOUT, I_HGIN, I_HGLB, I_HGNG, I_HGOUT, I_FNG, N_IN };

constexpr size_t al256(size_t x) { return (x + 255) & ~(size_t)255; }
constexpr int NROWS_MAX = 2 * TT + NE * 256;
constexpr int N0P = 5376;
constexpr size_t WS_CTL = 0;
constexpr size_t WS_MODV = 1024;
constexpr size_t WS_DT = al256(WS_MODV + (size_t)2 * (NB + 1) * 6144 * 4);
constexpr size_t WS_XC = al256(WS_DT + (size_t)TT * 32 * 4);
constexpr size_t WS_EIDX = al256(WS_XC + (size_t)TC * DM * 4);
constexpr size_t WS_EW = al256(WS_EIDX + (size_t)TT * 2 * 4);
constexpr size_t WS_EPOS = al256(WS_EW + (size_t)TT * 2 * 4);
constexpr size_t WS_RSLOT = al256(WS_EPOS + (size_t)TT * 2 * 4);
constexpr size_t WS_RW = al256(WS_RSLOT + (size_t)NROWS_MAX * 4);
constexpr size_t WS_WIN0 = al256(WS_RW + (size_t)NROWS_MAX * 4);
constexpr size_t WS_WOUT0 = al256(WS_WIN0 + (size_t)N0P * 1024 * 2);
constexpr size_t WS_WHGI = al256(WS_WOUT0 + (size_t)1024 * 2048 * 2);
constexpr size_t WS_WHGO = al256(WS_WHGI + (size_t)5120 * 1024 * 2);
constexpr size_t WS_H = al256(WS_WHGO + (size_t)1024 * 1024 * 2);
constexpr size_t WS_R = al256(WS_H + (size_t)TT * DM * 2);
constexpr size_t WS_Z = WS_R;
constexpr size_t WS_XR = al256(WS_Z + (size_t)TT * 1024 * 2);
constexpr size_t WS_U = al256(WS_XR + (size_t)TT * 2048 * 2);
constexpr size_t WS_XBC = al256(WS_U + (size_t)TT * 1024 * 2);
constexpr size_t WS_Y = al256(WS_XBC + (size_t)TT * 2048 * 2);
constexpr size_t WS_END0 = al256(WS_Y + (size_t)TT * 1024 * 4);
constexpr size_t WS_WGU = WS_R;
constexpr size_t WS_WDT = al256(WS_WGU + (size_t)NE * 1024 * 1024 * 2);
constexpr size_t WS_HS = al256(WS_WDT + (size_t)NE * 1024 * 512 * 2);
constexpr size_t WS_ACT = al256(WS_HS + (size_t)NROWS_MAX * 1024 * 2);
constexpr size_t WS_YS = al256(WS_ACT + (size_t)NROWS_MAX * 512 * 2);
constexpr size_t WS_ENDM = al256(WS_YS + (size_t)2 * TT * 1024 * 2);
constexpr size_t WS_P1 = WS_R;
constexpr size_t WS_O = al256(WS_P1 + (size_t)TT * 5120 * 2);
constexpr size_t WS_END1 = al256(WS_O + (size_t)TL * 1024 * 4);
constexpr size_t cmax(size_t a, size_t b) { return a > b ? a : b; }
constexpr size_t WS_NEED = cmax(WS_END0, cmax(WS_ENDM, WS_END1));
static_assert(WS_YS >= WS_O || true, "");

struct P { const float* in[N_IN]; float* out; unsigned char* ws; };

HD int tok_modrow(int r) { return r < TL ? r / SEQ : NB; }
HD const float* xin_row(const P& p, int r) { return r < TL ? p.in[I_X] + (size_t)r * DM : p.in[I_CTX] + (size_t)(r - TL) * DM; }
HD float* xcur_row(const P& p, int r) { return r < TL ? p.out + (size_t)r * DM : (float*)(p.ws + WS_XC) + (size_t)(r - TL) * DM; }
HD const float* modv(const P& p, int l, int row, int m) { return (const float*)(p.ws + WS_MODV) + ((size_t)(l * (NB + 1) + row) * 6 + m) * DM; }

HD void ph_mod(const P& p, long tid, long nth) {
  float* MV = (float*)(p.ws + WS_MODV);
  if (tid < 64) ((int*)(p.ws + WS_CTL))[tid] = 0;
  for (long i = tid; i < 2 * 6144; i += nth) {
    const int l = (int)(i / 6144), j = (int)(i % 6144);
    float acc[NB + 1];
    for (int r = 0; r <= NB; ++r) acc[r] = 0.f;
    const float* w = p.in[I_MODW] + (size_t)l * DM * 6144 + j;
    for (int k = 0; k < DM; ++k) {
      const float wv = w[(size_t)k * 6144];
#pragma unroll
      for (int r = 0; r <= NB; ++r) { const float cv = r < NB ? p.in[I_C][r * DM + k] : p.in[I_CCTX][k]; acc[r] += siluf_(cv) * wv; }
    }
#pragma unroll
    for (int r = 0; r <= NB; ++r) MV[(size_t)(l * (NB + 1) + r) * 6144 + j] = acc[r] + p.in[I_MODB][l * 6144 + j];
  }
}
template <class Src> HD void conv_wt(bf16_t* Bt, int N, int K, int ldw, const Src& src, long tid, long nth) {
  const long items = (long)N * (K / 8);
  for (long it = tid; it < items; it += nth) {
    const int n = (int)(it % N), k8 = (int)(it / N);
    const float* s = src(n);
    f32x4 a = {0.f, 0.f, 0.f, 0.f}, b = {0.f, 0.f, 0.f, 0.f};
    if (s) { s += (size_t)k8 * 8 * ldw; a = (f32x4){s[0], s[(size_t)ldw], s[(size_t)2 * ldw], s[(size_t)3 * ldw]}; b = (f32x4){s[(size_t)4 * ldw], s[(size_t)5 * ldw], s[(size_t)6 * ldw], s[(size_t)7 * ldw]}; }
    store_bf16x8(Bt + (size_t)n * K + k8 * 8, a, b);
  }
}
struct SrcWin0 { const float* W; HD const float* operator()(int n) const {
    if (n < 3072) return W + n;
    if (n < 5120) { const int m = n - 3072, t = m >> 8, w = m & 255; return w < 128 ? W + 3104 + t * 128 + w : W + 4128 + t * 128 + (w - 128); }
    if (n < 5152) return W + 3072 + (n - 5120);
    return nullptr; } };
struct SrcId { const float* W; HD const float* operator()(int n) const { return W + n; } };
struct SrcGU { const float* Wg; const float* Wu; HD const float* operator()(int n) const { const int t = n >> 8, w = n & 255; return w < 128 ? Wg + t * 128 + w : Wu + t * 128 + (w - 128); } };
HD void ph_convert_dense(const P& p, long tid, long nth) {
  conv_wt((bf16_t*)(p.ws + WS_WIN0), N0P, 1024, AB_IN, SrcWin0{p.in[I_ABIN]}, tid, nth);
  conv_wt((bf16_t*)(p.ws + WS_WOUT0), 1024, 2048, 1024, SrcId{p.in[I_ABOUT]}, tid, nth);
  conv_wt((bf16_t*)(p.ws + WS_WHGI), 5120, 1024, HG_IN, SrcId{p.in[I_HGIN]}, tid, nth);
  conv_wt((bf16_t*)(p.ws + WS_WHGO), 1024, 1024, 1024, SrcId{p.in[I_HGOUT]}, tid, nth);
}
HD void ph_convert_moe(const P& p, int l, long tid, long nth) {
  for (int e = 0; e < NE; ++e) {
    const size_t eo = (size_t)(l * NE + e);
    conv_wt((bf16_t*)(p.ws + WS_WGU) + (size_t)e * 1024 * 1024, 1024, 1024, DE, SrcGU{p.in[I_WG] + eo * DM * DE, p.in[I_WU] + eo * DM * DE}, tid, nth);
    conv_wt((bf16_t*)(p.ws + WS_WDT) + (size_t)e * 1024 * 512, 1024, 512, DM, SrcId{p.in[I_WD] + eo * DE * DM}, tid, nth);
  }
}

HD void ph_norm(const P& p, int l, int mb, bool from_input, int ntok, int comb, int route, long tid, long nth) {
  bf16_t* H = (bf16_t*)(p.ws + WS_H);
  const float* g = p.in[mb == 0 ? I_NMIXG : I_NFFNG] + l * DM;
  const bf16_t* YS = (const bf16_t*)(p.ws + WS_YS);
  const int lane = LANE;
  for (long r = tid / LW; r < ntok; r += nth / LW) {
    const int mr = tok_modrow((int)r);
    float* xc = xcur_row(p, (int)r);
    const float* x = from_input ? xin_row(p, (int)r) : xc;
    const float* sh = modv(p, l, mr, mb), *sc = modv(p, l, mr, mb + 1);
    float ss = 0.f;
    if (comb >= 0) {
      const float* g5 = modv(p, comb, mr, 5);
      for (int k = lane; k < DM; k += LW) { const float v = xc[k] + g5[k] * (bf2f(YS[(size_t)(2 * r) * DM + k]) + bf2f(YS[(size_t)(2 * r + 1) * DM + k])); xc[k] = v; ss += v * v; }
    } else {
      for (int k = lane; k < DM; k += LW) ss += x[k] * x[k];
    }
    ss = wsum(ss);
    const float rstd = 1.f / sqrtf(ss / DM + EPS);
    float lg[NE];
#pragma unroll
    for (int e = 0; e < NE; ++e) lg[e] = 0.f;
    for (int k = lane; k < DM; k += LW) {
      const float h = x[k] * rstd * g[k] * (1.f + sc[k]) + sh[k];
      H[(size_t)r * DM + k] = f2bf(h);
      if (route >= 0) {
#pragma unroll
        for (int e = 0; e < NE; ++e) lg[e] += h * p.in[I_RW][k * NE + e];
      }
    }
    if (route >= 0) {
      float s[NE], sel[NE];
#pragma unroll
      for (int e = 0; e < NE; ++e) { lg[e] = wsum(lg[e]); s[e] = sigmoidf_(lg[e]); sel[e] = s[e] + p.in[I_RB][e]; }
      int bg = 0; float bgs = -1e30f;
#pragma unroll
      for (int gq = 0; gq < 4; ++gq) {
        float m1 = -1e30f, m2 = -1e30f;
#pragma unroll
        for (int i = 0; i < 4; ++i) { const float v = sel[gq * 4 + i]; if (v > m1) { m2 = m1; m1 = v; } else if (v > m2) m2 = v; }
        const float gs = m1 + m2;
        if (gs > bgs) { bgs = gs; bg = gq; }
      }
      int i1 = 0, i2 = 0; float v1 = -1e30f, v2 = -1e30f; float s1 = 0.f, s2 = 0.f;
#pragma unroll
      for (int gq = 0; gq < 4; ++gq) if (gq == bg) {
#pragma unroll
        for (int i = 0; i < 4; ++i) { const float v = sel[gq * 4 + i]; if (v > v1) { v1 = v; i1 = i; s1 = s[gq * 4 + i]; } }
#pragma unroll
        for (int i = 0; i < 4; ++i) { const float v = sel[gq * 4 + i]; if (i != i1 && v > v2) { v2 = v; i2 = i; s2 = s[gq * 4 + i]; } }
      }
      if (lane == 0) {
        int* EI = (int*)(p.ws + WS_EIDX); float* EW = (float*)(p.ws + WS_EW); int* EP = (int*)(p.ws + WS_EPOS); int* CNT = (int*)(p.ws + WS_CTL) + route * NE;
        const int e1 = bg * 4 + i1, e2 = bg * 4 + i2;
        EI[r * 2] = e1; EI[r * 2 + 1] = e2;
        const float inv = 1.f / (s1 + s2);
        EW[r * 2] = s1 * inv; EW[r * 2 + 1] = s2 * inv;
        EP[r * 2] = atomic_inc_int(CNT + e1); EP[r * 2 + 1] = atomic_inc_int(CNT + e2);
      }
    }
  }
}

HD int moe_base(const int* CNT, int e) { int b = 0; for (int i = 0; i < NE; ++i) if (i < e) b += (CNT[i] + 255) & ~255; return b; }
HD void ph_moe_gather(const P& p, int l, int ntok, long tid, long nth) {
  const int* CNT = (const int*)(p.ws + WS_CTL) + l * NE; const int* EI = (const int*)(p.ws + WS_EIDX); const int* EP = (const int*)(p.ws + WS_EPOS); const float* EW = (const float*)(p.ws + WS_EW);
  int* RS = (int*)(p.ws + WS_RSLOT); float* RW = (float*)(p.ws + WS_RW);
  const u32x4* H = (const u32x4*)(p.ws + WS_H); u32x4* HS = (u32x4*)(p.ws + WS_HS);
  for (long it = tid; it < (long)ntok * 2 * 128; it += nth) {
    const int s = (int)(it >> 7), j = (int)(it & 127), e = EI[s];
    const int row = moe_base(CNT, e) + EP[s];
    HS[(size_t)row * 128 + j] = H[(size_t)(s >> 1) * 128 + j];
    if (j == 0) { RS[row] = s; RW[row] = EW[s]; }
  }
  for (long it = tid; it < (long)NE * 256 * 128; it += nth) {
    const int e = (int)(it >> 15), pr = (int)((it >> 7) & 255), j = (int)(it & 127);
    const int c = CNT[e], padn = ((c + 255) & ~255) - c;
    if (pr < padn) { const int row = moe_base(CNT, e) + c + pr; HS[(size_t)row * 128 + j] = (u32x4){0u, 0u, 0u, 0u}; if (j == 0) { RS[row] = -1; RW[row] = 0.f; } }
  }
}

typedef short bf16x8 __attribute__((ext_vector_type(8)));
typedef short s16x4 __attribute__((ext_vector_type(4)));
typedef unsigned u32x2 __attribute__((ext_vector_type(2)));
#ifndef CPU_TEST
#define LAS __attribute__((address_space(3)))
DEV void blk_sync() { __syncthreads(); }
DEV float wshfl(float v, int src) { return __shfl(v, src); }
DEV f32x4 mfma16(bf16x8 a, bf16x8 b, f32x4 c) { return __builtin_amdgcn_mfma_f32_16x16x32_bf16(a, b, c, 0, 0, 0); }
DEV s16x4 lds_tr4(const LAS unsigned char* p) { return __builtin_amdgcn_ds_read_tr16_b64_v4i16((LAS s16x4*)p); }
#else
#define LAS
inline void blk_sync() { emu_block_barrier(); }
inline float wshfl(float v, int src) { return emu_shfl(v, src); }
inline f32x4 mfma16(bf16x8 a, bf16x8 b, f32x4 c) { return emu_mfma_16x16x32(a, b, c); }
inline s16x4 lds_tr4(const unsigned char* p) { return emu_tr_read(p); }
#endif
DEV bf16x8 frag_row(const LAS unsigned char* m, int ld, int R0, int K0, int lane) { return *(const LAS bf16x8*)(m + ((R0 + (lane & 15)) * ld + K0 + 8 * (lane >> 4)) * 2); }
DEV bf16x8 frag_tr(const LAS unsigned char* m, int ld, int R0, int K0, int lane) {
  const int fq = lane >> 4, qq = (lane & 15) >> 2, pp = lane & 3;
  const LAS unsigned char* a = m + ((K0 + 8 * fq + qq) * ld + R0 + 4 * pp) * 2;
  const s16x4 lo = lds_tr4(a), hi = lds_tr4(a + 4 * ld * 2);
  return (bf16x8){lo[0], lo[1], lo[2], lo[3], hi[0], hi[1], hi[2], hi[3]};
}
DEV void store_lds8(LAS unsigned char* p, f32x4 a, f32x4 b) { u32x4 w; w.x = pk2(a[0], a[1]); w.y = pk2(a[2], a[3]); w.z = pk2(b[0], b[1]); w.w = pk2(b[2], b[3]); *(LAS u32x4*)p = w; }
DEV void lds_store_bf16x4(LAS unsigned char* p, f32x4 v) { u32x2 w; w.x = pk2(v[0], v[1]); w.y = pk2(v[2], v[3]); *(LAS u32x2*)p = w; }

namespace pg8 {
typedef short bf16x8 __attribute__((ext_vector_type(8)));
constexpr int BM = 256, BK = 64, HALF = 128, HTB = HALF * BK * 2, STAGE_BYTES = 8 * HTB, NXCD = 8, WGM = 8;
HD int lds_byte(int r, int c) { const int st = (r >> 4) * 2 + (c >> 5), rr = r & 15, cc = c & 31, ob = rr * 64 + cc * 2; return st * 1024 + (ob ^ (((ob >> 9) & 1) << 5)); }
HD void stage_rc(int b, int& R, int& C) { const int st = b / 1024, sb = b % 1024, swz = sb ^ (((sb >> 9) & 1) << 5); R = (st >> 1) * 16 + swz / 64; C = (st & 1) * 32 + (swz % 64) / 2; }
HD int perm32(int rho) { const int n = rho >> 4, i = rho & 15; return 8 * (i >> 2) + 4 * n + (i & 3); }
struct Unit { int pm, pn; const bf16_t* Bt; };
struct Gemm { const bf16_t* A; int K; };

HD void tile_order(int L, int nM, int nN, int& pm, int& pn) {
  const int nwg = nM * nN; int wgid = L;
  { const int q = nwg / NXCD, r = nwg % NXCD, xcd = wgid % NXCD, off = wgid / NXCD; wgid = (xcd < r ? xcd * (q + 1) : r * (q + 1) + (xcd - r) * q) + off; }
  const int nig = WGM * nN, gid = wgid / nig, fm = gid * WGM, gsz = (nM - fm) < WGM ? (nM - fm) : WGM;
  pm = fm + ((wgid % nig) % gsz); pn = (wgid % nig) / gsz;
}

#ifndef CPU_TEST
#define PG8_LAS __attribute__((address_space(3)))
template <class Epi, class Sched, bool ALIGN_EPI = true, bool SP2 = true>
__device__ __forceinline__ void gemm_phase(PG8_LAS unsigned char* lds, const Gemm g, const Sched& S, const Epi& E) {
    const int tid = tidx(), wid = __builtin_amdgcn_readfirstlane(tid >> 6), lane = tid & 63, wr = wid >> 2, wc = wid & 3, fr = lane & 15, fq = lane >> 4;
    const int K = g.K, nt = K / BK;
    unsigned voffA[2], voffB[2];
#pragma unroll
    for (int i = 0; i < 2; ++i) { int R, C; stage_rc(tid * 16 + i * 8192, R, C); const int Rb = Epi::PERM ? ((R & ~31) + perm32(R & 31)) : R;
        voffA[i] = (unsigned)(R * K + C) * 2u; voffB[i] = (unsigned)(Rb * K + C) * 2u; }
    const size_t kstep = (size_t)(BK * 2);
    const size_t hstep = (size_t)HALF * K * 2;
    const size_t tstep = 2 * hstep;
    const unsigned ldsw = (unsigned)wid * 1024u;
    const int aoff = lds_byte(wr * 64 + fr, fq * 8), boff = lds_byte(wc * 32 + fr, fq * 8);
#define PG8_SA(b, h) (((b) * 2 + (h)) * HTB)
#define PG8_SB(b, h) ((4 + (b) * 2 + (h)) * HTB)
#define PG8_STAGE(bufoff, gbase, voff) do { _Pragma("unroll") for (int _i = 0; _i < 2; ++_i) \
        __builtin_amdgcn_global_load_lds((const unsigned*)((const char*)(gbase) + (voff)[_i]), (PG8_LAS unsigned*)(lds + (bufoff) + ldsw + _i * 8192), 16, 0, 0); } while (0)
#define PG8_LDA(dst, b, h) do { _Pragma("unroll") for (int m = 0; m < 4; ++m) _Pragma("unroll") for (int k = 0; k < 2; ++k) dst[m][k] = *(const PG8_LAS bf16x8*)(lds + PG8_SA(b, h) + aoff + m * 2048 + k * 1024); } while (0)
#define PG8_LDB(dst, b, h) do { _Pragma("unroll") for (int n = 0; n < 2; ++n) _Pragma("unroll") for (int k = 0; k < 2; ++k) dst[n][k] = *(const PG8_LAS bf16x8*)(lds + PG8_SB(b, h) + boff + n * 2048 + k * 1024); } while (0)
#define PG8_MMA(ai, bj, At, Bt) do { __builtin_amdgcn_s_setprio(1); _Pragma("unroll") for (int m = 0; m < 4; ++m) _Pragma("unroll") for (int n = 0; n < 2; ++n) _Pragma("unroll") for (int k = 0; k < 2; ++k) \
        acc[ai][bj][m][n] = __builtin_amdgcn_mfma_f32_16x16x32_bf16(Bt[n][k], At[m][k], acc[ai][bj][m][n], 0, 0, 0); __builtin_amdgcn_s_setprio(0); } while (0)
#define PG8_WAIT_V(n) asm volatile("s_waitcnt vmcnt(" #n ")" ::: "memory")
#define PG8_WAIT_L(n) asm volatile("s_waitcnt lgkmcnt(" #n ")" ::: "memory")
#define PG8_BAR __builtin_amdgcn_s_barrier()
#define PG8_SCHED __builtin_amdgcn_sched_barrier(0)
    Unit cur, nxt; int ui = 0;
    if (!S.next(0, cur)) return;
    f32x4 acc[2][2][4][2];
#pragma unroll
    for (int a = 0; a < 2; ++a)
#pragma unroll
        for (int b = 0; b < 2; ++b)
#pragma unroll
            for (int m = 0; m < 4; ++m)
#pragma unroll
                for (int n = 0; n < 2; ++n) acc[a][b][m][n] = (f32x4){0.f, 0.f, 0.f, 0.f};
    bf16x8 At[4][2], B0[2][2], B1[2][2];
    const char* cA = (const char*)g.A + (size_t)cur.pm * tstep; const char* cB = (const char*)cur.Bt + (size_t)cur.pn * tstep;
    if constexpr (SP2) {
        PG8_STAGE(PG8_SB(0, 0), cB, voffB); PG8_STAGE(PG8_SB(0, 1), cB + hstep, voffB); PG8_STAGE(PG8_SA(0, 0), cA, voffA); PG8_STAGE(PG8_SA(0, 1), cA + hstep, voffA);
        if (wr == 1) PG8_BAR;
        PG8_WAIT_V(2); PG8_BAR;
        PG8_STAGE(PG8_SB(1, 0), cB + kstep, voffB); PG8_STAGE(PG8_SA(1, 0), cA + kstep, voffA); PG8_STAGE(PG8_SB(1, 1), cB + hstep + kstep, voffB);
        PG8_WAIT_V(6); PG8_BAR;
    } else {
        PG8_STAGE(PG8_SB(0, 0), cB, voffB); PG8_STAGE(PG8_SA(0, 0), cA, voffA); PG8_STAGE(PG8_SB(0, 1), cB + hstep, voffB); PG8_STAGE(PG8_SA(0, 1), cA + hstep, voffA);
        if (wr == 1) PG8_BAR;
        PG8_WAIT_V(4); PG8_BAR;
        PG8_STAGE(PG8_SB(1, 0), cB + kstep, voffB); PG8_STAGE(PG8_SA(1, 0), cA + kstep, voffA); PG8_STAGE(PG8_SB(1, 1), cB + hstep + kstep, voffB);
        PG8_WAIT_V(6); PG8_BAR;
    }
    for (;;) {
        const bool has_next = S.next(ui + 1, nxt);
        const char* nA = has_next ? (const char*)g.A + (size_t)nxt.pm * tstep : cA; const char* nB = has_next ? (const char*)nxt.Bt + (size_t)nxt.pn * tstep : cB;
        for (int t = 0; t < nt; t += 2) {
            const bool last = (t == nt - 2);
            const char* a1 = cA + (size_t)(t + 1) * kstep;
            const char* a2 = last ? nA : cA + (size_t)(t + 2) * kstep; const char* b2 = last ? nB : cB + (size_t)(t + 2) * kstep;
            const char* a3 = a2 + kstep; const char* b3 = b2 + kstep;
            if constexpr (SP2) {
            PG8_LDB(B0, 0, 0); PG8_LDB(B1, 0, 1); PG8_SCHED; PG8_LDA(At, 0, 0); PG8_STAGE(PG8_SA(1, 1), a1 + hstep, voffA);
            PG8_WAIT_V(8); PG8_WAIT_L(0); PG8_BAR; PG8_MMA(0, 0, At, B0); PG8_MMA(0, 1, At, B1); PG8_BAR; PG8_SCHED;
            PG8_LDA(At, 0, 1); PG8_STAGE(PG8_SB(0, 0), b2, voffB); PG8_STAGE(PG8_SB(0, 1), b2 + hstep, voffB); PG8_STAGE(PG8_SA(0, 0), a2, voffA);
            PG8_WAIT_V(8); PG8_WAIT_L(0); PG8_BAR; PG8_MMA(1, 0, At, B0); PG8_MMA(1, 1, At, B1); PG8_BAR; PG8_SCHED;
            PG8_LDB(B0, 1, 0); PG8_LDB(B1, 1, 1); PG8_SCHED; PG8_LDA(At, 1, 0); PG8_STAGE(PG8_SA(0, 1), a2 + hstep, voffA);
            PG8_WAIT_V(8); PG8_WAIT_L(0); PG8_BAR; PG8_MMA(0, 0, At, B0); PG8_MMA(0, 1, At, B1); PG8_BAR; PG8_SCHED;
            PG8_LDA(At, 1, 1); PG8_STAGE(PG8_SB(1, 0), b3, voffB); PG8_STAGE(PG8_SB(1, 1), b3 + hstep, voffB); PG8_STAGE(PG8_SA(1, 0), a3, voffA);
            PG8_WAIT_V(8); PG8_WAIT_L(0); PG8_BAR; PG8_MMA(1, 0, At, B0); PG8_MMA(1, 1, At, B1); PG8_BAR; PG8_SCHED;
            } else {
            PG8_LDB(B0, 0, 0); PG8_SCHED; PG8_LDA(At, 0, 0); PG8_STAGE(PG8_SA(1, 1), a1 + hstep, voffA);
            PG8_WAIT_L(8); PG8_BAR; PG8_WAIT_L(0); PG8_MMA(0, 0, At, B0); PG8_BAR; PG8_SCHED;
            PG8_LDB(B1, 0, 1); PG8_STAGE(PG8_SB(0, 0), b2, voffB);
            PG8_BAR; PG8_WAIT_L(0); PG8_MMA(0, 1, At, B1); PG8_BAR;
            PG8_LDA(At, 0, 1); PG8_STAGE(PG8_SA(0, 0), a2, voffA);
            PG8_BAR; PG8_WAIT_L(0); PG8_MMA(1, 0, At, B0); PG8_BAR; PG8_SCHED;
            PG8_STAGE(PG8_SB(0, 1), b2 + hstep, voffB);
            PG8_WAIT_V(6); PG8_BAR; PG8_MMA(1, 1, At, B1); PG8_BAR;
            PG8_LDB(B0, 1, 0); PG8_SCHED; PG8_LDA(At, 1, 0); PG8_STAGE(PG8_SA(0, 1), a2 + hstep, voffA);
            PG8_WAIT_L(8); PG8_BAR; PG8_WAIT_L(0); PG8_MMA(0, 0, At, B0); PG8_BAR; PG8_SCHED;
            PG8_LDB(B1, 1, 1); PG8_STAGE(PG8_SB(1, 0), b3, voffB);
            PG8_BAR; PG8_WAIT_L(0); PG8_MMA(0, 1, At, B1); PG8_BAR;
            PG8_LDA(At, 1, 1); PG8_STAGE(PG8_SA(1, 0), a3, voffA);
            PG8_BAR; PG8_WAIT_L(0); PG8_MMA(1, 0, At, B0); PG8_BAR; PG8_SCHED;
            PG8_STAGE(PG8_SB(1, 1), b3 + hstep, voffB);
            PG8_WAIT_V(6); PG8_BAR; PG8_MMA(1, 1, At, B1); PG8_BAR;
            }
        }
        if constexpr (ALIGN_EPI) { if (wr == 0) PG8_BAR; }
        E(acc, cur, wr, wc, fr, fq);
        if (!has_next) break;
#pragma unroll
        for (int a = 0; a < 2; ++a)
#pragma unroll
            for (int b = 0; b < 2; ++b)
#pragma unroll
                for (int m = 0; m < 4; ++m)
#pragma unroll
                    for (int n = 0; n < 2; ++n) acc[a][b][m][n] = (f32x4){0.f, 0.f, 0.f, 0.f};
        cur = nxt; cA = nA; cB = nB; ++ui;
        if constexpr (ALIGN_EPI) { if (wr == 1) PG8_BAR; }
    }
    PG8_WAIT_V(0);
    if constexpr (!ALIGN_EPI) { if (wr == 0) PG8_BAR; }
    PG8_BAR;
#undef PG8_SA
#undef PG8_SB
#undef PG8_STAGE
#undef PG8_LDA
#undef PG8_LDB
#undef PG8_MMA
#undef PG8_WAIT_V
#undef PG8_WAIT_L
#undef PG8_BAR
#undef PG8_SCHED
}
#define GEMM_RUN(lds, g, S, E) pg8::gemm_phase((PG8_LAS unsigned char*)(lds), g, S, E)
#else
template <class Epi, class Sched> void gemm_phase_ref(const Gemm g, const Sched& S, const Epi& E) {
  Unit u;
  for (int ui = 0; S.next(ui, u); ++ui)
    for (int wid = 0; wid < 8; ++wid) for (int lane = 0; lane < 64; ++lane) {
      const int wr = wid >> 2, wc = wid & 3, fr = lane & 15, fq = lane >> 4;
      f32x4 acc[2][2][4][2];
      for (int ai = 0; ai < 2; ++ai) for (int bj = 0; bj < 2; ++bj) for (int m = 0; m < 4; ++m) for (int n = 0; n < 2; ++n) for (int i = 0; i < 4; ++i) {
        const size_t row = (size_t)u.pm * 256 + ai * 128 + wr * 64 + m * 16 + fr;
        const size_t col = (size_t)u.pn * 256 + bj * 128 + wc * 32 + (Epi::PERM ? 8 * fq + 4 * n + i : 16 * n + 4 * fq + i);
        const bf16_t* a = g.A + row * g.K, *b = u.Bt + col * g.K; float s = 0.f;
        for (int k = 0; k < g.K; ++k) s += bf2f(a[k]) * bf2f(b[k]);
        acc[ai][bj][m][n][i] = s;
      }
      E(acc, u, wr, wc, fr, fq);
    }
}
#define GEMM_RUN(lds, g, S, E) do { if (tidx() == 0) pg8::gemm_phase_ref(g, S, E); } while (0)
#endif
}
using pg8::Unit; using pg8::Gemm;

struct DenseOrder { int nM, nN, G, c; const bf16_t* Bt;
  HD bool next(int i, Unit& u) const { const long L = (long)i * G + c; if (L >= (long)nM * nN) return false; pg8::tile_order((int)L, nM, nN, u.pm, u.pn); u.Bt = Bt; return true; } };
struct Inproj1Order { int G, c; const bf16_t* Bt;
  HD bool next(int i, Unit& u) const { const long L = (long)i * G + c; const int n1 = (TL / 256) * 20, n2 = (TC / 256) * 12; if (L >= n1 + n2) return false;
    if (L < n1) pg8::tile_order((int)L, TL / 256, 20, u.pm, u.pn); else { const int q = (int)L - n1; u.pm = TL / 256 + q % (TC / 256); u.pn = 8 + q / (TC / 256); }
    u.Bt = Bt; return true; } };
struct MoeOrder { int G, c; const int* CNT; const bf16_t* Bt; size_t estride;
  HD bool next(int i, Unit& u) const { const long L = (long)i * G + c; const int t = (int)(L >> 2); int tb = 0, e = -1;
    for (int j = 0; j < NE; ++j) { const int nt = (CNT[j] + 255) >> 8; if (e < 0 && t < tb + nt) e = j; tb += nt; }
    if (e < 0) return false; u.pm = t; u.pn = (int)(L & 3); u.Bt = Bt + (size_t)e * estride; return true; } };

HD f32x4 silu4(f32x4 v) { return (f32x4){siluf_(v[0]), siluf_(v[1]), siluf_(v[2]), siluf_(v[3])}; }
HD f32x4 sigm4(f32x4 v) { return (f32x4){sigmoidf_(v[0]), sigmoidf_(v[1]), sigmoidf_(v[2]), sigmoidf_(v[3])}; }
struct EpiInproj0 { static constexpr bool PERM = true; bf16_t* Z; bf16_t* XR; bf16_t* U; float* DT; const float* dtb;
  HD void operator()(const f32x4 (&acc)[2][2][4][2], const Unit& u, int wr, int wc, int fr, int fq) const {
#pragma unroll
    for (int ai = 0; ai < 2; ++ai)
#pragma unroll
      for (int m = 0; m < 4; ++m) {
        const size_t row = (size_t)u.pm * 256 + ai * 128 + wr * 64 + m * 16 + fr; const int cl = wc * 32 + 8 * fq;
        if (u.pn < 12) { bf16_t* base = u.pn < 4 ? Z + row * 1024 + u.pn * 256 : XR + row * 2048 + (u.pn - 4) * 256;
#pragma unroll
          for (int bj = 0; bj < 2; ++bj) store_bf16x8(base + bj * 128 + cl, acc[ai][bj][m][0], acc[ai][bj][m][1]); }
        else if (u.pn < 20) store_bf16x8(U + row * 1024 + (u.pn - 12) * 128 + cl, acc[ai][0][m][0] * sigm4(acc[ai][1][m][0]), acc[ai][0][m][1] * sigm4(acc[ai][1][m][1]));
        else if (wc == 0) {
#pragma unroll
          for (int n = 0; n < 2; ++n)
#pragma unroll
            for (int i = 0; i < 4; ++i) { const int j = 8 * fq + 4 * n + i; DT[row * 32 + j] = softplusf_(acc[ai][0][m][n][i] + dtb[j]); } }
      }
  } };
struct EpiResid { static constexpr bool PERM = false; const P* p; int l; bool from_input;
  HD void operator()(const f32x4 (&acc)[2][2][4][2], const Unit& u, int wr, int wc, int fr, int fq) const {
#pragma unroll
    for (int ai = 0; ai < 2; ++ai)
#pragma unroll
      for (int m = 0; m < 4; ++m) {
        const int row = u.pm * 256 + ai * 128 + wr * 64 + m * 16 + fr;
        const float* base = from_input ? xin_row(*p, row) : xcur_row(*p, row); float* dst = xcur_row(*p, row); const float* gate = modv(*p, l, tok_modrow(row), 2);
#pragma unroll
        for (int bj = 0; bj < 2; ++bj)
#pragma unroll
          for (int n = 0; n < 2; ++n) { const int c = u.pn * 256 + bj * 128 + wc * 32 + 16 * n + 4 * fq;
            *(f32x4*)(dst + c) = *(const f32x4*)(base + c) + *(const f32x4*)(gate + c) * acc[ai][bj][m][n]; }
      }
  } };
struct EpiMoe1 { static constexpr bool PERM = true; bf16_t* ACT;
  HD void operator()(const f32x4 (&acc)[2][2][4][2], const Unit& u, int wr, int wc, int fr, int fq) const {
#pragma unroll
    for (int ai = 0; ai < 2; ++ai)
#pragma unroll
      for (int m = 0; m < 4; ++m) { const size_t row = (size_t)u.pm * 256 + ai * 128 + wr * 64 + m * 16 + fr;
        store_bf16x8(ACT + row * 512 + u.pn * 128 + wc * 32 + 8 * fq, silu4(acc[ai][0][m][0]) * acc[ai][1][m][0], silu4(acc[ai][0][m][1]) * acc[ai][1][m][1]); }
  } };
struct EpiMoe2 { static constexpr bool PERM = true; bf16_t* YS; const int* RS; const float* RW;
  HD void operator()(const f32x4 (&acc)[2][2][4][2], const Unit& u, int wr, int wc, int fr, int fq) const {
#pragma unroll
    for (int ai = 0; ai < 2; ++ai)
#pragma unroll
      for (int m = 0; m < 4; ++m) { const int row = u.pm * 256 + ai * 128 + wr * 64 + m * 16 + fr; const int slot = RS[row];
        if (slot >= 0) { const float w = RW[row]; bf16_t* dst = YS + (size_t)slot * 1024 + u.pn * 256 + wc * 32 + 8 * fq;
#pragma unroll
          for (int bj = 0; bj < 2; ++bj) store_bf16x8(dst + bj * 128, acc[ai][bj][m][0] * w, acc[ai][bj][m][1] * w); } }
  } };
struct EpiInproj1 { static constexpr bool PERM = true; bf16_t* P1; const float* lbraw;
  HD void operator()(const f32x4 (&acc)[2][2][4][2], const Unit& u, int wr, int wc, int fr, int fq) const {
#pragma unroll
    for (int ai = 0; ai < 2; ++ai)
#pragma unroll
      for (int m = 0; m < 4; ++m) { const size_t row = (size_t)u.pm * 256 + ai * 128 + wr * 64 + m * 16 + fr;
#pragma unroll
        for (int bj = 0; bj < 2; ++bj) { const int c = u.pn * 256 + bj * 128 + wc * 32 + 8 * fq; f32x4 v0 = acc[ai][bj][m][0], v1 = acc[ai][bj][m][1];
          if (u.pn < 4) { v0 = silu4(v0); v1 = silu4(v1); }
          else if (u.pn >= 12) {
#pragma unroll
            for (int i = 0; i < 4; ++i) { const int c0 = (c + i) & 1023, c1 = (c + 4 + i) & 1023;
              const float lb0 = 1.f / (1.f + expf(lbraw[c0] - lbraw[1024 + c0])), lb1 = 1.f / (1.f + expf(lbraw[c1] - lbraw[1024 + c1]));
              v0[i] = logf(lb0 + (1.f - lb0) * sigmoidf_(v0[i])); v1[i] = logf(lb1 + (1.f - lb1) * sigmoidf_(v1[i])); } }
          store_bf16x8(P1 + row * 5120 + c, v0, v1); } }
  } };

DEV void ph_gemm_inproj0(const P& p, void* lds, int bid, int G) {
  Gemm g{(const bf16_t*)(p.ws + WS_H), 1024}; DenseOrder S{TT / 256, N0P / 256, G, bid, (const bf16_t*)(p.ws + WS_WIN0)};
  EpiInproj0 E{(bf16_t*)(p.ws + WS_Z), (bf16_t*)(p.ws + WS_XR), (bf16_t*)(p.ws + WS_U), (float*)(p.ws + WS_DT), p.in[I_DTB]};
  GEMM_RUN(lds, g, S, E);
}
DEV void ph_gemm_outproj0(const P& p, void* lds, int bid, int G) {
  Gemm g{(const bf16_t*)(p.ws + WS_XR), 2048}; DenseOrder S{TT / 256, 4, G, bid, (const bf16_t*)(p.ws + WS_WOUT0)}; EpiResid E{&p, 0, true};
  GEMM_RUN(lds, g, S, E);
}
DEV void ph_gemm_moe1(const P& p, int l, void* lds, int bid, int G) {
  Gemm g{(const bf16_t*)(p.ws + WS_HS), 1024}; MoeOrder S{G, bid, (const int*)(p.ws + WS_CTL) + l * NE, (const bf16_t*)(p.ws + WS_WGU), (size_t)1024 * 1024}; EpiMoe1 E{(bf16_t*)(p.ws + WS_ACT)};
  GEMM_RUN(lds, g, S, E);
}
DEV void ph_gemm_moe2(const P& p, int l, void* lds, int bid, int G) {
  Gemm g{(const bf16_t*)(p.ws + WS_ACT), 512}; MoeOrder S{G, bid, (const int*)(p.ws + WS_CTL) + l * NE, (const bf16_t*)(p.ws + WS_WDT), (size_t)1024 * 512};
  EpiMoe2 E{(bf16_t*)(p.ws + WS_YS), (const int*)(p.ws + WS_RSLOT), (const float*)(p.ws + WS_RW)};
  GEMM_RUN(lds, g, S, E);
}
DEV void ph_gemm_inproj1(const P& p, void* lds, int bid, int G) {
  Gemm g{(const bf16_t*)(p.ws + WS_H), 1024}; Inproj1Order S{G, bid, (const bf16_t*)(p.ws + WS_WHGI)}; EpiInproj1 E{(bf16_t*)(p.ws + WS_P1), p.in[I_HGLB]};
  GEMM_RUN(lds, g, S, E);
}
DEV void ph_gemm_outproj1(const P& p, void* lds, int bid, int G) {
  Gemm g{(const bf16_t*)(p.ws + WS_H), 1024}; DenseOrder S{TL / 256, 4, G, bid, (const bf16_t*)(p.ws + WS_WHGO)}; EpiResid E{&p, 1, false};
  GEMM_RUN(lds, g, S, E);
}

HD void tok_pos(int r, int& t, int& L) { if (r < TL) { t = r % SEQ; L = SEQ; } else { t = (r - TL) % CTX; L = CTX; } }

HD void ph_conv5(const P& p, long tid, long nth) {
  const bf16_t* XR = (const bf16_t*)(p.ws + WS_XR); bf16_t* XBC = (bf16_t*)(p.ws + WS_XBC);
  for (long i = tid; i < (long)TT * 2048; i += nth) {
    const int r = (int)(i / 2048), c = (int)(i % 2048);
    int t, L; tok_pos(r, t, L);
    float acc = p.in[I_SCB][c];
#pragma unroll
    for (int k = 0; k < 5; ++k) { const int tt = t + k - 2; if (tt >= 0 && tt < L) acc += bf2f(XR[(size_t)(r + k - 2) * 2048 + c]) * p.in[I_SCW][k * 2048 + c]; }
    XBC[i] = f2bf(siluf_(acc));
  }
}

HD void ph_ssd_scan(const P& p, long tid, long nth) {
  const bf16_t* XBC = (const bf16_t*)(p.ws + WS_XBC); const float* DT = (const float*)(p.ws + WS_DT); float* Y = (float*)(p.ws + WS_Y);
  for (long it = tid; it < (long)NB * 16 * 64; it += nth) {
    const int b = (int)(it / 1024), h = (int)((it / 64) % 16), pp = (int)(it % 64), g = h / 4;
    const float Dk = p.in[I_SSDD][h];
    for (int dir = 0; dir < 2; ++dir) {
      const float a = -expf(p.in[I_ALOG][dir * 16 + h]);
      float S[128];
#pragma unroll
      for (int n = 0; n < 128; ++n) S[n] = 0.f;
      for (int s = 0; s < CTX + SEQ; ++s) {
        int r;
        if (s < CTX) r = TL + b * CTX + (dir ? CTX - 1 - s : s);
        else { const int t = s - CTX; r = b * SEQ + (dir ? SEQ - 1 - t : t); }
        const float dt = DT[(size_t)r * 32 + dir * 16 + h];
        const float xv = bf2f(XBC[(size_t)r * 2048 + h * 64 + pp]);
        const float dec = expf(dt * a), xdt = xv * dt;
        const bf16_t* Bp = XBC + (size_t)r * 2048 + 1024 + g * 128, *Cp = XBC + (size_t)r * 2048 + 1536 + g * 128;
        float y = 0.f;
#pragma unroll
        for (int c8 = 0; c8 < 16; ++c8) {
          const u32x4 bv = *(const u32x4*)(Bp + c8 * 8), cv = *(const u32x4*)(Cp + c8 * 8);
          CHUNK_FENCE();
#pragma unroll
          for (int j = 0; j < 4; ++j) {
            const unsigned bw = j == 0 ? bv.x : j == 1 ? bv.y : j == 2 ? bv.z : bv.w, cw = j == 0 ? cv.x : j == 1 ? cv.y : j == 2 ? cv.z : cv.w;
            S[c8 * 8 + 2 * j] = dec * S[c8 * 8 + 2 * j] + xdt * bflo(bw); y += S[c8 * 8 + 2 * j] * bflo(cw);
            S[c8 * 8 + 2 * j + 1] = dec * S[c8 * 8 + 2 * j + 1] + xdt * bfhi(bw); y += S[c8 * 8 + 2 * j + 1] * bfhi(cw);
          }
        }
        float* yo = Y + (size_t)r * 1024 + h * 64 + pp;
        if (dir == 0) *yo = y + Dk * xv; else *yo += y;
      }
    }
  }
}

HD void ph_ssd_readout(const P& p, long tid, long nth) {
  const float* Y = (const float*)(p.ws + WS_Y); const bf16_t* Z = (const bf16_t*)(p.ws + WS_Z); bf16_t* OC = (bf16_t*)(p.ws + WS_XR);
  const int lane = LANE;
  for (long r = tid / LW; r < TT; r += nth / LW) {
    float ss = 0.f;
    for (int k = lane; k < 1024; k += LW) { const float v = Y[(size_t)r * 1024 + k] * siluf_(bf2f(Z[(size_t)r * 1024 + k])); ss += v * v; }
    ss = wsum(ss);
    const float rstd = 1.f / sqrtf(ss / 1024.f + EPS);
    for (int k = lane; k < 1024; k += LW) { const float v = Y[(size_t)r * 1024 + k] * siluf_(bf2f(Z[(size_t)r * 1024 + k])); OC[(size_t)r * 2048 + k] = f2bf(v * rstd * p.in[I_SSDG][k]); }
  }
}
HD void ph_cf_conv(const P& p, long tid, long nth) {
  const bf16_t* U = (const bf16_t*)(p.ws + WS_U); bf16_t* CT = (bf16_t*)(p.ws + WS_H);
  for (long i = tid; i < (long)TT * 1024; i += nth) {
    const int r = (int)(i / 1024), c = (int)(i % 1024);
    int t, L;
    if (r < TL) { t = r % GW; L = GW; } else { t = (r - TL) % CTX; L = CTX; }
    float acc = p.in[I_CFB][c];
    for (int j = 0; j < 31; ++j) { const int tt = t + j - 15; if (tt >= 0 && tt < L) acc += bf2f(U[(size_t)(r + j - 15) * 1024 + c]) * p.in[I_CFW][j * 1024 + c]; }
    CT[i] = f2bf(acc);
  }
}
HD void ph_cf_ln(const P& p, long tid, long nth) {
  const bf16_t* CT = (const bf16_t*)(p.ws + WS_H); bf16_t* OC = (bf16_t*)(p.ws + WS_XR);
  const int lane = LANE;
  for (long r = tid / LW; r < TT; r += nth / LW) {
    float s = 0.f;
    for (int k = lane; k < 1024; k += LW) s += bf2f(CT[(size_t)r * 1024 + k]);
    const float mu = wsum(s) / 1024.f; float q = 0.f;
    for (int k = lane; k < 1024; k += LW) { const float d = bf2f(CT[(size_t)r * 1024 + k]) - mu; q += d * d; }
    const float rstd = 1.f / sqrtf(wsum(q) / 1024.f + EPS);
    for (int k = lane; k < 1024; k += LW) { const float v = (bf2f(CT[(size_t)r * 1024 + k]) - mu) * rstd * p.in[I_CFLG][k] + p.in[I_CFLB][k]; OC[(size_t)r * 2048 + 1024 + k] = f2bf(siluf_(v)); }
  }
}

HD void ph_hg_scan(const P& p, long tid, long nth) {
  const bf16_t* P1 = (const bf16_t*)(p.ws + WS_P1); float* O = (float*)(p.ws + WS_O);
  for (long it = tid; it < (long)NB * 8 * 128; it += nth) {
    const int b = (int)(it / 1024), h = (int)((it / 128) % 8), v = (int)(it % 128);
    for (int dir = 0; dir < 2; ++dir) {
      float S[128];
#pragma unroll
      for (int k = 0; k < 128; ++k) S[k] = 0.f;
      for (int s = 0; s < CTX + SEQ; ++s) {
        int r; const bool isctx = s < CTX;
        if (isctx) r = TL + b * CTX + (dir ? CTX - 1 - s : s);
        else { int tp = s - CTX; tp = dir ? SEQ - 1 - tp : tp; const int col = tp / ROWS, row = tp % ROWS; r = b * SEQ + row * GW + col; }
        const bf16_t* pr = P1 + (size_t)r * 5120;
        const float vv = bf2f(pr[2048 + h * 128 + v]);
        const bf16_t* lf = pr + 3072 + dir * 1024 + h * 128, *q = pr + h * 128;
        float o = 0.f;
#pragma unroll
        for (int c8 = 0; c8 < 16; ++c8) {
          const u32x4 fv = *(const u32x4*)(lf + c8 * 8), qv = *(const u32x4*)(q + c8 * 8);
          CHUNK_FENCE();
#pragma unroll
          for (int j = 0; j < 4; ++j) {
            const unsigned fw = j == 0 ? fv.x : j == 1 ? fv.y : j == 2 ? fv.z : fv.w, qw = j == 0 ? qv.x : j == 1 ? qv.y : j == 2 ? qv.z : qv.w;
            const float f0 = expf(bflo(fw)), f1 = expf(bfhi(fw));
            S[c8 * 8 + 2 * j] = f0 * S[c8 * 8 + 2 * j] + (1.f - f0) * vv; o += isctx ? 0.f : S[c8 * 8 + 2 * j] * bflo(qw);
            S[c8 * 8 + 2 * j + 1] = f1 * S[c8 * 8 + 2 * j + 1] + (1.f - f1) * vv; o += isctx ? 0.f : S[c8 * 8 + 2 * j + 1] * bfhi(qw);
          }
        }
        if (!isctx) { float* op = O + (size_t)r * 1024 + h * 128 + v; if (dir == 0) *op = o; else *op += o; }
      }
    }
  }
}
HD void ph_hg_readout(const P& p, long tid, long nth) {
  const float* O = (const float*)(p.ws + WS_O); const bf16_t* P1 = (const bf16_t*)(p.ws + WS_P1); bf16_t* RO = (bf16_t*)(p.ws + WS_H);
  for (long i = tid; i < (long)TL * 8; i += nth) {
    const int r = (int)(i / 8), h = (int)(i % 8);
    float ss = 0.f;
    for (int v = 0; v < 128; ++v) { const float o = O[(size_t)r * 1024 + h * 128 + v]; ss += o * o; }
    const float rstd = 1.f / sqrtf(ss / 128.f + EPS);
    for (int v = 0; v < 128; ++v) {
      const float o = O[(size_t)r * 1024 + h * 128 + v] * rstd * p.in[I_HGNG][v];
      RO[(size_t)r * 1024 + h * 128 + v] = f2bf(o * siluf_(bf2f(P1[(size_t)r * 5120 + 1024 + h * 128 + v])));
    }
  }
}
HD void ph_final(const P& p, long tid, long nth) {
  const bf16_t* YS = (const bf16_t*)(p.ws + WS_YS); const int lane = LANE;
  for (long r = tid / LW; r < TL; r += nth / LW) {
    float* x = p.out + (size_t)r * DM; const float* g5 = modv(p, 1, tok_modrow((int)r), 5); float ss = 0.f;
    for (int k = lane; k < DM; k += LW) { const float v = x[k] + g5[k] * (bf2f(YS[(size_t)(2 * r) * DM + k]) + bf2f(YS[(size_t)(2 * r + 1) * DM + k])); x[k] = v; ss += v * v; }
    const float rstd = 1.f / sqrtf(wsum(ss) / DM + EPS);
    for (int k = lane; k < DM; k += LW) x[k] = x[k] * rstd * p.in[I_FNG][k];
  }
}


constexpr int SSD_LD = 136, SSD_LDX = 72;
constexpr int SSD_OFF_C = 0, SSD_OFF_B = SSD_OFF_C + 128 * SSD_LD * 2, SSD_OFF_X = SSD_OFF_B + 128 * SSD_LD * 2, SSD_OFF_XW = SSD_OFF_X + 128 * SSD_LDX * 2,
              SSD_OFF_S = SSD_OFF_XW + 128 * SSD_LDX * 2, SSD_OFF_F = SSD_OFF_S + 64 * SSD_LD * 2, SSD_LDS_END = SSD_OFF_F + 520 * 4;
static_assert(SSD_LDS_END <= LDS_BYTES, "SSD LDS map");
DEV void ph_ssd_chunked(const P& p, LAS unsigned char* lds, int bid, int G) {
  const int t = tidx(), wid = t >> 6, lane = t & 63, fr = lane & 15, fq = lane >> 4;
  constexpr int LD = SSD_LD, LDX = SSD_LDX;
  LAS unsigned char* Cm = lds + SSD_OFF_C; LAS unsigned char* Bm = lds + SSD_OFF_B; LAS unsigned char* Xm = lds + SSD_OFF_X; LAS unsigned char* XWm = lds + SSD_OFF_XW; LAS unsigned char* Sb = lds + SSD_OFF_S;
  LAS float* fa = (LAS float*)(lds + SSD_OFF_F);
  const bf16_t* XBC = (const bf16_t*)(p.ws + WS_XBC); const float* DT = (const float*)(p.ws + WS_DT);
  constexpr int NCH = (CTX + SEQ) / 128;
  for (int u = bid; u < NB * 32; u += G) {
    const int b = u >> 5, d = (u >> 4) & 1, h = u & 15, g = h >> 2, sgn = d ? -1 : 1;
    const float a = -expf(p.in[I_ALOG][d * 16 + h]), Dk = p.in[I_SSDD][h];
    bf16_t* Yd = (bf16_t*)(p.ws + WS_Y) + (size_t)d * TT * 1024;
    f32x4 ST[2][2];
#pragma unroll
    for (int i = 0; i < 2; ++i)
#pragma unroll
      for (int j = 0; j < 2; ++j) ST[i][j] = (f32x4){0.f, 0.f, 0.f, 0.f};
    blk_sync();
    for (int i = t; i < 64 * LD / 2; i += NT) ((LAS unsigned*)Sb)[i] = 0u;
    for (int c = 0; c < NCH; ++c) {
      const int s0 = c * 128;
      const int r0 = s0 < CTX ? TL + b * CTX + (d ? CTX - 1 - s0 : s0) : b * SEQ + (d ? SEQ - 1 - (s0 - CTX) : (s0 - CTX));
      u32x4 xv[2];
#pragma unroll
      for (int i = 0; i < 4; ++i) { const int v = t + NT * i, row = v >> 4, c16 = v & 15; const bf16_t* src = XBC + (size_t)(r0 + sgn * row) * 2048 + g * 128 + c16 * 8;
        *(LAS u32x4*)(Cm + row * LD * 2 + c16 * 16) = *(const u32x4*)(src + 1536); *(LAS u32x4*)(Bm + row * LD * 2 + c16 * 16) = *(const u32x4*)(src + 1024); }
#pragma unroll
      for (int i = 0; i < 2; ++i) { const int v = t + NT * i, row = v >> 3, c8 = v & 7; xv[i] = *(const u32x4*)(XBC + (size_t)(r0 + sgn * row) * 2048 + h * 64 + c8 * 8);
        *(LAS u32x4*)(Xm + row * LDX * 2 + c8 * 16) = xv[i]; }
      if (wid == 0) {
        const int j0 = 2 * lane; const float dt0 = DT[(size_t)(r0 + sgn * j0) * 32 + d * 16 + h], dt1 = DT[(size_t)(r0 + sgn * (j0 + 1)) * 32 + d * 16 + h];
        const float la0 = dt0 * a, la1 = dt1 * a; float ps = la0 + la1;
#pragma unroll
        for (int o = 1; o < 64; o <<= 1) { const float n = wshfl(ps, lane - o); if (lane >= o) ps += n; }
        const float end = wshfl(ps, 63), ac0 = ps - la1, ac1 = ps;
        fa[j0] = dt0; fa[j0 + 1] = dt1; fa[128 + j0] = ac0; fa[129 + j0] = ac1; fa[256 + j0] = dt0 * expf(end - ac0); fa[257 + j0] = dt1 * expf(end - ac1);
        fa[384 + j0] = expf(ac0); fa[385 + j0] = expf(ac1); if (lane == 0) fa[512] = expf(end);
      }
      blk_sync();
#pragma unroll
      for (int i = 0; i < 2; ++i) { const int v = t + NT * i, row = v >> 3, c8 = v & 7; const float w = fa[256 + row]; u32x4 o;
        o.x = pk2(bflo(xv[i].x) * w, bfhi(xv[i].x) * w); o.y = pk2(bflo(xv[i].y) * w, bfhi(xv[i].y) * w); o.z = pk2(bflo(xv[i].z) * w, bfhi(xv[i].z) * w); o.w = pk2(bflo(xv[i].w) * w, bfhi(xv[i].w) * w);
        *(LAS u32x4*)(XWm + row * LDX * 2 + c8 * 16) = o; }
      const int I1 = wid & 3, J1 = wid >> 2;
      f32x4 cb[2][4];
#pragma unroll
      for (int i = 0; i < 2; ++i)
#pragma unroll
        for (int j = 0; j < 4; ++j) cb[i][j] = (f32x4){0.f, 0.f, 0.f, 0.f};
      if (2 * I1 <= ((4 * J1 + 3) | 1)) {
#pragma unroll
        for (int q = 0; q < 4; ++q) {
          bf16x8 af[2], bfm[4];
#pragma unroll
          for (int i = 0; i < 2; ++i) af[i] = frag_row(Bm, LD, 16 * (2 * I1 + i), 32 * q, lane);
#pragma unroll
          for (int j = 0; j < 4; ++j) bfm[j] = frag_row(Cm, LD, 16 * (4 * J1 + j), 32 * q, lane);
#pragma unroll
          for (int i = 0; i < 2; ++i)
#pragma unroll
            for (int j = 0; j < 4; ++j) if (2 * I1 + i <= ((4 * J1 + j) | 1)) cb[i][j] = mfma16(af[i], bfm[j], cb[i][j]);
        }
      }
      blk_sync();
      const int NI = wid & 3, PJ = wid >> 2;
      { const float dec = fa[512];
#pragma unroll
        for (int i = 0; i < 2; ++i)
#pragma unroll
          for (int j = 0; j < 2; ++j) ST[i][j] *= dec;
#pragma unroll
        for (int q = 0; q < 4; ++q) {
          bf16x8 af[2], bfm[2];
#pragma unroll
          for (int i = 0; i < 2; ++i) af[i] = frag_tr(Bm, LD, 16 * (2 * NI + i), 32 * q, lane);
#pragma unroll
          for (int j = 0; j < 2; ++j) bfm[j] = frag_tr(XWm, LDX, 16 * (2 * PJ + j), 32 * q, lane);
#pragma unroll
          for (int i = 0; i < 2; ++i)
#pragma unroll
            for (int j = 0; j < 2; ++j) ST[i][j] = mfma16(af[i], bfm[j], ST[i][j]);
        }
      }
      blk_sync();
#pragma unroll
      for (int i = 0; i < 2; ++i)
#pragma unroll
        for (int j = 0; j < 4; ++j) if (2 * I1 + i <= ((4 * J1 + j) | 1)) {
          const int s = 16 * (2 * I1 + i) + 4 * fq, l = 16 * (4 * J1 + j) + fr; const float al = fa[128 + l];
          const f32x4 as = *(const LAS f32x4*)(fa + 128 + s), ds = *(const LAS f32x4*)(fa + s); f32x4 m;
#pragma unroll
          for (int e = 0; e < 4; ++e) m[e] = (s + e <= l) ? cb[i][j][e] * expf(al - as[e]) * ds[e] : 0.f;
          lds_store_bf16x4(Bm + (l * LD + s) * 2, m);
        }
      blk_sync();
      { const int PI = wid & 1, JJ = wid >> 1;
        f32x4 yd[2][2], yo[2][2];
#pragma unroll
        for (int i = 0; i < 2; ++i)
#pragma unroll
          for (int j = 0; j < 2; ++j) { yd[i][j] = (f32x4){0.f, 0.f, 0.f, 0.f}; yo[i][j] = (f32x4){0.f, 0.f, 0.f, 0.f}; }
        for (int q = 0; q <= JJ; ++q) {
          bf16x8 af[2], bfm[2];
#pragma unroll
          for (int i = 0; i < 2; ++i) af[i] = frag_tr(Xm, LDX, 16 * (2 * PI + i), 32 * q, lane);
#pragma unroll
          for (int j = 0; j < 2; ++j) bfm[j] = frag_row(Bm, LD, 16 * (2 * JJ + j), 32 * q, lane);
#pragma unroll
          for (int i = 0; i < 2; ++i)
#pragma unroll
            for (int j = 0; j < 2; ++j) yd[i][j] = mfma16(af[i], bfm[j], yd[i][j]);
        }
#pragma unroll
        for (int q = 0; q < 4; ++q) {
          bf16x8 af[2], bfm[2];
#pragma unroll
          for (int i = 0; i < 2; ++i) af[i] = frag_row(Sb, LD, 16 * (2 * PI + i), 32 * q, lane);
#pragma unroll
          for (int j = 0; j < 2; ++j) bfm[j] = frag_row(Cm, LD, 16 * (2 * JJ + j), 32 * q, lane);
#pragma unroll
          for (int i = 0; i < 2; ++i)
#pragma unroll
            for (int j = 0; j < 2; ++j) yo[i][j] = mfma16(af[i], bfm[j], yo[i][j]);
        }
#pragma unroll
        for (int i = 0; i < 2; ++i)
#pragma unroll
          for (int j = 0; j < 2; ++j) { const int pb = 16 * (2 * PI + i) + 4 * fq, l = 16 * (2 * JJ + j) + fr; const float e = fa[384 + l];
            f32x4 y = yd[i][j] + yo[i][j] * e;
            if (d == 0) { const u32x2 xs = *(const LAS u32x2*)(Xm + (l * LDX + pb) * 2); y += (f32x4){bflo(xs.x), bfhi(xs.x), bflo(xs.y), bfhi(xs.y)} * Dk; }
            u32x2 o; o.x = pk2(y[0], y[1]); o.y = pk2(y[2], y[3]); *(u32x2*)(Yd + (size_t)(r0 + sgn * l) * 1024 + h * 64 + pb) = o; }
      }
      blk_sync();
#pragma unroll
      for (int i = 0; i < 2; ++i)
#pragma unroll
        for (int j = 0; j < 2; ++j) lds_store_bf16x4(Sb + ((16 * (2 * PJ + j) + fr) * LD + 16 * (2 * NI + i) + 4 * fq) * 2, ST[i][j]);
    }
  }
}
HD void ph_ssd_readout2(const P& p, long tid, long nth) {
  const bf16_t* Y0 = (const bf16_t*)(p.ws + WS_Y); const bf16_t* Y1 = Y0 + (size_t)TT * 1024; const bf16_t* Z = (const bf16_t*)(p.ws + WS_Z); bf16_t* OC = (bf16_t*)(p.ws + WS_XR);
  const int lane = LANE;
  for (long r = tid / LW; r < TT; r += nth / LW) {
    float ss = 0.f;
    for (int k = lane; k < 1024; k += LW) { const float v = (bf2f(Y0[(size_t)r * 1024 + k]) + bf2f(Y1[(size_t)r * 1024 + k])) * siluf_(bf2f(Z[(size_t)r * 1024 + k])); ss += v * v; }
    ss = wsum(ss);
    const float rstd = 1.f / sqrtf(ss / 1024.f + EPS);
    for (int k = lane; k < 1024; k += LW) { const float v = (bf2f(Y0[(size_t)r * 1024 + k]) + bf2f(Y1[(size_t)r * 1024 + k])) * siluf_(bf2f(Z[(size_t)r * 1024 + k])); OC[(size_t)r * 2048 + k] = f2bf(v * rstd * p.in[I_SSDG][k]); }
  }
}


constexpr int HG_LD = 136, HG_LDV = 72;
constexpr int HG_OFF_G = 0, HG_OFF_QR = HG_OFF_G + 64 * 128 * 4, HG_OFF_KR = HG_OFF_QR + 64 * HG_LD * 2, HG_OFF_QG = HG_OFF_KR + 64 * HG_LD * 2, HG_OFF_KE = HG_OFF_QG + 64 * HG_LD * 2,
              HG_OFF_V = HG_OFF_KE + 64 * HG_LD * 2, HG_OFF_AT = HG_OFF_V + 64 * HG_LDV * 2, HG_OFF_S = HG_OFF_AT + 64 * HG_LDV * 2, HG_LDS_END = HG_OFF_S + 64 * HG_LD * 2;
static_assert(HG_LDS_END <= LDS_BYTES, "HGRN2 LDS map");
HD int hg_row(int b, int d, int s) { if (s < CTX) return TL + b * CTX + (d ? CTX - 1 - s : s); int tp = s - CTX; if (d) tp = SEQ - 1 - tp; return b * SEQ + (tp % ROWS) * GW + tp / ROWS; }
DEV void ph_hg_chunked(const P& p, LAS unsigned char* lds, int bid, int G) {
  const int t = tidx(), wid = t >> 6, lane = t & 63, fr = lane & 15, fq = lane >> 4;
  constexpr int LD = HG_LD, LDV = HG_LDV;
  LAS float* Gm = (LAS float*)(lds + HG_OFF_G); LAS unsigned char* QRm = lds + HG_OFF_QR; LAS unsigned char* KRm = lds + HG_OFF_KR; LAS unsigned char* QGm = lds + HG_OFF_QG; LAS unsigned char* KEm = lds + HG_OFF_KE;
  LAS unsigned char* Vm = lds + HG_OFF_V; LAS unsigned char* ATm = lds + HG_OFF_AT; LAS unsigned char* Sb = lds + HG_OFF_S; LAS float* PT = (LAS float*)ATm;
  const bf16_t* P1 = (const bf16_t*)(p.ws + WS_P1);
  constexpr int NCH = (CTX + SEQ) / 64;
  for (int u = bid; u < NB * 32; u += G) {
    const int b = u >> 5, d = (u >> 4) & 1, h = (u >> 1) & 7, vh = u & 1;
    bf16_t* Od = (bf16_t*)(p.ws + WS_O) + (size_t)d * TL * 1024;
    f32x4 ST[2][2];
#pragma unroll
    for (int i = 0; i < 2; ++i)
#pragma unroll
      for (int j = 0; j < 2; ++j) ST[i][j] = (f32x4){0.f, 0.f, 0.f, 0.f};
    blk_sync();
    for (int i = t; i < 64 * LD / 2; i += NT) ((LAS unsigned*)Sb)[i] = 0u;
    for (int c = 0; c < NCH; ++c) {
      const bool lat = c * 64 >= CTX;
      u32x4 lfv[2], qv[2];
#pragma unroll
      for (int i = 0; i < 2; ++i) { const int v = t + NT * i, j = v >> 4, c16 = v & 15; const bf16_t* src = P1 + (size_t)hg_row(b, d, c * 64 + j) * 5120 + h * 128 + c16 * 8;
        lfv[i] = *(const u32x4*)(src + 3072 + d * 1024); qv[i] = lat ? *(const u32x4*)src : (u32x4){0u, 0u, 0u, 0u};
        LAS float* gp = Gm + j * 128 + c16 * 8;
        *(LAS f32x4*)gp = (f32x4){bflo(lfv[i].x), bfhi(lfv[i].x), bflo(lfv[i].y), bfhi(lfv[i].y)}; *(LAS f32x4*)(gp + 4) = (f32x4){bflo(lfv[i].z), bfhi(lfv[i].z), bflo(lfv[i].w), bfhi(lfv[i].w)}; }
      { const int j = t >> 3, c8 = t & 7; *(LAS u32x4*)(Vm + (j * LDV + c8 * 8) * 2) = *(const u32x4*)(P1 + (size_t)hg_row(b, d, c * 64 + j) * 5120 + 2048 + h * 128 + vh * 64 + c8 * 8); }
      blk_sync();
      { const int k = t & 127, part = t >> 7; float run = 0.f;
#pragma unroll
        for (int j = 0; j < 16; ++j) { run += Gm[(part * 16 + j) * 128 + k]; Gm[(part * 16 + j) * 128 + k] = run; }
        PT[part * 128 + k] = run;
        blk_sync();
        float pre = 0.f;
#pragma unroll
        for (int q = 0; q < 3; ++q) if (q < part) pre += PT[q * 128 + k];
        if (part > 0) {
#pragma unroll
          for (int j = 0; j < 16; ++j) Gm[(part * 16 + j) * 128 + k] += pre; }
      }
      blk_sync();
#pragma unroll
      for (int i = 0; i < 2; ++i) { const int v = t + NT * i, j = v >> 4, c16 = v & 15; f32x4 qr[2], kr[2], qg[2], ke[2];
#pragma unroll
        for (int hh = 0; hh < 2; ++hh) { const int k0 = c16 * 8 + hh * 4;
          const f32x4 gc = *(const LAS f32x4*)(Gm + j * 128 + k0), gm = *(const LAS f32x4*)(Gm + 31 * 128 + k0), ge = *(const LAS f32x4*)(Gm + 63 * 128 + k0);
          const unsigned lw0 = hh ? lfv[i].z : lfv[i].x, lw1 = hh ? lfv[i].w : lfv[i].y, qw0 = hh ? qv[i].z : qv[i].x, qw1 = hh ? qv[i].w : qv[i].y;
          const f32x4 lf4 = (f32x4){bflo(lw0), bfhi(lw0), bflo(lw1), bfhi(lw1)}, q4 = (f32x4){bflo(qw0), bfhi(qw0), bflo(qw1), bfhi(qw1)};
#pragma unroll
          for (int e = 0; e < 4; ++e) { const float kk = 1.f - expf(lf4[e]), e1 = expf(gc[e] - gm[e]);
            qr[hh][e] = q4[e] * e1; kr[hh][e] = kk / e1; qg[hh][e] = qr[hh][e] * expf(gm[e]); ke[hh][e] = kk * expf(ge[e] - gc[e]); } }
        const int off = (j * LD + c16 * 8) * 2;
        store_lds8(QRm + off, qr[0], qr[1]); store_lds8(KRm + off, kr[0], kr[1]); store_lds8(QGm + off, qg[0], qg[1]); store_lds8(KEm + off, ke[0], ke[1]); }
      blk_sync();
      const int TI = wid & 3, TJ = wid >> 2;
      if (lat && TI <= ((2 * TJ + 1) | 1)) {
        f32x4 at[2] = {(f32x4){0.f, 0.f, 0.f, 0.f}, (f32x4){0.f, 0.f, 0.f, 0.f}};
#pragma unroll
        for (int q = 0; q < 4; ++q) { const bf16x8 af = frag_row(KRm, LD, 16 * TI, 32 * q, lane);
#pragma unroll
          for (int j = 0; j < 2; ++j) at[j] = mfma16(af, frag_row(QRm, LD, 16 * (2 * TJ + j), 32 * q, lane), at[j]); }
#pragma unroll
        for (int j = 0; j < 2; ++j) { const int s = 16 * TI + 4 * fq, l = 16 * (2 * TJ + j) + fr; f32x4 m;
#pragma unroll
          for (int e = 0; e < 4; ++e) m[e] = (s + e <= l) ? at[j][e] : 0.f;
          lds_store_bf16x4(ATm + (l * LDV + s) * 2, m); }
      }
      const int KI = wid & 3, VJ = wid >> 2;
      f32x4 SN[2][2];
#pragma unroll
      for (int i = 0; i < 2; ++i) { const f32x4 ge = *(const LAS f32x4*)(Gm + 63 * 128 + 16 * (2 * KI + i) + 4 * fq); const f32x4 dec = (f32x4){expf(ge[0]), expf(ge[1]), expf(ge[2]), expf(ge[3])};
#pragma unroll
        for (int j = 0; j < 2; ++j) SN[i][j] = ST[i][j] * dec; }
#pragma unroll
      for (int q = 0; q < 2; ++q) { bf16x8 af[2], bfm[2];
#pragma unroll
        for (int i = 0; i < 2; ++i) af[i] = frag_tr(KEm, LD, 16 * (2 * KI + i), 32 * q, lane);
#pragma unroll
        for (int j = 0; j < 2; ++j) bfm[j] = frag_tr(Vm, LDV, 16 * (2 * VJ + j), 32 * q, lane);
#pragma unroll
        for (int i = 0; i < 2; ++i)
#pragma unroll
          for (int j = 0; j < 2; ++j) SN[i][j] = mfma16(af[i], bfm[j], SN[i][j]); }
#pragma unroll
      for (int i = 0; i < 2; ++i)
#pragma unroll
        for (int j = 0; j < 2; ++j) ST[i][j] = SN[i][j];
      blk_sync();
      if (lat) { const int VI = wid & 3; f32x4 o[2] = {(f32x4){0.f, 0.f, 0.f, 0.f}, (f32x4){0.f, 0.f, 0.f, 0.f}};
        for (int q = 0; q <= TJ; ++q) { const bf16x8 af = frag_tr(Vm, LDV, 16 * VI, 32 * q, lane);
#pragma unroll
          for (int j = 0; j < 2; ++j) o[j] = mfma16(af, frag_row(ATm, LDV, 16 * (2 * TJ + j), 32 * q, lane), o[j]); }
#pragma unroll
        for (int q = 0; q < 4; ++q) { const bf16x8 af = frag_row(Sb, LD, 16 * VI, 32 * q, lane);
#pragma unroll
          for (int j = 0; j < 2; ++j) o[j] = mfma16(af, frag_row(QGm, LD, 16 * (2 * TJ + j), 32 * q, lane), o[j]); }
#pragma unroll
        for (int j = 0; j < 2; ++j) { const int l = 16 * (2 * TJ + j) + fr; u32x2 w; w.x = pk2(o[j][0], o[j][1]); w.y = pk2(o[j][2], o[j][3]);
          *(u32x2*)(Od + (size_t)hg_row(b, d, c * 64 + l) * 1024 + h * 128 + vh * 64 + 16 * VI + 4 * fq) = w; }
      }
      blk_sync();
#pragma unroll
      for (int i = 0; i < 2; ++i)
#pragma unroll
        for (int j = 0; j < 2; ++j) lds_store_bf16x4(Sb + ((16 * (2 * VJ + j) + fr) * LD + 16 * (2 * KI + i) + 4 * fq) * 2, ST[i][j]);
    }
  }
}
HD void ph_hg_readout2(const P& p, long tid, long nth) {
  const bf16_t* O0 = (const bf16_t*)(p.ws + WS_O); const bf16_t* O1 = O0 + (size_t)TL * 1024; const bf16_t* P1 = (const bf16_t*)(p.ws + WS_P1); bf16_t* RO = (bf16_t*)(p.ws + WS_H);
  for (long i = tid; i < (long)TL * 8; i += nth) {
    const int r = (int)(i / 8), h = (int)(i % 8);
    float ss = 0.f;
    for (int v = 0; v < 128; ++v) { const float o = bf2f(O0[(size_t)r * 1024 + h * 128 + v]) + bf2f(O1[(size_t)r * 1024 + h * 128 + v]); ss += o * o; }
    const float rstd = 1.f / sqrtf(ss / 128.f + EPS);
    for (int v = 0; v < 128; ++v) {
      const float o = (bf2f(O0[(size_t)r * 1024 + h * 128 + v]) + bf2f(O1[(size_t)r * 1024 + h * 128 + v])) * rstd * p.in[I_HGNG][v];
      RO[(size_t)r * 1024 + h * 128 + v] = f2bf(o * siluf_(bf2f(P1[(size_t)r * 5120 + 1024 + h * 128 + v])));
    }
  }
}

#define PROGRAM(T, B, SYNC) \
  T(ph_mod(p, tid, nth)) T(ph_convert_dense(p, tid, nth)) SYNC \
  T(ph_norm(p, 0, 0, true, TT, -1, -1, tid, nth)) SYNC \
  B(ph_gemm_inproj0(p, lds, bid, G)) SYNC \
  T(ph_conv5(p, tid, nth)) SYNC \
  B(ph_ssd_chunked(p, LDSP, bid, G)) T(ph_cf_conv(p, tid, nth)) SYNC \
  T(ph_ssd_readout2(p, tid, nth)) T(ph_cf_ln(p, tid, nth)) SYNC \
  B(ph_gemm_outproj0(p, lds, bid, G)) SYNC \
  T(ph_norm(p, 0, 3, false, TT, -1, 0, tid, nth)) T(ph_convert_moe(p, 0, tid, nth)) SYNC \
  T(ph_moe_gather(p, 0, TT, tid, nth)) SYNC \
  B(ph_gemm_moe1(p, 0, lds, bid, G)) SYNC \
  B(ph_gemm_moe2(p, 0, lds, bid, G)) SYNC \
  T(ph_norm(p, 1, 0, false, TT, 0, -1, tid, nth)) SYNC \
  B(ph_gemm_inproj1(p, lds, bid, G)) SYNC \
  B(ph_hg_chunked(p, LDSP, bid, G)) SYNC \
  T(ph_hg_readout2(p, tid, nth)) SYNC \
  B(ph_gemm_outproj1(p, lds, bid, G)) SYNC \
  T(ph_norm(p, 1, 3, false, TL, -1, 1, tid, nth)) T(ph_convert_moe(p, 1, tid, nth)) SYNC \
  T(ph_moe_gather(p, 1, TL, tid, nth)) SYNC \
  B(ph_gemm_moe1(p, 1, lds, bid, G)) SYNC \
  B(ph_gemm_moe2(p, 1, lds, bid, G)) SYNC \
  T(ph_final(p, tid, nth))

#ifndef CPU_TEST
__global__ void __launch_bounds__(NT) mega(P p) {
  extern __shared__ __attribute__((aligned(16))) unsigned char lds[];
  cg::grid_group grid = cg::this_grid();
  const long nth = (long)gridDim.x * NT;
  const int bid = blockIdx.x, G = gridDim.x;
#define LDSP ((LAS unsigned char*)lds)
#define T_(stmt_) { const long tid = (long)blockIdx.x * NT + tidx(); stmt_; }
#define B_(stmt_) stmt_;
#define S_ grid.sync();
  PROGRAM(T_, B_, S_)
}

extern "C" void kernel_launch(void* const* d_in, const int* in_sizes, int n_in, void* d_out, int out_size,
                              void* d_ws, size_t ws_size, hipStream_t stream) {
  static int grid_blocks = 0;
  if (!grid_blocks) {
    int dev = 0, cus = 0, per_cu = 0;
    (void)hipGetDevice(&dev);
    (void)hipDeviceGetAttribute(&cus, hipDeviceAttributeMultiprocessorCount, dev);
    (void)hipFuncSetAttribute((const void*)mega, hipFuncAttributeMaxDynamicSharedMemorySize, LDS_BYTES);
    (void)hipOccupancyMaxActiveBlocksPerMultiprocessor(&per_cu, (const void*)mega, NT, LDS_BYTES);
    if (per_cu < 1) per_cu = 1;
    grid_blocks = cus * per_cu;
    if (n_in != N_IN || out_size != TL * DM || ws_size < WS_NEED) { fprintf(stderr, "kernel_launch: bad sizes n_in=%d out=%d ws=%zu need=%zu\n", n_in, out_size, ws_size, (size_t)WS_NEED); grid_blocks = -1; }
  }
  if (grid_blocks < 0) return;
  P p{};
  for (int i = 0; i < N_IN; ++i) p.in[i] = (const float*)d_in[i];
  p.out = (float*)d_out; p.ws = (unsigned char*)d_ws;
  void* args[] = {&p};
  hipError_t e = hipLaunchCooperativeKernel((const void*)mega, dim3(grid_blocks), dim3(NT), args, LDS_BYTES, stream);
  if (e != hipSuccess) fprintf(stderr, "cooperative launch failed: %s (grid %d)\n", hipGetErrorString(e), grid_blocks);
}
#endif
```

```cpp
#ifndef CPU_TEST
#include <hip/hip_runtime.h>
#include <hip/hip_cooperative_groups.h>
namespace cg = cooperative_groups;
#define HD __host__ __device__ __forceinline__
#define DEV __device__ __forceinline__
#else
#define HD inline
#define DEV inline
#endif
#include <cstdio>
#include <cstdint>
#include <cmath>

#ifndef CFG_B
#define CFG_B 8
#define CFG_SEQ 2048
#define CFG_CTX 256
#endif
constexpr int NB = CFG_B, SEQ = CFG_SEQ, CTX = CFG_CTX, DM = 1024, GW = 64, ROWS = SEQ / GW;
constexpr int TL = NB * SEQ, TC = NB * CTX, TT = TL + TC;
constexpr int AB_IN = 5152, HG_IN = 5120, NE = 16, DE = 512;
constexpr float EPS = 1e-6f;
constexpr int NT = 512;
constexpr int LDS_BYTES = 147456;
static_assert(SEQ % 256 == 0 && CTX % 256 == 0, "token tiles of 256 must not straddle sequences");

typedef unsigned short bf16_t;
typedef float f32x4 __attribute__((ext_vector_type(4)));
typedef unsigned u32x4 __attribute__((ext_vector_type(4)));
HD float bf2f(bf16_t h) { unsigned u = (unsigned)h << 16; return __builtin_bit_cast(float, u); }
HD unsigned f2bfu(float f) { unsigned u = __builtin_bit_cast(unsigned, f); return (u + 0x7fffu + ((u >> 16) & 1u)) >> 16; }
HD bf16_t f2bf(float f) { return (bf16_t)f2bfu(f); }
#if defined(__HIP_DEVICE_COMPILE__)
typedef float f32x2_t __attribute__((ext_vector_type(2)));
typedef __bf16 bf16x2_t __attribute__((ext_vector_type(2)));
DEV unsigned pk2(float lo, float hi) { return __builtin_bit_cast(unsigned, __builtin_convertvector((f32x2_t){lo, hi}, bf16x2_t)); }
#else
HD unsigned pk2(float lo, float hi) { return f2bfu(lo) | (f2bfu(hi) << 16); }
#endif
HD float bflo(unsigned w) { return __builtin_bit_cast(float, w << 16); }
HD float bfhi(unsigned w) { return __builtin_bit_cast(float, w & 0xffff0000u); }
HD f32x4 bf4lo(u32x4 v) { return (f32x4){bflo(v.x), bfhi(v.x), bflo(v.y), bfhi(v.y)}; }
HD f32x4 bf4hi(u32x4 v) { return (f32x4){bflo(v.z), bfhi(v.z), bflo(v.w), bfhi(v.w)}; }
HD void store_bf16x8(bf16_t* dst, f32x4 a, f32x4 b) { u32x4 w; w.x = pk2(a[0], a[1]); w.y = pk2(a[2], a[3]); w.z = pk2(b[0], b[1]); w.w = pk2(b[2], b[3]); *(u32x4*)dst = w; }
#ifndef CPU_TEST
#define CHUNK_FENCE() asm volatile("" ::: "memory")
#define OPAQUE_INT(v) asm volatile("" : "+v"(v))
#define OPAQUE_ACC8(k, a0, a1, a2, a3, a4, a5, a6, a7) asm volatile("" : "+v"(k), "+v"(a0), "+v"(a1), "+v"(a2), "+v"(a3), "+v"(a4), "+v"(a5), "+v"(a6), "+v"(a7))
constexpr int LW = 64;
DEV int tidx() { int t = threadIdx.x; asm volatile("" : "+v"(t)); return t; }
#define LANE (tidx() & 63)
DEV float wsum(float v) { for (int o = 32; o; o >>= 1) v += __shfl_xor(v, o); return v; }
DEV float gsum16(float v) { for (int o = 8; o; o >>= 1) v += __shfl_xor(v, o); return v; }
DEV int atomic_inc_int(int* p) { return atomicAdd(p, 1); }
#else
inline int tidx() { return emu_tid(); }
#define CHUNK_FENCE()
#define OPAQUE_INT(v)
#define OPAQUE_ACC8(k, a0, a1, a2, a3, a4, a5, a6, a7)
constexpr int LW = 1;
#define LANE 0
inline float wsum(float v) { return v; }
inline float gsum16(float v) { return v; }
inline int atomic_inc_int(int* p) { return __atomic_fetch_add(p, 1, __ATOMIC_RELAXED); }
inline int atomicAdd(int* p, int v) { return __atomic_fetch_add(p, v, __ATOMIC_RELAXED); }
#endif
#if defined(__HIP_DEVICE_COMPILE__)
DEV float fexp(float x) { return __expf(x); }
DEV float flog(float x) { return __logf(x); }
DEV float fdiv(float a, float b) { return a * __builtin_amdgcn_rcpf(b); }
DEV float frsqrt(float x) { return __builtin_amdgcn_rsqf(x); }
#else
HD float fexp(float x) { return expf(x); }
HD float flog(float x) { return logf(x); }
HD float fdiv(float a, float b) { return a / b; }
HD float frsqrt(float x) { return 1.f / sqrtf(x); }
#endif
HD float sigmoidf_(float x) { return fdiv(1.f, 1.f + fexp(-x)); }
HD float siluf_(float x) { return fdiv(x, 1.f + fexp(-x)); }
HD float softplusf_(float x) { return x > 20.f ? x : flog(1.f + fexp(x)); }

enum { I_X, I_C, I_CTX, I_CCTX, I_MODW, I_MODB, I_NMIXG, I_NFFNG, I_RW, I_RB, I_WG, I_WU, I_WD, I_ABIN, I_SCW, I_SCB, I_DTB, I_ALOG, I_SSDD, I_SSDG,
       I_CFW, I_CFB, I_CFLG, I_CFLB, I_ABOUT, I_HGIN, I_HGLB, I_HGNG, I_HGOUT, I_FNG, N_IN };

constexpr size_t al256(size_t x) { return (x + 255) & ~(size_t)255; }
constexpr int NROWS_MAX = 2 * TT + NE * 256;
constexpr int N0P = 5376;
constexpr size_t WS_CTL = 0;
constexpr size_t WS_BAR = 1024;
constexpr size_t WS_LB = 16384;
constexpr size_t WS_MODV = 16384 + 4096;
constexpr size_t WS_DT = al256(WS_MODV + (size_t)2 * (NB + 1) * 6144 * 4);
constexpr size_t WS_XC = al256(WS_DT + (size_t)TT * 32 * 4);
constexpr size_t WS_EIDX = al256(WS_XC + (size_t)TC * DM * 4);
constexpr size_t WS_EW = al256(WS_EIDX + (size_t)TT * 2 * 4);
constexpr size_t WS_EPOS = al256(WS_EW + (size_t)TT * 2 * 4);
constexpr int MOE_CAP = TT;
constexpr size_t WS_RSLOT = al256(WS_EPOS + (size_t)TT * 2 * 4);
constexpr size_t WS_RW = al256(WS_RSLOT + (size_t)NE * MOE_CAP * 4);
constexpr size_t WS_WIN0 = al256(WS_RW + (size_t)NE * MOE_CAP * 4);
constexpr size_t WS_WOUT0 = al256(WS_WIN0 + (size_t)N0P * 1024 * 2);
constexpr size_t WS_WHGI = al256(WS_WOUT0 + (size_t)1024 * 2048 * 2);
constexpr size_t WS_WHGO = al256(WS_WHGI + (size_t)5120 * 1024 * 2);
constexpr size_t WS_H = al256(WS_WHGO + (size_t)1024 * 1024 * 2);
constexpr size_t WS_R = al256(WS_H + (size_t)TT * DM * 2);
constexpr size_t WS_Z = WS_R;
constexpr size_t WS_XR = al256(WS_Z + (size_t)TT * 1024 * 2);
constexpr size_t WS_U = al256(WS_XR + (size_t)TT * 2048 * 2);
constexpr size_t WS_XBC = al256(WS_U + (size_t)TT * 1024 * 2);
constexpr size_t WS_Y = al256(WS_XBC + (size_t)TT * 2048 * 2);
constexpr size_t WS_END0 = al256(WS_Y + (size_t)TT * 1024 * 4);
constexpr size_t WS_ACT = WS_R;
constexpr size_t WS_WGU = WS_XBC > al256(WS_ACT + (size_t)NROWS_MAX * 512 * 2) ? WS_XBC : al256(WS_ACT + (size_t)NROWS_MAX * 512 * 2);
constexpr size_t WS_WDT = al256(WS_WGU + (size_t)NE * 1024 * 1024 * 2);
constexpr size_t WS_YS = al256(WS_WDT + (size_t)NE * 1024 * 512 * 2);
constexpr size_t WS_ENDM = al256(WS_YS + (size_t)2 * TT * 1024 * 2);
static_assert(WS_ACT + (size_t)NROWS_MAX * 512 * 2 <= WS_WGU && (CFG_B != 8 || WS_WGU == WS_XBC), "MoE map");
constexpr size_t WS_P1 = WS_R;
constexpr size_t WS_O = al256(WS_P1 + (size_t)TT * 5120 * 2);
constexpr size_t WS_END1 = al256(WS_O + (size_t)TL * 1024 * 4);
constexpr size_t cmax(size_t a, size_t b) { return a > b ? a : b; }
constexpr size_t WS_NEED = cmax(WS_END0, cmax(WS_ENDM, WS_END1));
static_assert(WS_YS >= WS_O || true, "");

struct P { const float* in[N_IN]; float* out; unsigned char* ws; };

HD int tok_modrow(int r) { return r < TL ? r / SEQ : NB; }
HD const float* xin_row(const P& p, int r) { return r < TL ? p.in[I_X] + (size_t)r * DM : p.in[I_CTX] + (size_t)(r - TL) * DM; }
HD float* xcur_row(const P& p, int r) { return r < TL ? p.out + (size_t)r * DM : (float*)(p.ws + WS_XC) + (size_t)(r - TL) * DM; }
HD const float* modv(const P& p, int l, int row, int m) { return (const float*)(p.ws + WS_MODV) + ((size_t)(l * (NB + 1) + row) * 6 + m) * DM; }

struct SrcWin0 { const float* W; HD const float* operator()(int n) const {
    if (n < 3072) return W + n;
    if (n < 5120) { const int m = n - 3072, t = m >> 8, w = m & 255; return w < 128 ? W + 3104 + t * 128 + w : W + 4128 + t * 128 + (w - 128); }
    if (n < 5152) return W + 3072 + (n - 5120);
    return nullptr; } };
struct SrcId { const float* W; HD const float* operator()(int n) const { return W + n; } };
struct SrcGU { const float* Wg; const float* Wu; HD const float* operator()(int n) const { const int t = n >> 8, w = n & 255; return w < 128 ? Wg + t * 128 + w : Wu + t * 128 + (w - 128); } };


HD int moe_base(const int* CNT, int e) { int b = 0; for (int i = 0; i < NE; ++i) if (i < e) b += (CNT[i] + 255) & ~255; return b; }

typedef short bf16x8 __attribute__((ext_vector_type(8)));
typedef short s16x4 __attribute__((ext_vector_type(4)));
typedef unsigned u32x2 __attribute__((ext_vector_type(2)));
#ifndef CPU_TEST
#define LAS __attribute__((address_space(3)))
DEV void blk_sync() { asm volatile("s_waitcnt lgkmcnt(0)" ::: "memory"); __builtin_amdgcn_s_barrier(); asm volatile("" ::: "memory"); }
DEV float wshfl(float v, int src) { return __shfl(v, src); }
DEV unsigned long long wballot(bool pred) { return __ballot(pred); }
DEV void wave_sync() { asm volatile("s_waitcnt lgkmcnt(0)" ::: "memory"); __builtin_amdgcn_wave_barrier(); asm volatile("" ::: "memory"); }
DEV float bwsum(float v) { for (int o = 32; o; o >>= 1) v += __shfl_xor(v, o); return v; }
DEV f32x4 mfma16(bf16x8 a, bf16x8 b, f32x4 c) { return __builtin_amdgcn_mfma_f32_16x16x32_bf16(a, b, c, 0, 0, 0); }
DEV s16x4 lds_tr4(const LAS unsigned char* p) { return __builtin_amdgcn_ds_read_tr16_b64_v4i16((LAS s16x4*)p); }
#else
#define LAS
inline void blk_sync() { emu_block_barrier(); }
inline float wshfl(float v, int src) { return emu_shfl(v, src); }
inline unsigned long long wballot(bool pred) { return emu_ballot(pred); }
inline void wave_sync() { emu_wave_barrier(); }
inline float bwsum(float v) { for (int o = 32; o; o >>= 1) v += emu_shfl(v, (emu_tid() & 63) ^ o); return v; }
inline f32x4 mfma16(bf16x8 a, bf16x8 b, f32x4 c) { return emu_mfma_16x16x32(a, b, c); }
inline s16x4 lds_tr4(const unsigned char* p) { return emu_tr_read(p); }
#endif
DEV bf16x8 frag_row(const LAS unsigned char* m, int ld, int R0, int K0, int lane) { return *(const LAS bf16x8*)(m + ((R0 + (lane & 15)) * ld + K0 + 8 * (lane >> 4)) * 2); }
DEV bf16x8 frag_tr(const LAS unsigned char* m, int ld, int R0, int K0, int lane) {
  const int fq = lane >> 4, qq = (lane & 15) >> 2, pp = lane & 3;
  const LAS unsigned char* a = m + ((K0 + 8 * fq + qq) * ld + R0 + 4 * pp) * 2;
  const s16x4 lo = lds_tr4(a), hi = lds_tr4(a + 4 * ld * 2);
  return (bf16x8){lo[0], lo[1], lo[2], lo[3], hi[0], hi[1], hi[2], hi[3]};
}
#if defined(__HIP_DEVICE_COMPILE__)
DEV float dot2bf(unsigned a, unsigned b, float c) { return __builtin_amdgcn_fdot2_f32_bf16(__builtin_bit_cast(bf16x2_t, a), __builtin_bit_cast(bf16x2_t, b), c, false); }
#else
HD float dot2bf(unsigned a, unsigned b, float c) { return c + bflo(a) * bflo(b) + bfhi(a) * bfhi(b); }
#endif
DEV void store_lds8(LAS unsigned char* p, f32x4 a, f32x4 b) { u32x4 w; w.x = pk2(a[0], a[1]); w.y = pk2(a[2], a[3]); w.z = pk2(b[0], b[1]); w.w = pk2(b[2], b[3]); *(LAS u32x4*)p = w; }
DEV void lds_store_bf16x4(LAS unsigned char* p, f32x4 v) { u32x2 w; w.x = pk2(v[0], v[1]); w.y = pk2(v[2], v[3]); *(LAS u32x2*)p = w; }

namespace pg8 {
typedef short bf16x8 __attribute__((ext_vector_type(8)));
constexpr int BM = 256, BK = 64, HALF = 128, HTB = HALF * BK * 2, STAGE_BYTES = 8 * HTB, NXCD = 8, WGM = 8;
HD int lds_byte(int r, int c) { const int st = (r >> 4) * 2 + (c >> 5), rr = r & 15, cc = c & 31, ob = rr * 64 + cc * 2; return st * 1024 + (ob ^ (((ob >> 9) & 1) << 5)); }
HD void stage_rc(int b, int& R, int& C) { const int st = b / 1024, sb = b % 1024, swz = sb ^ (((sb >> 9) & 1) << 5); R = (st >> 1) * 16 + swz / 64; C = (st & 1) * 32 + (swz % 64) / 2; }
HD int perm32(int rho) { const int n = rho >> 4, i = rho & 15; return 8 * (i >> 2) + 4 * n + (i & 3); }
struct Unit { int pm, pn; const bf16_t* Bt; const int* rs; const float* rw; int nvalid; };
struct Gemm { const bf16_t* A; int K; };

HD void tile_order(int L, int nM, int nN, int& pm, int& pn) {
  const int nwg = nM * nN; int wgid = L;
  { const int q = nwg / NXCD, r = nwg % NXCD, xcd = wgid % NXCD, off = wgid / NXCD; wgid = (xcd < r ? xcd * (q + 1) : r * (q + 1) + (xcd - r) * q) + off; }
  const int nig = WGM * nN, gid = wgid / nig, fm = gid * WGM, gsz = (nM - fm) < WGM ? (nM - fm) : WGM;
  pm = fm + ((wgid % nig) % gsz); pn = (wgid % nig) / gsz;
}

#ifndef CPU_TEST
#define PG8_LAS __attribute__((address_space(3)))
#define PG8_GLDS(gp, lp) __builtin_amdgcn_global_load_lds((const unsigned*)(gp), (PG8_LAS unsigned*)(lp), 16, 0, 0)
#define PG8_WAIT_V(n) asm volatile("s_waitcnt vmcnt(" #n ")" ::: "memory")
#define PG8_WAIT_L(n) asm volatile("s_waitcnt lgkmcnt(" #n ")" ::: "memory")
#define PG8_BAR __builtin_amdgcn_s_barrier()
#define PG8_SCHED __builtin_amdgcn_sched_barrier(0)
#define PG8_PRIO(n) __builtin_amdgcn_s_setprio(n)
#define PG8_UNIFORM(x) __builtin_amdgcn_readfirstlane(x)
#define PG8_MFMA(a, b, c) __builtin_amdgcn_mfma_f32_16x16x32_bf16(a, b, c, 0, 0, 0)
#else
#define PG8_LAS
#define PG8_GLDS(gp, lp) emu_global_load_lds16((const void*)(gp), (void*)(lp))
#define PG8_WAIT_V(n)
#define PG8_WAIT_L(n)
#define PG8_BAR emu_block_barrier()
#define PG8_SCHED
#define PG8_PRIO(n)
#define PG8_UNIFORM(x) (x)
#define PG8_MFMA(a, b, c) emu_mfma_16x16x32(a, b, c)
#endif
template <class Epi, class Sched, bool GATHER = false, bool ALIGN_EPI = true, bool SP2 = true>
DEV void gemm_phase(PG8_LAS unsigned char* lds, const Gemm g, const Sched& S, const Epi& E) {
    const int tid = tidx(), wid = PG8_UNIFORM(tid >> 6), lane = tid & 63, wr = wid >> 2, wc = wid & 3, fr = lane & 15, fq = lane >> 4;
    const int K = g.K, nt = K / BK;
    unsigned voffA[2], voffB[2]; int stR[2], stC[2];
#pragma unroll
    for (int i = 0; i < 2; ++i) { int R, C; stage_rc(tid * 16 + i * 8192, R, C); const int Rb = Epi::PERM ? ((R & ~31) + perm32(R & 31)) : R; stR[i] = R; stC[i] = C;
        voffA[i] = (unsigned)(R * K + C) * 2u; voffB[i] = (unsigned)(Rb * K + C) * 2u; }
    const size_t kstep = (size_t)(BK * 2);
    const size_t hstep = (size_t)HALF * K * 2;
    const size_t tstep = 2 * hstep;
    const unsigned ldsw = (unsigned)wid * 1024u;
    const int aoff = lds_byte(wr * 64 + fr, fq * 8), boff = lds_byte(wc * 32 + fr, fq * 8);
#define PG8_SA(b, h) (((b) * 2 + (h)) * HTB)
#define PG8_SB(b, h) ((4 + (b) * 2 + (h)) * HTB)
#define PG8_STAGE(bufoff, gbase, voff) do { _Pragma("unroll") for (int _i = 0; _i < 2; ++_i) \
        PG8_GLDS((const char*)(gbase) + (voff)[_i], lds + (bufoff) + ldsw + _i * 8192); } while (0)
#define PG8_STAGE_A(bufoff, h, kb, vg0, vg1) do { if constexpr (GATHER) { if (h) PG8_STAGE(bufoff, kb, vg1); else PG8_STAGE(bufoff, kb, vg0); } else PG8_STAGE(bufoff, (kb) + (h) * hstep, voffA); } while (0)
#define PG8_ROWOFFS(U, v0, v1) do { if constexpr (GATHER) { _Pragma("unroll") for (int _i = 0; _i < 2; ++_i) { \
        const int l0_ = stR[_i], l1_ = HALF + stR[_i]; const int s0_ = l0_ < (U).nvalid ? (U).rs[l0_] : 0, s1_ = l1_ < (U).nvalid ? (U).rs[l1_] : 0; \
        v0[_i] = (unsigned)((s0_ >> 1) * K + stC[_i]) * 2u; v1[_i] = (unsigned)((s1_ >> 1) * K + stC[_i]) * 2u; } } } while (0)
#define PG8_LDA(dst, b, h) do { _Pragma("unroll") for (int m = 0; m < 4; ++m) _Pragma("unroll") for (int k = 0; k < 2; ++k) dst[m][k] = *(const PG8_LAS bf16x8*)(lds + PG8_SA(b, h) + aoff + m * 2048 + k * 1024); } while (0)
#define PG8_LDB(dst, b, h) do { _Pragma("unroll") for (int n = 0; n < 2; ++n) _Pragma("unroll") for (int k = 0; k < 2; ++k) dst[n][k] = *(const PG8_LAS bf16x8*)(lds + PG8_SB(b, h) + boff + n * 2048 + k * 1024); } while (0)
#define PG8_MMA(ai, bj, At, Bt) do { PG8_PRIO(1); _Pragma("unroll") for (int m = 0; m < 4; ++m) _Pragma("unroll") for (int n = 0; n < 2; ++n) _Pragma("unroll") for (int k = 0; k < 2; ++k) \
        acc[ai][bj][m][n] = PG8_MFMA(Bt[n][k], At[m][k], acc[ai][bj][m][n]); PG8_PRIO(0); } while (0)
    Unit cur, nxt; int ui = 0;
    if (!S.next(0, cur)) return;
    f32x4 acc[2][2][4][2];
#pragma unroll
    for (int a = 0; a < 2; ++a)
#pragma unroll
        for (int b = 0; b < 2; ++b)
#pragma unroll
            for (int m = 0; m < 4; ++m)
#pragma unroll
                for (int n = 0; n < 2; ++n) acc[a][b][m][n] = (f32x4){0.f, 0.f, 0.f, 0.f};
    bf16x8 At[4][2], B0[2][2], B1[2][2];
    unsigned cv0[2] = {0u, 0u}, cv1[2] = {0u, 0u}, nv0[2] = {0u, 0u}, nv1[2] = {0u, 0u};
    PG8_ROWOFFS(cur, cv0, cv1);
    const char* cA = GATHER ? (const char*)g.A : (const char*)g.A + (size_t)cur.pm * tstep; const char* cB = (const char*)cur.Bt + (size_t)cur.pn * tstep;
    if constexpr (SP2) {
        PG8_STAGE(PG8_SB(0, 0), cB, voffB); PG8_STAGE(PG8_SB(0, 1), cB + hstep, voffB); PG8_STAGE_A(PG8_SA(0, 0), 0, cA, cv0, cv1); PG8_STAGE_A(PG8_SA(0, 1), 1, cA, cv0, cv1);
        if (wr == 1) PG8_BAR;
        PG8_WAIT_V(2); PG8_BAR;
        PG8_STAGE(PG8_SB(1, 0), cB + kstep, voffB); PG8_STAGE_A(PG8_SA(1, 0), 0, cA + kstep, cv0, cv1); PG8_STAGE(PG8_SB(1, 1), cB + hstep + kstep, voffB);
        PG8_WAIT_V(6); PG8_BAR;
    } else {
        PG8_STAGE(PG8_SB(0, 0), cB, voffB); PG8_STAGE_A(PG8_SA(0, 0), 0, cA, cv0, cv1); PG8_STAGE(PG8_SB(0, 1), cB + hstep, voffB); PG8_STAGE_A(PG8_SA(0, 1), 1, cA, cv0, cv1);
        if (wr == 1) PG8_BAR;
        PG8_WAIT_V(4); PG8_BAR;
        PG8_STAGE(PG8_SB(1, 0), cB + kstep, voffB); PG8_STAGE_A(PG8_SA(1, 0), 0, cA + kstep, cv0, cv1); PG8_STAGE(PG8_SB(1, 1), cB + hstep + kstep, voffB);
        PG8_WAIT_V(6); PG8_BAR;
    }
    for (;;) {
        const bool has_next = S.next(ui + 1, nxt);
        if (has_next) PG8_ROWOFFS(nxt, nv0, nv1);
        else { nv0[0] = cv0[0]; nv0[1] = cv0[1]; nv1[0] = cv1[0]; nv1[1] = cv1[1]; }
        const char* nA = has_next ? (GATHER ? (const char*)g.A : (const char*)g.A + (size_t)nxt.pm * tstep) : cA; const char* nB = has_next ? (const char*)nxt.Bt + (size_t)nxt.pn * tstep : cB;
        for (int t = 0; t < nt; t += 2) {
            const bool last = (t == nt - 2);
            const char* a1 = cA + (size_t)(t + 1) * kstep;
            const char* a2 = last ? nA : cA + (size_t)(t + 2) * kstep; const char* b2 = last ? nB : cB + (size_t)(t + 2) * kstep;
            const char* a3 = a2 + kstep; const char* b3 = b2 + kstep;
            unsigned w0[2], w1[2];
            w0[0] = last ? nv0[0] : cv0[0]; w0[1] = last ? nv0[1] : cv0[1]; w1[0] = last ? nv1[0] : cv1[0]; w1[1] = last ? nv1[1] : cv1[1];
            if constexpr (SP2) {
            PG8_LDB(B0, 0, 0); PG8_LDB(B1, 0, 1); PG8_SCHED; PG8_LDA(At, 0, 0); PG8_STAGE_A(PG8_SA(1, 1), 1, a1, cv0, cv1);
            PG8_WAIT_V(8); PG8_WAIT_L(0); PG8_BAR; PG8_MMA(0, 0, At, B0); PG8_MMA(0, 1, At, B1); PG8_BAR; PG8_SCHED;
            PG8_LDA(At, 0, 1); PG8_STAGE(PG8_SB(0, 0), b2, voffB); PG8_STAGE(PG8_SB(0, 1), b2 + hstep, voffB); PG8_STAGE_A(PG8_SA(0, 0), 0, a2, w0, w1);
            PG8_WAIT_V(8); PG8_WAIT_L(0); PG8_BAR; PG8_MMA(1, 0, At, B0); PG8_MMA(1, 1, At, B1); PG8_BAR; PG8_SCHED;
            PG8_LDB(B0, 1, 0); PG8_LDB(B1, 1, 1); PG8_SCHED; PG8_LDA(At, 1, 0); PG8_STAGE_A(PG8_SA(0, 1), 1, a2, w0, w1);
            PG8_WAIT_V(8); PG8_WAIT_L(0); PG8_BAR; PG8_MMA(0, 0, At, B0); PG8_MMA(0, 1, At, B1); PG8_BAR; PG8_SCHED;
            PG8_LDA(At, 1, 1); PG8_STAGE(PG8_SB(1, 0), b3, voffB); PG8_STAGE(PG8_SB(1, 1), b3 + hstep, voffB); PG8_STAGE_A(PG8_SA(1, 0), 0, a3, w0, w1);
            PG8_WAIT_V(8); PG8_WAIT_L(0); PG8_BAR; PG8_MMA(1, 0, At, B0); PG8_MMA(1, 1, At, B1); PG8_BAR; PG8_SCHED;
            } else {
            PG8_LDB(B0, 0, 0); PG8_SCHED; PG8_LDA(At, 0, 0); PG8_STAGE_A(PG8_SA(1, 1), 1, a1, cv0, cv1);
            PG8_WAIT_L(8); PG8_BAR; PG8_WAIT_L(0); PG8_MMA(0, 0, At, B0); PG8_BAR; PG8_SCHED;
            PG8_LDB(B1, 0, 1); PG8_STAGE(PG8_SB(0, 0), b2, voffB);
            PG8_BAR; PG8_WAIT_L(0); PG8_MMA(0, 1, At, B1); PG8_BAR;
            PG8_LDA(At, 0, 1); PG8_STAGE_A(PG8_SA(0, 0), 0, a2, w0, w1);
            PG8_BAR; PG8_WAIT_L(0); PG8_MMA(1, 0, At, B0); PG8_BAR; PG8_SCHED;
            PG8_STAGE(PG8_SB(0, 1), b2 + hstep, voffB);
            PG8_WAIT_V(6); PG8_BAR; PG8_MMA(1, 1, At, B1); PG8_BAR;
            PG8_LDB(B0, 1, 0); PG8_SCHED; PG8_LDA(At, 1, 0); PG8_STAGE_A(PG8_SA(0, 1), 1, a2, w0, w1);
            PG8_WAIT_L(8); PG8_BAR; PG8_WAIT_L(0); PG8_MMA(0, 0, At, B0); PG8_BAR; PG8_SCHED;
            PG8_LDB(B1, 1, 1); PG8_STAGE(PG8_SB(1, 0), b3, voffB);
            PG8_BAR; PG8_WAIT_L(0); PG8_MMA(0, 1, At, B1); PG8_BAR;
            PG8_LDA(At, 1, 1); PG8_STAGE_A(PG8_SA(1, 0), 0, a3, w0, w1);
            PG8_BAR; PG8_WAIT_L(0); PG8_MMA(1, 0, At, B0); PG8_BAR; PG8_SCHED;
            PG8_STAGE(PG8_SB(1, 1), b3 + hstep, voffB);
            PG8_WAIT_V(6); PG8_BAR; PG8_MMA(1, 1, At, B1); PG8_BAR;
            }
        }
        if constexpr (ALIGN_EPI) { if (wr == 0) PG8_BAR; }
        E(acc, cur, wr, wc, fr, fq);
        if (!has_next) break;
#pragma unroll
        for (int a = 0; a < 2; ++a)
#pragma unroll
            for (int b = 0; b < 2; ++b)
#pragma unroll
                for (int m = 0; m < 4; ++m)
#pragma unroll
                    for (int n = 0; n < 2; ++n) acc[a][b][m][n] = (f32x4){0.f, 0.f, 0.f, 0.f};
        cur = nxt; cA = nA; cB = nB; ++ui; cv0[0] = nv0[0]; cv0[1] = nv0[1]; cv1[0] = nv1[0]; cv1[1] = nv1[1];
        if constexpr (ALIGN_EPI) { if (wr == 1) PG8_BAR; }
    }
    PG8_WAIT_V(0);
    if constexpr (!ALIGN_EPI) { if (wr == 0) PG8_BAR; }
    PG8_BAR;
#undef PG8_SA
#undef PG8_SB
#undef PG8_STAGE
#undef PG8_STAGE_A
#undef PG8_ROWOFFS
#undef PG8_LDA
#undef PG8_LDB
#undef PG8_MMA
}
#ifdef CPU_TEST
template <class Epi, class Sched> void gemm_phase_ref(const Gemm g, const Sched& S, const Epi& E) {
  Unit u;
  for (int ui = 0; S.next(ui, u); ++ui)
    for (int wid = 0; wid < 8; ++wid) for (int lane = 0; lane < 64; ++lane) {
      const int wr = wid >> 2, wc = wid & 3, fr = lane & 15, fq = lane >> 4;
      f32x4 acc[2][2][4][2];
      for (int ai = 0; ai < 2; ++ai) for (int bj = 0; bj < 2; ++bj) for (int m = 0; m < 4; ++m) for (int n = 0; n < 2; ++n) for (int i = 0; i < 4; ++i) {
        const size_t row = (size_t)u.pm * 256 + ai * 128 + wr * 64 + m * 16 + fr;
        const size_t col = (size_t)u.pn * 256 + bj * 128 + wc * 32 + (Epi::PERM ? 8 * fq + 4 * n + i : 16 * n + 4 * fq + i);
        const bf16_t* a = g.A + row * g.K, *b = u.Bt + col * g.K; float s = 0.f;
        for (int k = 0; k < g.K; ++k) s += bf2f(a[k]) * bf2f(b[k]);
        acc[ai][bj][m][n][i] = s;
      }
      E(acc, u, wr, wc, fr, fq);
    }
}
#define GEMM_RUN(lds, g, S, E) do { if (tidx() == 0) pg8::gemm_phase_ref(g, S, E); } while (0)
#define GEMM_RUN_GATHER(lds, g, S, E) pg8::gemm_phase<decltype(E), decltype(S), true>((unsigned char*)(lds), g, S, E)
#else
#define GEMM_RUN(lds, g, S, E) pg8::gemm_phase<decltype(E), decltype(S), false>((PG8_LAS unsigned char*)(lds), g, S, E)
#define GEMM_RUN_GATHER(lds, g, S, E) pg8::gemm_phase<decltype(E), decltype(S), true>((PG8_LAS unsigned char*)(lds), g, S, E)
#endif
}
using pg8::Unit; using pg8::Gemm;

struct DenseOrder { int nM, nN, G, c; const bf16_t* Bt;
  HD bool next(int i, Unit& u) const { const long L = (long)i * G + c; if (L >= (long)nM * nN) return false; pg8::tile_order((int)L, nM, nN, u.pm, u.pn); u.Bt = Bt; u.rs = nullptr; u.rw = nullptr; u.nvalid = 256; return true; } };
struct Inproj1Order { int G, c; const bf16_t* Bt;
  HD bool next(int i, Unit& u) const { const long L = (long)i * G + c; const int n1 = (TL / 256) * 20, n2 = (TC / 256) * 12; if (L >= n1 + n2) return false;
    if (L < n1) pg8::tile_order((int)L, TL / 256, 20, u.pm, u.pn); else { const int q = (int)L - n1; u.pm = TL / 256 + q % (TC / 256); u.pn = 8 + q / (TC / 256); }
    u.Bt = Bt; u.rs = nullptr; u.rw = nullptr; u.nvalid = 256; return true; } };
struct MoeOrder { int G, c; const int* CNT; const bf16_t* Bt; size_t estride; const int* RS; const float* RW;
  HD bool next(int i, Unit& u) const { const long L = (long)i * G + c; const int t = (int)(L >> 2); int tb = 0, e = -1, j = 0, ce = 0;
    for (int q = 0; q < NE; ++q) { const int cq = CNT[q], nt = (cq + 255) >> 8; if (e < 0 && t < tb + nt) { e = q; j = t - tb; ce = cq; } tb += nt; }
    if (e < 0) return false; u.pm = t; u.pn = (int)(L & 3); u.Bt = Bt + (size_t)e * estride;
    u.rs = RS + (size_t)e * MOE_CAP + 256 * j; u.rw = RW + (size_t)e * MOE_CAP + 256 * j; u.nvalid = ce - 256 * j < 256 ? ce - 256 * j : 256; return true; } };

HD f32x4 silu4(f32x4 v) { return (f32x4){siluf_(v[0]), siluf_(v[1]), siluf_(v[2]), siluf_(v[3])}; }
HD f32x4 sigm4(f32x4 v) { return (f32x4){sigmoidf_(v[0]), sigmoidf_(v[1]), sigmoidf_(v[2]), sigmoidf_(v[3])}; }
struct EpiInproj0 { static constexpr bool PERM = true; bf16_t* Z; bf16_t* XR; bf16_t* U; float* DT; const float* dtb;
  HD void operator()(const f32x4 (&acc)[2][2][4][2], const Unit& u, int wr, int wc, int fr, int fq) const {
#pragma unroll
    for (int ai = 0; ai < 2; ++ai)
#pragma unroll
      for (int m = 0; m < 4; ++m) {
        const size_t row = (size_t)u.pm * 256 + ai * 128 + wr * 64 + m * 16 + fr; const int cl = wc * 32 + 8 * fq;
        if (u.pn < 12) { bf16_t* base = u.pn < 4 ? Z + row * 1024 + u.pn * 256 : XR + row * 2048 + (u.pn - 4) * 256;
#pragma unroll
          for (int bj = 0; bj < 2; ++bj) store_bf16x8(base + bj * 128 + cl, acc[ai][bj][m][0], acc[ai][bj][m][1]); }
        else if (u.pn < 20) store_bf16x8(U + row * 1024 + (u.pn - 12) * 128 + cl, acc[ai][0][m][0] * sigm4(acc[ai][1][m][0]), acc[ai][0][m][1] * sigm4(acc[ai][1][m][1]));
        else if (wc == 0) {
#pragma unroll
          for (int n = 0; n < 2; ++n)
#pragma unroll
            for (int i = 0; i < 4; ++i) { const int j = 8 * fq + 4 * n + i; DT[row * 32 + j] = softplusf_(acc[ai][0][m][n][i] + dtb[j]); } }
      }
  } };
struct EpiResid { static constexpr bool PERM = false; const P* p; int l; bool from_input;
  HD void operator()(const f32x4 (&acc)[2][2][4][2], const Unit& u, int wr, int wc, int fr, int fq) const {
    const float* gate = modv(*p, l, tok_modrow(u.pm * 256), 2) + u.pn * 256 + wc * 32 + 4 * fq;
    f32x4 g4[2][2];
#pragma unroll
    for (int bj = 0; bj < 2; ++bj)
#pragma unroll
      for (int n = 0; n < 2; ++n) g4[bj][n] = *(const f32x4*)(gate + bj * 128 + 16 * n);
#pragma unroll
    for (int ai = 0; ai < 2; ++ai)
#pragma unroll
      for (int m = 0; m < 4; ++m) {
        const int row = u.pm * 256 + ai * 128 + wr * 64 + m * 16 + fr;
        const float* base = from_input ? xin_row(*p, row) : xcur_row(*p, row); float* dst = xcur_row(*p, row);
#pragma unroll
        for (int bj = 0; bj < 2; ++bj)
#pragma unroll
          for (int n = 0; n < 2; ++n) { const int c = u.pn * 256 + bj * 128 + wc * 32 + 16 * n + 4 * fq;
            *(f32x4*)(dst + c) = *(const f32x4*)(base + c) + g4[bj][n] * acc[ai][bj][m][n]; }
      }
  } };
struct EpiMoe1 { static constexpr bool PERM = true; bf16_t* ACT;
  HD void operator()(const f32x4 (&acc)[2][2][4][2], const Unit& u, int wr, int wc, int fr, int fq) const {
#pragma unroll
    for (int ai = 0; ai < 2; ++ai)
#pragma unroll
      for (int m = 0; m < 4; ++m) { const size_t row = (size_t)u.pm * 256 + ai * 128 + wr * 64 + m * 16 + fr;
        store_bf16x8(ACT + row * 512 + u.pn * 128 + wc * 32 + 8 * fq, silu4(acc[ai][0][m][0]) * acc[ai][1][m][0], silu4(acc[ai][0][m][1]) * acc[ai][1][m][1]); }
  } };
struct EpiMoe2 { static constexpr bool PERM = true; bf16_t* YS;
  HD void operator()(const f32x4 (&acc)[2][2][4][2], const Unit& u, int wr, int wc, int fr, int fq) const {
#pragma unroll
    for (int ai = 0; ai < 2; ++ai)
#pragma unroll
      for (int m = 0; m < 4; ++m) { const int li = ai * 128 + wr * 64 + m * 16 + fr;
        if (li < u.nvalid) { const int slot = u.rs[li]; const float w = u.rw[li]; bf16_t* dst = YS + (size_t)slot * 1024 + u.pn * 256 + wc * 32 + 8 * fq;
#pragma unroll
          for (int bj = 0; bj < 2; ++bj) store_bf16x8(dst + bj * 128, acc[ai][bj][m][0] * w, acc[ai][bj][m][1] * w); } }
  } };
struct EpiInproj1 { static constexpr bool PERM = true; bf16_t* P1; const float* lbt;
  HD void operator()(const f32x4 (&acc)[2][2][4][2], const Unit& u, int wr, int wc, int fr, int fq) const {
#pragma unroll
    for (int bj = 0; bj < 2; ++bj) { const int c = u.pn * 256 + bj * 128 + wc * 32 + 8 * fq;
      f32x4 lb0 = {0.f, 0.f, 0.f, 0.f}, lb1 = {0.f, 0.f, 0.f, 0.f};
      if (u.pn >= 12) { lb0 = *(const f32x4*)(lbt + (c & 1023)); lb1 = *(const f32x4*)(lbt + (c & 1023) + 4); }
#pragma unroll
      for (int ai = 0; ai < 2; ++ai)
#pragma unroll
        for (int m = 0; m < 4; ++m) { const size_t row = (size_t)u.pm * 256 + ai * 128 + wr * 64 + m * 16 + fr; f32x4 v0 = acc[ai][bj][m][0], v1 = acc[ai][bj][m][1];
          if (u.pn < 4) { v0 = silu4(v0); v1 = silu4(v1); }
          else if (u.pn >= 12) {
#pragma unroll
            for (int i = 0; i < 4; ++i) { v0[i] = (1.f - lb0[i]) * sigmoidf_(-v0[i]); v1[i] = (1.f - lb1[i]) * sigmoidf_(-v1[i]); } }
          store_bf16x8(P1 + row * 5120 + c, v0, v1); } }
  } };

DEV void ph_gemm_inproj0(const P& p, void* lds, int bid, int G) {
  Gemm g{(const bf16_t*)(p.ws + WS_H), 1024}; DenseOrder S{TT / 256, N0P / 256, G, bid, (const bf16_t*)(p.ws + WS_WIN0)};
  EpiInproj0 E{(bf16_t*)(p.ws + WS_Z), (bf16_t*)(p.ws + WS_XR), (bf16_t*)(p.ws + WS_U), (float*)(p.ws + WS_DT), p.in[I_DTB]};
  GEMM_RUN(lds, g, S, E);
}
DEV void ph_gemm_outproj0(const P& p, void* lds, int bid, int G) {
  Gemm g{(const bf16_t*)(p.ws + WS_XR), 2048}; DenseOrder S{TT / 256, 4, G, bid, (const bf16_t*)(p.ws + WS_WOUT0)}; EpiResid E{&p, 0, true};
  GEMM_RUN(lds, g, S, E);
}
DEV void ph_gemm_moe1(const P& p, int l, void* lds, int bid, int G) {
  Gemm g{(const bf16_t*)(p.ws + WS_H), 1024}; MoeOrder S{G, bid, (const int*)(p.ws + WS_CTL) + l * NE, (const bf16_t*)(p.ws + WS_WGU), (size_t)1024 * 1024, (const int*)(p.ws + WS_RSLOT), (const float*)(p.ws + WS_RW)}; EpiMoe1 E{(bf16_t*)(p.ws + WS_ACT)};
  GEMM_RUN_GATHER(lds, g, S, E);
}
DEV void ph_gemm_moe2(const P& p, int l, void* lds, int bid, int G) {
  Gemm g{(const bf16_t*)(p.ws + WS_ACT), 512}; MoeOrder S{G, bid, (const int*)(p.ws + WS_CTL) + l * NE, (const bf16_t*)(p.ws + WS_WDT), (size_t)1024 * 512, (const int*)(p.ws + WS_RSLOT), (const float*)(p.ws + WS_RW)};
  EpiMoe2 E{(bf16_t*)(p.ws + WS_YS)};
  GEMM_RUN(lds, g, S, E);
}
DEV void ph_gemm_inproj1(const P& p, void* lds, int bid, int G) {
  Gemm g{(const bf16_t*)(p.ws + WS_H), 1024}; Inproj1Order S{G, bid, (const bf16_t*)(p.ws + WS_WHGI)}; EpiInproj1 E{(bf16_t*)(p.ws + WS_P1), (const float*)(p.ws + WS_LB)};
  GEMM_RUN(lds, g, S, E);
}
DEV void ph_gemm_outproj1(const P& p, void* lds, int bid, int G) {
  Gemm g{(const bf16_t*)(p.ws + WS_H), 1024}; DenseOrder S{TL / 256, 4, G, bid, (const bf16_t*)(p.ws + WS_WHGO)}; EpiResid E{&p, 1, false};
  GEMM_RUN(lds, g, S, E);
}

HD void tok_pos(int r, int& t, int& L) { if (r < TL) { t = r % SEQ; L = SEQ; } else { t = (r - TL) % CTX; L = CTX; } }


constexpr int SSD_LD = 136, SSD_LDX = 72;
constexpr int SSD_OFF_C = 0, SSD_OFF_B = SSD_OFF_C + 128 * SSD_LD * 2, SSD_OFF_X = SSD_OFF_B + 128 * SSD_LD * 2, SSD_OFF_XW = SSD_OFF_X + 128 * SSD_LDX * 2,
              SSD_OFF_S = SSD_OFF_XW + 128 * SSD_LDX * 2, SSD_OFF_F = SSD_OFF_S + 64 * SSD_LD * 2, SSD_LDS_END = SSD_OFF_F + 520 * 4;
static_assert(SSD_LDS_END <= LDS_BYTES, "SSD LDS map");
DEV void ph_ssd_chunked(const P& p, LAS unsigned char* lds, int bid, int G) {
  const int t = tidx(), wid = PG8_UNIFORM(t >> 6), lane = t & 63, fr = lane & 15, fq = lane >> 4;
  constexpr int LD = SSD_LD, LDX = SSD_LDX;
  LAS unsigned char* Cm = lds + SSD_OFF_C; LAS unsigned char* Bm = lds + SSD_OFF_B; LAS unsigned char* Xm = lds + SSD_OFF_X; LAS unsigned char* XWm = lds + SSD_OFF_XW; LAS unsigned char* Sb = lds + SSD_OFF_S;
  LAS float* fa = (LAS float*)(lds + SSD_OFF_F);
  const bf16_t* XBC = (const bf16_t*)(p.ws + WS_XBC); const float* DT = (const float*)(p.ws + WS_DT);
  constexpr int NCH = (CTX + SEQ) / 128;
  for (int u = bid; u < NB * 32; u += G) {
    const int b = u >> 5, d = (u >> 4) & 1, h = u & 15, g = h >> 2, sgn = d ? -1 : 1;
    const float a = -fexp(p.in[I_ALOG][d * 16 + h]), Dk = p.in[I_SSDD][h];
    bf16_t* Yd = (bf16_t*)(p.ws + WS_Y) + (size_t)d * TT * 1024;
    f32x4 ST[2][2];
#pragma unroll
    for (int i = 0; i < 2; ++i)
#pragma unroll
      for (int j = 0; j < 2; ++j) ST[i][j] = (f32x4){0.f, 0.f, 0.f, 0.f};
    blk_sync();
    for (int i = t; i < 64 * LD / 2; i += NT) ((LAS unsigned*)Sb)[i] = 0u;
    u32x4 nC[4], nB[4], nX[2]; float ndt0 = 0.f, ndt1 = 0.f;
#define SSD_R0(cc) ((cc) * 128 < CTX ? TL + b * CTX + (d ? CTX - 1 - (cc) * 128 : (cc) * 128) : b * SEQ + (d ? SEQ - 1 - ((cc) * 128 - CTX) : ((cc) * 128 - CTX)))
#define SSD_LOAD(cc) do { const int r0_ = SSD_R0(cc); \
      _Pragma("unroll") for (int i_ = 0; i_ < 4; ++i_) { const int v_ = t + NT * i_; const bf16_t* s_ = XBC + (size_t)(r0_ + sgn * (v_ >> 4)) * 2048 + g * 128 + (v_ & 15) * 8; nC[i_] = *(const u32x4*)(s_ + 1536); nB[i_] = *(const u32x4*)(s_ + 1024); } \
      _Pragma("unroll") for (int i_ = 0; i_ < 2; ++i_) { const int v_ = t + NT * i_; nX[i_] = *(const u32x4*)(XBC + (size_t)(r0_ + sgn * (v_ >> 3)) * 2048 + h * 64 + (v_ & 7) * 8); } \
      if (wid == 0) { ndt0 = DT[(size_t)(r0_ + sgn * (2 * lane)) * 32 + d * 16 + h]; ndt1 = DT[(size_t)(r0_ + sgn * (2 * lane + 1)) * 32 + d * 16 + h]; } } while (0)
    SSD_LOAD(0);
    for (int c = 0; c < NCH; ++c) {
      const int s0 = c * 128;
      const int r0 = s0 < CTX ? TL + b * CTX + (d ? CTX - 1 - s0 : s0) : b * SEQ + (d ? SEQ - 1 - (s0 - CTX) : (s0 - CTX));
      u32x4 xv[2];
#pragma unroll
      for (int i = 0; i < 4; ++i) { const int v = t + NT * i, row = v >> 4, c16 = v & 15; *(LAS u32x4*)(Cm + row * LD * 2 + c16 * 16) = nC[i]; *(LAS u32x4*)(Bm + row * LD * 2 + c16 * 16) = nB[i]; }
#pragma unroll
      for (int i = 0; i < 2; ++i) { const int v = t + NT * i, row = v >> 3, c8 = v & 7; xv[i] = nX[i]; *(LAS u32x4*)(Xm + row * LDX * 2 + c8 * 16) = xv[i]; }
      const float dt0 = ndt0, dt1 = ndt1;
      if (c + 1 < NCH) SSD_LOAD(c + 1);
      if (wid == 0) {
        const int j0 = 2 * lane;
        const float la0 = dt0 * a, la1 = dt1 * a; float ps = la0 + la1;
#pragma unroll
        for (int o = 1; o < 64; o <<= 1) { const float n = wshfl(ps, lane - o); if (lane >= o) ps += n; }
        const float end = wshfl(ps, 63), ac0 = ps - la1, ac1 = ps;
        fa[j0] = dt0; fa[j0 + 1] = dt1; fa[128 + j0] = ac0; fa[129 + j0] = ac1; fa[256 + j0] = dt0 * fexp(end - ac0); fa[257 + j0] = dt1 * fexp(end - ac1);
        fa[384 + j0] = fexp(ac0); fa[385 + j0] = fexp(ac1); if (lane == 0) fa[512] = fexp(end);
      }
      blk_sync();
#pragma unroll
      for (int i = 0; i < 2; ++i) { const int v = t + NT * i, row = v >> 3, c8 = v & 7; const float w = fa[256 + row]; u32x4 o;
        o.x = pk2(bflo(xv[i].x) * w, bfhi(xv[i].x) * w); o.y = pk2(bflo(xv[i].y) * w, bfhi(xv[i].y) * w); o.z = pk2(bflo(xv[i].z) * w, bfhi(xv[i].z) * w); o.w = pk2(bflo(xv[i].w) * w, bfhi(xv[i].w) * w);
        *(LAS u32x4*)(XWm + row * LDX * 2 + c8 * 16) = o; }
      const int I1 = (0x22331100 >> (4 * wid)) & 3, J1 = (0x01011010 >> (4 * wid)) & 1;
      f32x4 cb[2][4];
#pragma unroll
      for (int i = 0; i < 2; ++i)
#pragma unroll
        for (int j = 0; j < 4; ++j) cb[i][j] = (f32x4){0.f, 0.f, 0.f, 0.f};
      if (2 * I1 <= ((4 * J1 + 3) | 1)) {
#pragma unroll
        for (int q = 0; q < 4; ++q) {
          bf16x8 af[2], bfm[4];
#pragma unroll
          for (int i = 0; i < 2; ++i) af[i] = frag_row(Bm, LD, 16 * (2 * I1 + i), 32 * q, lane);
#pragma unroll
          for (int j = 0; j < 4; ++j) bfm[j] = frag_row(Cm, LD, 16 * (4 * J1 + j), 32 * q, lane);
#pragma unroll
          for (int i = 0; i < 2; ++i)
#pragma unroll
            for (int j = 0; j < 4; ++j) if (2 * I1 + i <= ((4 * J1 + j) | 1)) cb[i][j] = mfma16(af[i], bfm[j], cb[i][j]);
        }
      }
      blk_sync();
      const int NI = wid & 3, PJ = wid >> 2;
      { const float dec = fa[512];
#pragma unroll
        for (int i = 0; i < 2; ++i)
#pragma unroll
          for (int j = 0; j < 2; ++j) ST[i][j] *= dec;
#pragma unroll
        for (int q = 0; q < 4; ++q) {
          bf16x8 af[2], bfm[2];
#pragma unroll
          for (int i = 0; i < 2; ++i) af[i] = frag_tr(Bm, LD, 16 * (2 * NI + i), 32 * q, lane);
#pragma unroll
          for (int j = 0; j < 2; ++j) bfm[j] = frag_tr(XWm, LDX, 16 * (2 * PJ + j), 32 * q, lane);
#pragma unroll
          for (int i = 0; i < 2; ++i)
#pragma unroll
            for (int j = 0; j < 2; ++j) ST[i][j] = mfma16(af[i], bfm[j], ST[i][j]);
        }
      }
      blk_sync();
#pragma unroll
      for (int i = 0; i < 2; ++i)
#pragma unroll
        for (int j = 0; j < 4; ++j) if (2 * I1 + i <= ((4 * J1 + j) | 1)) {
          const int s = 16 * (2 * I1 + i) + 4 * fq, l = 16 * (4 * J1 + j) + fr; const float al = fa[128 + l];
          const f32x4 as = *(const LAS f32x4*)(fa + 128 + s), ds = *(const LAS f32x4*)(fa + s); f32x4 m;
#pragma unroll
          for (int e = 0; e < 4; ++e) m[e] = (s + e <= l) ? cb[i][j][e] * fexp(al - as[e]) * ds[e] : 0.f;
          lds_store_bf16x4(Bm + (l * LD + s) * 2, m);
        }
      blk_sync();
      { const int PI = wid & 1, JJ = wid >> 1;
        f32x4 yd[2][2], yo[2][2];
#pragma unroll
        for (int i = 0; i < 2; ++i)
#pragma unroll
          for (int j = 0; j < 2; ++j) { yd[i][j] = (f32x4){0.f, 0.f, 0.f, 0.f}; yo[i][j] = (f32x4){0.f, 0.f, 0.f, 0.f}; }
        for (int q = 0; q <= JJ; ++q) {
          bf16x8 af[2], bfm[2];
#pragma unroll
          for (int i = 0; i < 2; ++i) af[i] = frag_tr(Xm, LDX, 16 * (2 * PI + i), 32 * q, lane);
#pragma unroll
          for (int j = 0; j < 2; ++j) bfm[j] = frag_row(Bm, LD, 16 * (2 * JJ + j), 32 * q, lane);
#pragma unroll
          for (int i = 0; i < 2; ++i)
#pragma unroll
            for (int j = 0; j < 2; ++j) yd[i][j] = mfma16(af[i], bfm[j], yd[i][j]);
        }
#pragma unroll
        for (int q = 0; q < 4; ++q) {
          bf16x8 af[2], bfm[2];
#pragma unroll
          for (int i = 0; i < 2; ++i) af[i] = frag_row(Sb, LD, 16 * (2 * PI + i), 32 * q, lane);
#pragma unroll
          for (int j = 0; j < 2; ++j) bfm[j] = frag_row(Cm, LD, 16 * (2 * JJ + j), 32 * q, lane);
#pragma unroll
          for (int i = 0; i < 2; ++i)
#pragma unroll
            for (int j = 0; j < 2; ++j) yo[i][j] = mfma16(af[i], bfm[j], yo[i][j]);
        }
#pragma unroll
        for (int i = 0; i < 2; ++i)
#pragma unroll
          for (int j = 0; j < 2; ++j) { const int pb = 16 * (2 * PI + i) + 4 * fq, l = 16 * (2 * JJ + j) + fr; const float e = fa[384 + l];
            f32x4 y = yd[i][j] + yo[i][j] * e;
            if (d == 0) { const u32x2 xs = *(const LAS u32x2*)(Xm + (l * LDX + pb) * 2); y += (f32x4){bflo(xs.x), bfhi(xs.x), bflo(xs.y), bfhi(xs.y)} * Dk; }
            u32x2 o; o.x = pk2(y[0], y[1]); o.y = pk2(y[2], y[3]); *(u32x2*)(Yd + (size_t)(r0 + sgn * l) * 1024 + h * 64 + pb) = o; }
      }
      blk_sync();
#pragma unroll
      for (int i = 0; i < 2; ++i)
#pragma unroll
        for (int j = 0; j < 2; ++j) lds_store_bf16x4(Sb + ((16 * (2 * PJ + j) + fr) * LD + 16 * (2 * NI + i) + 4 * fq) * 2, ST[i][j]);
    }
  }
}


constexpr int HG_LD = 136, HG_LDV = 72;
constexpr int HG_OFF_G = 0, HG_OFF_QR = HG_OFF_G + 64 * 128 * 4, HG_OFF_KR = HG_OFF_QR + 64 * HG_LD * 2, HG_OFF_QG = HG_OFF_KR + 64 * HG_LD * 2, HG_OFF_KE = HG_OFF_QG + 64 * HG_LD * 2,
              HG_OFF_V = HG_OFF_KE + 64 * HG_LD * 2, HG_OFF_AT = HG_OFF_V + 64 * HG_LDV * 2, HG_OFF_S = HG_OFF_AT + 64 * HG_LDV * 2, HG_LDS_END = HG_OFF_S + 64 * HG_LD * 2;
static_assert(HG_LDS_END <= LDS_BYTES, "HGRN2 LDS map");
HD int hg_row(int b, int d, int s) { if (s < CTX) return TL + b * CTX + (d ? CTX - 1 - s : s); int tp = s - CTX; if (d) tp = SEQ - 1 - tp; return b * SEQ + (tp % ROWS) * GW + tp / ROWS; }
DEV void ph_hg_chunked(const P& p, LAS unsigned char* lds, int bid, int G) {
  const int t = tidx(), wid = PG8_UNIFORM(t >> 6), lane = t & 63, fr = lane & 15, fq = lane >> 4;
  constexpr int LD = HG_LD, LDV = HG_LDV;
  LAS float* Gm = (LAS float*)(lds + HG_OFF_G); LAS unsigned char* QRm = lds + HG_OFF_QR; LAS unsigned char* KRm = lds + HG_OFF_KR; LAS unsigned char* QGm = lds + HG_OFF_QG; LAS unsigned char* KEm = lds + HG_OFF_KE;
  LAS unsigned char* Vm = lds + HG_OFF_V; LAS unsigned char* ATm = lds + HG_OFF_AT; LAS unsigned char* Sb = lds + HG_OFF_S; LAS float* PT = (LAS float*)ATm;
  const bf16_t* P1 = (const bf16_t*)(p.ws + WS_P1);
  constexpr int NCH = (CTX + SEQ) / 64;
  for (int u = bid; u < NB * 32; u += G) {
    const int b = u >> 5, d = (u >> 4) & 1, h = (u >> 1) & 7, vh = u & 1;
    bf16_t* Od = (bf16_t*)(p.ws + WS_O) + (size_t)d * TL * 1024;
    f32x4 ST[2][2];
#pragma unroll
    for (int i = 0; i < 2; ++i)
#pragma unroll
      for (int j = 0; j < 2; ++j) ST[i][j] = (f32x4){0.f, 0.f, 0.f, 0.f};
    blk_sync();
    for (int i = t; i < 64 * LD / 2; i += NT) ((LAS unsigned*)Sb)[i] = 0u;
    u32x4 nlf[2], nq[2], nv;
#define HG_LOAD(cc) do { _Pragma("unroll") for (int i_ = 0; i_ < 2; ++i_) { const int v_ = t + NT * i_; const bf16_t* s_ = P1 + (size_t)hg_row(b, d, (cc) * 64 + (v_ >> 4)) * 5120 + h * 128 + (v_ & 15) * 8; \
        nlf[i_] = *(const u32x4*)(s_ + 3072 + d * 1024); nq[i_] = ((cc) * 64 >= CTX) ? *(const u32x4*)s_ : (u32x4){0u, 0u, 0u, 0u}; } \
      nv = *(const u32x4*)(P1 + (size_t)hg_row(b, d, (cc) * 64 + (t >> 3)) * 5120 + 2048 + h * 128 + vh * 64 + (t & 7) * 8); } while (0)
    HG_LOAD(0);
    for (int c = 0; c < NCH; ++c) {
      const bool lat = c * 64 >= CTX;
      u32x4 lfv[2], qv[2];
#pragma unroll
      for (int i = 0; i < 2; ++i) { const int v = t + NT * i, j = v >> 4, c16 = v & 15; lfv[i] = nlf[i]; qv[i] = nq[i];
        LAS float* gp = Gm + j * 128 + c16 * 8;
        *(LAS f32x4*)gp = 1.f - (f32x4){bflo(lfv[i].x), bfhi(lfv[i].x), bflo(lfv[i].y), bfhi(lfv[i].y)}; *(LAS f32x4*)(gp + 4) = 1.f - (f32x4){bflo(lfv[i].z), bfhi(lfv[i].z), bflo(lfv[i].w), bfhi(lfv[i].w)}; }
      { const int j = t >> 3, c8 = t & 7; *(LAS u32x4*)(Vm + (j * LDV + c8 * 8) * 2) = nv; }
      if (c + 1 < NCH) HG_LOAD(c + 1);
      blk_sync();
      { const int k = t & 127, part = t >> 7; float gv[16];
#pragma unroll
        for (int j = 0; j < 16; ++j) gv[j] = Gm[(part * 16 + j) * 128 + k];
#pragma unroll
        for (int j = 1; j < 16; ++j) gv[j] *= gv[j - 1];
        PT[part * 128 + k] = gv[15];
        blk_sync();
        float pre = 1.f;
#pragma unroll
        for (int q = 0; q < 3; ++q) pre *= (q < part) ? PT[q * 128 + k] : 1.f;
#pragma unroll
        for (int j = 0; j < 16; ++j) Gm[(part * 16 + j) * 128 + k] = gv[j] * pre;
      }
      blk_sync();
#pragma unroll
      for (int hh = 0; hh < 2; ++hh) {
        const int k0 = (t & 15) * 8 + hh * 4;
        const f32x4 p31 = *(const LAS f32x4*)(Gm + 31 * 128 + k0), p63 = *(const LAS f32x4*)(Gm + 63 * 128 + k0);
        f32x4 ip31;
#pragma unroll
        for (int e = 0; e < 4; ++e) ip31[e] = fdiv(1.f, p31[e]);
#pragma unroll
        for (int i = 0; i < 2; ++i) { const int v = t + NT * i, j = v >> 4;
          const f32x4 pc = *(const LAS f32x4*)(Gm + j * 128 + k0);
          const unsigned kw0 = hh ? lfv[i].z : lfv[i].x, kw1 = hh ? lfv[i].w : lfv[i].y, qw0 = hh ? qv[i].z : qv[i].x, qw1 = hh ? qv[i].w : qv[i].y;
          const f32x4 k4 = (f32x4){bflo(kw0), bfhi(kw0), bflo(kw1), bfhi(kw1)}, q4 = (f32x4){bflo(qw0), bfhi(qw0), bflo(qw1), bfhi(qw1)};
          f32x4 kip;
#pragma unroll
          for (int e = 0; e < 4; ++e) kip[e] = fdiv(k4[e], pc[e]);
          const f32x4 qg = q4 * pc;
          const int off = (j * LD + k0) * 2;
          lds_store_bf16x4(QRm + off, qg * ip31); lds_store_bf16x4(KRm + off, kip * p31); lds_store_bf16x4(QGm + off, qg); lds_store_bf16x4(KEm + off, kip * p63); }
      }
      blk_sync();
      const int TI = wid & 3, TJ = wid >> 2;
      if (lat && TI <= ((2 * TJ + 1) | 1)) {
        f32x4 at[2] = {(f32x4){0.f, 0.f, 0.f, 0.f}, (f32x4){0.f, 0.f, 0.f, 0.f}};
#pragma unroll
        for (int q = 0; q < 4; ++q) { const bf16x8 af = frag_row(KRm, LD, 16 * TI, 32 * q, lane);
#pragma unroll
          for (int j = 0; j < 2; ++j) at[j] = mfma16(af, frag_row(QRm, LD, 16 * (2 * TJ + j), 32 * q, lane), at[j]); }
#pragma unroll
        for (int j = 0; j < 2; ++j) { const int s = 16 * TI + 4 * fq, l = 16 * (2 * TJ + j) + fr; f32x4 m;
#pragma unroll
          for (int e = 0; e < 4; ++e) m[e] = (s + e <= l) ? at[j][e] : 0.f;
          lds_store_bf16x4(ATm + (l * LDV + s) * 2, m); }
      }
      const int KI = wid & 3, VJ = wid >> 2;
      f32x4 SN[2][2];
#pragma unroll
      for (int i = 0; i < 2; ++i) { const f32x4 dec = *(const LAS f32x4*)(Gm + 63 * 128 + 16 * (2 * KI + i) + 4 * fq);
#pragma unroll
        for (int j = 0; j < 2; ++j) SN[i][j] = ST[i][j] * dec; }
#pragma unroll
      for (int q = 0; q < 2; ++q) { bf16x8 af[2], bfm[2];
#pragma unroll
        for (int i = 0; i < 2; ++i) af[i] = frag_tr(KEm, LD, 16 * (2 * KI + i), 32 * q, lane);
#pragma unroll
        for (int j = 0; j < 2; ++j) bfm[j] = frag_tr(Vm, LDV, 16 * (2 * VJ + j), 32 * q, lane);
#pragma unroll
        for (int i = 0; i < 2; ++i)
#pragma unroll
          for (int j = 0; j < 2; ++j) SN[i][j] = mfma16(af[i], bfm[j], SN[i][j]); }
#pragma unroll
      for (int i = 0; i < 2; ++i)
#pragma unroll
        for (int j = 0; j < 2; ++j) ST[i][j] = SN[i][j];
      blk_sync();
      if (lat) { const int VI = wid & 3; f32x4 o[2] = {(f32x4){0.f, 0.f, 0.f, 0.f}, (f32x4){0.f, 0.f, 0.f, 0.f}};
        for (int q = 0; q <= TJ; ++q) { const bf16x8 af = frag_tr(Vm, LDV, 16 * VI, 32 * q, lane);
#pragma unroll
          for (int j = 0; j < 2; ++j) o[j] = mfma16(af, frag_row(ATm, LDV, 16 * (2 * TJ + j), 32 * q, lane), o[j]); }
#pragma unroll
        for (int q = 0; q < 4; ++q) { const bf16x8 af = frag_row(Sb, LD, 16 * VI, 32 * q, lane);
#pragma unroll
          for (int j = 0; j < 2; ++j) o[j] = mfma16(af, frag_row(QGm, LD, 16 * (2 * TJ + j), 32 * q, lane), o[j]); }
#pragma unroll
        for (int j = 0; j < 2; ++j) { const int l = 16 * (2 * TJ + j) + fr; u32x2 w; w.x = pk2(o[j][0], o[j][1]); w.y = pk2(o[j][2], o[j][3]);
          *(u32x2*)(Od + (size_t)hg_row(b, d, c * 64 + l) * 1024 + h * 128 + vh * 64 + 16 * VI + 4 * fq) = w; }
      }
      blk_sync();
#pragma unroll
      for (int i = 0; i < 2; ++i)
#pragma unroll
        for (int j = 0; j < 2; ++j) lds_store_bf16x4(Sb + ((16 * (2 * VJ + j) + fr) * LD + 16 * (2 * KI + i) + 4 * fq) * 2, ST[i][j]);
    }
  }
}


constexpr int MODL_SC = 0, MODL_PART = (NB + 1) * DM * 4;
static_assert(MODL_PART + 32 * (NB + 1) * 48 * 4 <= LDS_BYTES, "mod LDS map");
DEV void ph_mod2(const P& p, LAS unsigned char* lds, int bid, int G) {
  const int t = tidx();
  LAS float* SC = (LAS float*)(lds + MODL_SC); LAS float* PART = (LAS float*)(lds + MODL_PART);
  if (bid == 0 && t < 64) ((int*)(p.ws + WS_CTL))[t] = 0;
  if (bid == 0) for (int i = t; i < 1024; i += NT) ((float*)(p.ws + WS_LB))[i] = fdiv(1.f, 1.f + fexp(p.in[I_HGLB][i] - p.in[I_HGLB][1024 + i]));
  for (int i = t; i < (NB + 1) * DM; i += NT) { const int r = i / DM, k = i % DM; SC[i] = siluf_(r < NB ? p.in[I_C][r * DM + k] : p.in[I_CCTX][k]); }
  blk_sync();
  for (int cg = bid; cg < 2 * 6144 / 48; cg += G) {
    const int l = cg / 128, col0 = (cg % 128) * 48;
    if (t < 384) { const int c4 = t % 12, ks = t / 12; const float* W = p.in[I_MODW] + (size_t)l * DM * 6144 + col0 + 4 * c4;
      f32x4 acc[NB + 1];
#pragma unroll
      for (int r = 0; r <= NB; ++r) acc[r] = (f32x4){0.f, 0.f, 0.f, 0.f};
#pragma unroll
      for (int k8 = 0; k8 < 32; k8 += 16) { f32x4 w[16];
#pragma unroll
        for (int kk = 0; kk < 16; ++kk) w[kk] = *(const f32x4*)(W + (size_t)(ks * 32 + k8 + kk) * 6144);
#pragma unroll
        for (int kk = 0; kk < 16; ++kk) { const int k = ks * 32 + k8 + kk;
#pragma unroll
          for (int r = 0; r <= NB; ++r) acc[r] += w[kk] * SC[r * DM + k]; } }
#pragma unroll
      for (int r = 0; r <= NB; ++r) *(LAS f32x4*)(PART + (ks * (NB + 1) + r) * 48 + 4 * c4) = acc[r];
    }
    blk_sync();
    if (t < (NB + 1) * 48) { const int r = t / 48, c = t % 48; float s = 0.f;
#pragma unroll 8
      for (int ks = 0; ks < 32; ++ks) s += PART[(ks * (NB + 1) + r) * 48 + c];
      ((float*)(p.ws + WS_MODV))[(size_t)(l * (NB + 1) + r) * 6144 + col0 + c] = s + p.in[I_MODB][l * 6144 + col0 + c]; }
    blk_sync();
  }
}

constexpr int CVT_LDT = 72;
template <class Src> DEV void cvt_tiles(LAS unsigned char* lds, bf16_t* Bt, int N, int K, int ldw, const Src& src, int first, int step) {
  const int t = tidx(), lane = t & 63, wid = t >> 6; const int ntn = N / 64, ntk = K / 256;
  for (int tile = first; tile < ntn * ntk; tile += step) {
    const int n0 = (tile % ntn) * 64, k0 = (tile / ntn) * 256;
    f32x4 v[8];
#pragma unroll
    for (int i = 0; i < 8; ++i) { const int kk = (t >> 4) + 32 * i, n4 = (t & 15) * 4; const float* s = src(n0 + n4);
      v[i] = (f32x4){0.f, 0.f, 0.f, 0.f}; if (s) v[i] = *(const f32x4*)(s + (size_t)(k0 + kk) * ldw); }
#pragma unroll
    for (int i = 0; i < 8; ++i) { const int kk = (t >> 4) + 32 * i, n4 = (t & 15) * 4; u32x2 o; o.x = pk2(v[i][0], v[i][1]); o.y = pk2(v[i][2], v[i][3]); *(LAS u32x2*)(lds + (kk * CVT_LDT + n4) * 2) = o; }
    blk_sync();
#pragma unroll
    for (int g = 0; g < 4; ++g) { const bf16x8 f = frag_tr(lds, CVT_LDT, 16 * g, 32 * wid, lane);
      *(bf16x8*)(Bt + (size_t)(n0 + 16 * g + (lane & 15)) * K + k0 + 32 * wid + 8 * (lane >> 4)) = f; }
    blk_sync();
  }
}
DEV void ph_convert_dense2(const P& p, LAS unsigned char* lds, int bid, int G) {
  cvt_tiles(lds, (bf16_t*)(p.ws + WS_WIN0), N0P, 1024, AB_IN, SrcWin0{p.in[I_ABIN]}, bid, G);
  cvt_tiles(lds, (bf16_t*)(p.ws + WS_WOUT0), 1024, 2048, 1024, SrcId{p.in[I_ABOUT]}, bid, G);
  cvt_tiles(lds, (bf16_t*)(p.ws + WS_WHGI), 5120, 1024, HG_IN, SrcId{p.in[I_HGIN]}, bid, G);
  cvt_tiles(lds, (bf16_t*)(p.ws + WS_WHGO), 1024, 1024, 1024, SrcId{p.in[I_HGOUT]}, bid, G);
}
DEV void ph_convert_moe2(const P& p, int l, LAS unsigned char* lds, int rank, int nconv) {
  if (rank < 0) return;
  for (int e = 0; e < NE; ++e) { const size_t eo = (size_t)(l * NE + e); const int first = (rank + nconv - (e * 16) % nconv) % nconv;
    cvt_tiles(lds, (bf16_t*)(p.ws + WS_WGU) + (size_t)e * 1024 * 1024, 1024, 1024, DE, SrcGU{p.in[I_WG] + eo * DM * DE, p.in[I_WU] + eo * DM * DE}, first, nconv);
    cvt_tiles(lds, (bf16_t*)(p.ws + WS_WDT) + (size_t)e * 1024 * 512, 1024, 512, DM, SrcId{p.in[I_WD] + eo * DE * DM}, (first + 64) % nconv, nconv); }
}

template <int LWX> DEV float wsumT(float v) { if constexpr (LWX == 1) return v; else return bwsum(v); }
DEV float reduce16_scatter(const float (&v)[16], int lane) {
  float a[8], b[4], c[2];
  { const bool hi = (lane & 32) != 0;
#pragma unroll
    for (int j = 0; j < 8; ++j) { const float mine = hi ? v[8 + j] : v[j], other = hi ? v[j] : v[8 + j]; a[j] = mine + wshfl(other, lane ^ 32); } }
  { const bool hi = (lane & 16) != 0;
#pragma unroll
    for (int j = 0; j < 4; ++j) { const float mine = hi ? a[4 + j] : a[j], other = hi ? a[j] : a[4 + j]; b[j] = mine + wshfl(other, lane ^ 16); } }
  { const bool hi = (lane & 8) != 0;
#pragma unroll
    for (int j = 0; j < 2; ++j) { const float mine = hi ? b[2 + j] : b[j], other = hi ? b[j] : b[2 + j]; c[j] = mine + wshfl(other, lane ^ 8); } }
  float d;
  { const bool hi = (lane & 4) != 0; const float mine = hi ? c[1] : c[0], other = hi ? c[0] : c[1]; d = mine + wshfl(other, lane ^ 4); }
  d += wshfl(d, lane ^ 2); d += wshfl(d, lane ^ 1);
  return d;
}
constexpr int RT_OFF_RW = 0, RT_OFF_LG = 16 * 1024 * 4, RT_OFF_LE = RT_OFF_LG + 8 * 2 * 16 * 4;
template <int LWX> DEV void norm_tokens(const P& p, int l, int mb, bool from_input, int comb, bool route, int r_begin, int r_end, int wave, int nwaves, int lane, LAS unsigned char* lds) {
  constexpr int NV = DM / 4 / LWX;
  bf16_t* H = (bf16_t*)(p.ws + WS_H);
  const float* g = p.in[mb == 0 ? I_NMIXG : I_NFFNG] + l * DM;
  const bf16_t* YS = (const bf16_t*)(p.ws + WS_YS);
  f32x4 pa[NV], pb[NV], pg5[NV]; int cur_mr = -1;
  for (long r0 = r_begin + 2 * wave; r0 < r_end; r0 += 2 * nwaves) {
    f32x4 xv[2][NV]; float ss[2];
#pragma unroll
    for (int q = 0; q < 2; ++q) { const long r = r0 + q; const int mr = tok_modrow((int)r); float* xc = xcur_row(p, (int)r); const float* x = from_input ? xin_row(p, (int)r) : xc;
      if (mr != cur_mr) { cur_mr = mr; const float* sh = modv(p, l, mr, mb), *sc = modv(p, l, mr, mb + 1);
#pragma unroll
        for (int i = 0; i < NV; ++i) { const int k = 4 * (lane + LWX * i); pa[i] = *(const f32x4*)(g + k) * (*(const f32x4*)(sc + k) + 1.f); pb[i] = *(const f32x4*)(sh + k); pg5[i] = comb >= 0 ? *(const f32x4*)(modv(p, comb, mr, 5) + k) : (f32x4){0.f, 0.f, 0.f, 0.f}; } }
      ss[q] = 0.f;
#pragma unroll
      for (int i = 0; i < NV; ++i) { const int k = 4 * (lane + LWX * i); f32x4 v = *(const f32x4*)(x + k);
        if (comb >= 0) { const u32x2 a = *(const u32x2*)(YS + (size_t)(2 * r) * DM + k), b = *(const u32x2*)(YS + (size_t)(2 * r + 1) * DM + k);
          v += pg5[i] * ((f32x4){bflo(a.x), bfhi(a.x), bflo(a.y), bfhi(a.y)} + (f32x4){bflo(b.x), bfhi(b.x), bflo(b.y), bfhi(b.y)}); }
        xv[q][i] = v; ss[q] += v[0] * v[0] + v[1] * v[1] + v[2] * v[2] + v[3] * v[3]; } }
    if (comb >= 0) {
#pragma unroll
      for (int q = 0; q < 2; ++q) { float* xc = xcur_row(p, (int)(r0 + q));
#pragma unroll
        for (int i = 0; i < NV; ++i) *(f32x4*)(xc + 4 * (lane + LWX * i)) = xv[q][i]; } }
#pragma unroll
    for (int q = 0; q < 2; ++q) { const long r = r0 + q;
      const float rstd = frsqrt(wsumT<LWX>(ss[q]) / DM + EPS);
#pragma unroll
      for (int i = 0; i < NV; ++i) { const int k = 4 * (lane + LWX * i);
        const f32x4 h = xv[q][i] * rstd * pa[i] + pb[i];
        u32x2 o; o.x = pk2(h[0], h[1]); o.y = pk2(h[2], h[3]); *(u32x2*)(H + (size_t)r * DM + k) = o; xv[q][i] = h; } }
    if constexpr (LWX == 64) if (route) {
      float lg[2][NE];
#pragma unroll
      for (int e = 0; e < NE; ++e) { lg[0][e] = 0.f; lg[1][e] = 0.f; }
      const LAS float* RWt = (const LAS float*)(lds + RT_OFF_RW);
#pragma unroll
      for (int i = 0; i < NV; ++i) { int k = 4 * (lane + LWX * i);
#pragma unroll
        for (int e = 0; e < NE; ++e) {
          const f32x4 w = *(const LAS f32x4*)(RWt + e * DM + k); const f32x4 a = xv[0][i] * w, b = xv[1][i] * w;
          lg[0][e] += (a[0] + a[1]) + (a[2] + a[3]); lg[1][e] += (b[0] + b[1]) + (b[2] + b[3]);
          if ((e & 3) == 3) OPAQUE_ACC8(k, lg[0][e - 3], lg[0][e - 2], lg[0][e - 1], lg[0][e], lg[1][e - 3], lg[1][e - 2], lg[1][e - 1], lg[1][e]); } }
      LAS float* LG = (LAS float*)(lds + RT_OFF_LG) + wave * 32;
#pragma unroll
      for (int q = 0; q < 2; ++q) { const float tot = reduce16_scatter(lg[q], lane); if ((lane & 3) == 0) LG[q * 16 + (lane >> 2)] = tot; }
      wave_sync();
      if (lane < 2) { const int q = lane; const long r = r0 + q; float s[NE], sel[NE];
#pragma unroll
        for (int e4 = 0; e4 < 4; ++e4) { const f32x4 v = *(const LAS f32x4*)(LG + q * 16 + 4 * e4);
#pragma unroll
          for (int j = 0; j < 4; ++j) { s[4 * e4 + j] = sigmoidf_(v[j]); sel[4 * e4 + j] = s[4 * e4 + j] + p.in[I_RB][4 * e4 + j]; } }
        int bg = 0; float bgs = -1e30f;
#pragma unroll
        for (int gq = 0; gq < 4; ++gq) {
          float m1 = -1e30f, m2 = -1e30f;
#pragma unroll
          for (int i = 0; i < 4; ++i) { const float v = sel[gq * 4 + i]; if (v > m1) { m2 = m1; m1 = v; } else if (v > m2) m2 = v; }
          const float gs = m1 + m2;
          if (gs > bgs) { bgs = gs; bg = gq; }
        }
        int i1 = 0, i2 = 0; float v1 = -1e30f, v2 = -1e30f; float s1 = 0.f, s2 = 0.f;
#pragma unroll
        for (int gq = 0; gq < 4; ++gq) if (gq == bg) {
#pragma unroll
          for (int i = 0; i < 4; ++i) { const float v = sel[gq * 4 + i]; if (v > v1) { v1 = v; i1 = i; s1 = s[gq * 4 + i]; } }
#pragma unroll
          for (int i = 0; i < 4; ++i) { const float v = sel[gq * 4 + i]; if (i != i1 && v > v2) { v2 = v; i2 = i; s2 = s[gq * 4 + i]; } }
        }
        int* EI = (int*)(p.ws + WS_EIDX); float* EW = (float*)(p.ws + WS_EW); LAS int* LE = (LAS int*)(lds + RT_OFF_LE);
        const int e1 = bg * 4 + i1, e2 = bg * 4 + i2;
        EI[r * 2] = e1; EI[r * 2 + 1] = e2;
        const float inv = fdiv(1.f, s1 + s2);
        EW[r * 2] = s1 * inv; EW[r * 2 + 1] = s2 * inv;
        LE[2 * (r - r_begin)] = e1; LE[2 * (r - r_begin) + 1] = e2; LAS float* LWt = (LAS float*)(LE + 256); LWt[2 * (r - r_begin)] = s1 * inv; LWt[2 * (r - r_begin) + 1] = s2 * inv;
      }
      wave_sync();
    }
  }
}
HD void ph_norm2(const P& p, int l, int mb, bool from_input, int ntok, int comb, long tid, long nth) {
  const int nblk = (int)(nth / NT), blk = (int)(tid / NT), wpb = NT / LW, tpb = ((ntok + nblk - 1) / nblk + 1) & ~1, rb = blk * tpb, re = rb + tpb < ntok ? rb + tpb : ntok;
  if (rb < re) norm_tokens<LW>(p, l, mb, from_input, comb, false, rb, re, (int)((tid % NT) / LW), wpb, LANE, nullptr);
}
DEV void ph_norm_route(const P& p, int l, int ntok, LAS unsigned char* lds, int bid, int G) {
  const int t = tidx(); LAS int* LE = (LAS int*)(lds + RT_OFF_LE);
  const int tpb = ((ntok + G - 1) / G + 1) & ~1, rb = bid * tpb, re = rb + tpb < ntok ? rb + tpb : ntok;
  { LAS float* RWt = (LAS float*)(lds + RT_OFF_RW); for (int i = t; i < NE * DM; i += NT) RWt[i] = p.in[I_RW][(i & (DM - 1)) * NE + (i >> 10)]; }
  blk_sync();
  if (rb < re) norm_tokens<64>(p, l, 3, false, -1, true, rb, re, t >> 6, NT / 64, t & 63, lds);
  blk_sync();
  { LAS int* WC = (LAS int*)(lds + RT_OFF_LG);
    const LAS float* LWt = (const LAS float*)(LE + 256); const int ns = 2 * (re - rb), wv = t >> 6, ln = t & 63;
    const int e = (rb < re && t < ns) ? LE[t] : -1; int rank = 0;
#pragma unroll
    for (int q = 0; q < NE; ++q) { const unsigned long long m = wballot(e == q); if (e == q) rank = __builtin_popcountll(m & ((1ull << ln) - 1ull)); if (ln == 0) WC[wv * NE + q] = __builtin_popcountll(m); }
    blk_sync();
    if (t < NE) { int tot = 0;
#pragma unroll
      for (int w = 0; w < NT / 64; ++w) tot += WC[w * NE + t];
      WC[128 + t] = tot > 0 ? atomicAdd((int*)(p.ws + WS_CTL) + l * NE + t, tot) : 0; }
    blk_sync();
    if (e >= 0) { int pos = WC[128 + e] + rank; for (int w = 0; w < wv; ++w) pos += WC[w * NE + e];
      ((int*)(p.ws + WS_RSLOT))[(size_t)e * MOE_CAP + pos] = 2 * rb + t; ((float*)(p.ws + WS_RW))[(size_t)e * MOE_CAP + pos] = LWt[t]; } }
  blk_sync();
}

HD void ph_conv5b(const P& p, long tid, long nth) {
  const bf16_t* XR = (const bf16_t*)(p.ws + WS_XR); bf16_t* XBC = (bf16_t*)(p.ws + WS_XBC);
  for (long it = tid; it < (long)(TT / 8) * 256; it += nth) {
    const int c = (int)(it & 255) * 8, r0 = (int)(it >> 8) * 8;
    int t0, L; tok_pos(r0, t0, L);
    u32x4 win[12];
#pragma unroll
    for (int k = 0; k < 12; ++k) { const int tt = t0 + k - 2; const bool ok = tt >= 0 && tt < L; const int tc = tt < 0 ? 0 : (tt >= L ? L - 1 : tt);
      u32x4 v = *(const u32x4*)(XR + (size_t)(r0 - t0 + tc) * 2048 + c); v.x = ok ? v.x : 0u; v.y = ok ? v.y : 0u; v.z = ok ? v.z : 0u; v.w = ok ? v.w : 0u; win[k] = v; }
    f32x4 w0[5], w1[5];
#pragma unroll
    for (int k = 0; k < 5; ++k) { w0[k] = *(const f32x4*)(p.in[I_SCW] + k * 2048 + c); w1[k] = *(const f32x4*)(p.in[I_SCW] + k * 2048 + c + 4); }
    const f32x4 b0 = *(const f32x4*)(p.in[I_SCB] + c), b1 = *(const f32x4*)(p.in[I_SCB] + c + 4);
#pragma unroll
    for (int j = 0; j < 8; ++j) {
      f32x4 a0 = b0, a1 = b1;
#pragma unroll
      for (int k = 0; k < 5; ++k) { a0 += bf4lo(win[j + k]) * w0[k]; a1 += bf4hi(win[j + k]) * w1[k]; }
      store_bf16x8(XBC + (size_t)(r0 + j) * 2048 + c, silu4(a0), silu4(a1));
    }
  }
}

constexpr int CF_TILES = TL / 64 + TC / 32;
DEV void ph_cf_fused(const P& p, LAS unsigned char* lds, int bid, int G) {
  const int t = tidx(), lane = t & 63, grp = t >> 6;
  const bf16_t* U = (const bf16_t*)(p.ws + WS_U); bf16_t* OC = (bf16_t*)(p.ws + WS_XR);
  for (int tile = bid; tile < CF_TILES; tile += G) {
    int row0, nout, wlo, whi;
    if (tile < TL / 64) { row0 = tile * 64; nout = 64; wlo = row0; whi = row0 + 64; }
    else { const int q = tile - TL / 64; row0 = TL + q * 32; nout = 32; const int seg0 = TL + (q * 32 / CTX) * CTX; wlo = row0 - 15 < seg0 ? seg0 : row0 - 15; whi = row0 + 32 + 15 > seg0 + CTX ? seg0 + CTX : row0 + 32 + 15; }
    const int nw = whi - wlo;
    { u32x4 xr[16];
#pragma unroll
      for (int i = 0; i < 16; ++i) { int v = (t + NT * i) & 4095; const int sl = i >> 3; v = v < nw * 64 ? v : nw * 64 - 1; xr[i] = *(const u32x4*)(U + (size_t)(wlo + (v >> 6)) * 1024 + sl * 512 + (v & 63) * 8); }
#pragma unroll
      for (int i = 0; i < 16; ++i) { const int v = (t + NT * i) & 4095, sl = i >> 3; if (v < nw * 64) *(LAS u32x4*)(lds + sl * 65536 + (v >> 6) * 1024 + (v & 63) * 16) = xr[i]; } }
    blk_sync();
#pragma unroll
    for (int sl = 0; sl < 2; ++sl) {
      const int ch = sl * 512 + t; LAS unsigned char* slab = lds + sl * 65536;
      unsigned WE[16], WO[16];
      { float w[32];
#pragma unroll
        for (int j = 0; j < 31; ++j) w[j] = p.in[I_CFW][j * 1024 + ch];
        w[31] = 0.f;
#pragma unroll
        for (int q = 0; q < 16; ++q) { WE[q] = pk2(q ? w[2 * q - 1] : 0.f, w[2 * q]); WO[q] = pk2(w[2 * q], w[2 * q + 1]); } }
      unsigned X[48];
#pragma unroll
      for (int w = 0; w < 48; ++w) { const int r0_ = row0 + 2 * w - 16, r1_ = r0_ + 1; const bool ok0 = r0_ >= wlo && r0_ < whi, ok1 = r1_ >= wlo && r1_ < whi;
        const int c0 = r0_ < wlo ? wlo : (r0_ >= whi ? whi - 1 : r0_), c1 = r1_ < wlo ? wlo : (r1_ >= whi ? whi - 1 : r1_);
        const unsigned lo = *(const LAS bf16_t*)(slab + (c0 - wlo) * 1024 + t * 2), hi = *(const LAS bf16_t*)(slab + (c1 - wlo) * 1024 + t * 2);
        X[w] = (ok0 ? lo : 0u) | ((ok1 ? hi : 0u) << 16); }
      blk_sync();
      const float cb = p.in[I_CFB][ch];
#pragma unroll
      for (int l = 0; l < 64; l += 2) {
        float ae = cb, ao = cb;
#pragma unroll
        for (int q = 0; q < 16; ++q) { ae = dot2bf(X[l / 2 + q], WE[q], ae); ao = dot2bf(X[l / 2 + 1 + q], WO[q], ao); }
        const unsigned pr = pk2(ae, ao);
        *(LAS bf16_t*)(slab + l * 1024 + t * 2) = (bf16_t)(pr & 0xffffu); *(LAS bf16_t*)(slab + (l + 1) * 1024 + t * 2) = (bf16_t)(pr >> 16);
      }
    }
    blk_sync();
    {
      for (int i0 = 0; i0 < nout / 8; i0 += 2) {
        f32x4 a[2][4], g4[4], b4[4]; float s[2], q[2]; int lc = lane * 8; OPAQUE_INT(lc);
#pragma unroll
        for (int k = 0; k < 4; ++k) { const int c = (k >> 1) * 512 + lc + (k & 1) * 4; g4[k] = *(const f32x4*)(p.in[I_CFLG] + c); b4[k] = *(const f32x4*)(p.in[I_CFLB] + c); }
#pragma unroll
        for (int u = 0; u < 2; ++u) { const int l = grp + 8 * (i0 + u);
          const u32x4 v0 = *(const LAS u32x4*)(lds + l * 1024 + lane * 16), v1 = *(const LAS u32x4*)(lds + 65536 + l * 1024 + lane * 16);
          a[u][0] = bf4lo(v0); a[u][1] = bf4hi(v0); a[u][2] = bf4lo(v1); a[u][3] = bf4hi(v1); s[u] = 0.f;
#pragma unroll
          for (int k = 0; k < 4; ++k) s[u] += (a[u][k][0] + a[u][k][1]) + (a[u][k][2] + a[u][k][3]); }
#pragma unroll
        for (int u = 0; u < 2; ++u) s[u] = bwsum(s[u]) * (1.f / 1024.f);
#pragma unroll
        for (int u = 0; u < 2; ++u) { q[u] = 0.f;
#pragma unroll
          for (int k = 0; k < 4; ++k) { a[u][k] -= s[u]; q[u] += (a[u][k][0] * a[u][k][0] + a[u][k][1] * a[u][k][1]) + (a[u][k][2] * a[u][k][2] + a[u][k][3] * a[u][k][3]); } }
#pragma unroll
        for (int u = 0; u < 2; ++u) q[u] = frsqrt(bwsum(q[u]) * (1.f / 1024.f) + EPS);
#pragma unroll
        for (int u = 0; u < 2; ++u) { const int l = grp + 8 * (i0 + u);
#pragma unroll
          for (int sl = 0; sl < 2; ++sl) store_bf16x8(OC + (size_t)(row0 + l) * 2048 + 1024 + sl * 512 + lane * 8, silu4(a[u][2 * sl] * q[u] * g4[2 * sl] + b4[2 * sl]), silu4(a[u][2 * sl + 1] * q[u] * g4[2 * sl + 1] + b4[2 * sl + 1])); }
      } }
    blk_sync();
  }
}

HD void ph_ssd_readout3(const P& p, long tid, long nth) {
  constexpr int NV = 1024 / 8 / LW;
  const bf16_t* Y0 = (const bf16_t*)(p.ws + WS_Y); const bf16_t* Y1 = Y0 + (size_t)TT * 1024; const bf16_t* Z = (const bf16_t*)(p.ws + WS_Z); bf16_t* OC = (bf16_t*)(p.ws + WS_XR);
  const int lane = LANE;
  f32x4 gn0[NV], gn1[NV];
#pragma unroll
  for (int i = 0; i < NV; ++i) { const int k = 8 * (lane + LW * i); gn0[i] = *(const f32x4*)(p.in[I_SSDG] + k); gn1[i] = *(const f32x4*)(p.in[I_SSDG] + k + 4); }
  for (long r = tid / LW; r < TT; r += nth / LW) {
    f32x4 v0[NV], v1[NV]; float ss = 0.f;
#pragma unroll
    for (int i = 0; i < NV; ++i) { const size_t o = (size_t)r * 1024 + 8 * (lane + LW * i); const u32x4 a = *(const u32x4*)(Y0 + o), b = *(const u32x4*)(Y1 + o), z = *(const u32x4*)(Z + o);
      v0[i] = (bf4lo(a) + bf4lo(b)) * silu4(bf4lo(z)); v1[i] = (bf4hi(a) + bf4hi(b)) * silu4(bf4hi(z));
      ss += (v0[i][0] * v0[i][0] + v0[i][1] * v0[i][1]) + (v0[i][2] * v0[i][2] + v0[i][3] * v0[i][3]) + (v1[i][0] * v1[i][0] + v1[i][1] * v1[i][1]) + (v1[i][2] * v1[i][2] + v1[i][3] * v1[i][3]); }
    const float rstd = frsqrt(wsum(ss) / 1024.f + EPS);
#pragma unroll
    for (int i = 0; i < NV; ++i) { const int k = 8 * (lane + LW * i); store_bf16x8(OC + (size_t)r * 2048 + k, v0[i] * rstd * gn0[i], v1[i] * rstd * gn1[i]); }
  }
}
HD void ph_hg_readout3(const P& p, long tid, long nth) {
  constexpr int GL = LW >= 16 ? 16 : 1;
  constexpr int NV = 16 / GL;
  const bf16_t* O0 = (const bf16_t*)(p.ws + WS_O); const bf16_t* O1 = O0 + (size_t)TL * 1024; const bf16_t* P1 = (const bf16_t*)(p.ws + WS_P1); bf16_t* RO = (bf16_t*)(p.ws + WS_H);
  const int sub = (int)(tid % GL);
  f32x4 hn0[NV], hn1[NV];
#pragma unroll
  for (int i = 0; i < NV; ++i) { const int vv = 8 * (sub + GL * i); hn0[i] = *(const f32x4*)(p.in[I_HGNG] + vv); hn1[i] = *(const f32x4*)(p.in[I_HGNG] + vv + 4); }
  for (long it = tid / GL; it < (long)TL * 8; it += nth / GL) {
    const size_t base = (size_t)(it >> 3) * 1024 + (it & 7) * 128;
    f32x4 v0[NV], v1[NV]; float ss = 0.f;
#pragma unroll
    for (int i = 0; i < NV; ++i) { const size_t o = base + 8 * (sub + GL * i); const u32x4 a = *(const u32x4*)(O0 + o), b = *(const u32x4*)(O1 + o);
      v0[i] = bf4lo(a) + bf4lo(b); v1[i] = bf4hi(a) + bf4hi(b);
      ss += (v0[i][0] * v0[i][0] + v0[i][1] * v0[i][1]) + (v0[i][2] * v0[i][2] + v0[i][3] * v0[i][3]) + (v1[i][0] * v1[i][0] + v1[i][1] * v1[i][1]) + (v1[i][2] * v1[i][2] + v1[i][3] * v1[i][3]); }
    ss = gsum16(ss);
    const float rstd = frsqrt(ss / 128.f + EPS);
#pragma unroll
    for (int i = 0; i < NV; ++i) { const int vv = 8 * (sub + GL * i); const u32x4 gt = *(const u32x4*)(P1 + (size_t)(it >> 3) * 5120 + 1024 + (it & 7) * 128 + vv);
      store_bf16x8(RO + base + vv, v0[i] * rstd * hn0[i] * silu4(bf4lo(gt)), v1[i] * rstd * hn1[i] * silu4(bf4hi(gt))); }
  }
}
HD void ph_final2(const P& p, long tid, long nth) {
  constexpr int NV = DM / 4 / LW;
  const bf16_t* YS = (const bf16_t*)(p.ws + WS_YS); const int lane = LANE;
  f32x4 fg[NV];
#pragma unroll
  for (int i = 0; i < NV; ++i) fg[i] = *(const f32x4*)(p.in[I_FNG] + 4 * (lane + LW * i));
  for (long r = tid / LW; r < TL; r += nth / LW) {
    float* x = p.out + (size_t)r * DM; const float* g5 = modv(p, 1, tok_modrow((int)r), 5); f32x4 xv[NV]; float ss = 0.f;
#pragma unroll
    for (int i = 0; i < NV; ++i) { const int k = 4 * (lane + LW * i); const u32x2 a = *(const u32x2*)(YS + (size_t)(2 * r) * DM + k), b = *(const u32x2*)(YS + (size_t)(2 * r + 1) * DM + k);
      const f32x4 v = *(const f32x4*)(x + k) + *(const f32x4*)(g5 + k) * ((f32x4){bflo(a.x), bfhi(a.x), bflo(a.y), bfhi(a.y)} + (f32x4){bflo(b.x), bfhi(b.x), bflo(b.y), bfhi(b.y)});
      xv[i] = v; ss += v[0] * v[0] + v[1] * v[1] + v[2] * v[2] + v[3] * v[3]; }
    const float rstd = frsqrt(wsum(ss) / DM + EPS);
#pragma unroll
    for (int i = 0; i < NV; ++i) { const int k = 4 * (lane + LW * i); *(f32x4*)(x + k) = xv[i] * rstd * fg[i]; }
  }
}

#define OUTPROJ0_CVT_N(G) (((TT / 256) * 4 > (G) && (TT / 256) * 4 < 2 * (G)) ? 2 * (G) - (TT / 256) * 4 : (G))
#define OUTPROJ0_CVT_RANK(bid, G) (((TT / 256) * 4 > (G) && (TT / 256) * 4 < 2 * (G)) ? (bid) - ((TT / 256) * 4 - (G)) : (bid))
#define PROGRAM(T, B, SYNC) \
  B(ph_mod2(p, LDSP, bid, G)) B(ph_convert_dense2(p, LDSP, bid, G)) SYNC \
  T(ph_norm2(p, 0, 0, true, TT, -1, tid, nth)) SYNC \
  B(ph_gemm_inproj0(p, lds, bid, G)) SYNC \
  T(ph_conv5b(p, tid, nth)) SYNC \
  B(ph_ssd_chunked(p, LDSP, bid, G)) B(ph_cf_fused(p, LDSP, bid, G)) SYNC \
  T(ph_ssd_readout3(p, tid, nth)) SYNC \
  B(ph_gemm_outproj0(p, lds, bid, G)) B(ph_convert_moe2(p, 0, LDSP, OUTPROJ0_CVT_RANK(bid, G), OUTPROJ0_CVT_N(G))) SYNC \
  B(ph_norm_route(p, 0, TT, LDSP, bid, G)) SYNC \
  B(ph_gemm_moe1(p, 0, lds, bid, G)) SYNC \
  B(ph_gemm_moe2(p, 0, lds, bid, G)) SYNC \
  T(ph_norm2(p, 1, 0, false, TT, 0, tid, nth)) SYNC \
  B(ph_gemm_inproj1(p, lds, bid, G)) SYNC \
  B(ph_hg_chunked(p, LDSP, bid, G)) SYNC \
  T(ph_hg_readout3(p, tid, nth)) SYNC \
  B(ph_gemm_outproj1(p, lds, bid, G)) SYNC \
  B(ph_norm_route(p, 1, TL, LDSP, bid, G)) B(ph_convert_moe2(p, 1, LDSP, bid, G)) SYNC \
  B(ph_gemm_moe1(p, 1, lds, bid, G)) SYNC \
  B(ph_gemm_moe2(p, 1, lds, bid, G)) SYNC \
  T(ph_final2(p, tid, nth))

#ifndef CPU_TEST
#define XB_TMO      128
#define XB_XCNT(j)  (256  + 64 * (j))
#define XB_XSUB(j)  (1280 + 64 * (j))
#define XB_XGEN(j)  (2304 + 64 * (j))
#define XB_TOP      3328
#define XB_TOPGEN   3392
#define XCD_BAR_WORDS 3456
#define XB_SPIN_CAP (1u << 18)

__device__ __forceinline__ unsigned xb_ld(unsigned* p)              { return __hip_atomic_load(p, __ATOMIC_RELAXED, __HIP_MEMORY_SCOPE_AGENT); }
__device__ __forceinline__ unsigned xb_add(unsigned* p, unsigned v) { return __hip_atomic_fetch_add(p, v, __ATOMIC_RELAXED, __HIP_MEMORY_SCOPE_AGENT); }
__device__ __forceinline__ unsigned xb_xcc_id() { return (unsigned)__builtin_amdgcn_s_getreg((3 << 11) | 20) & 0xFu; }
#define XB_SPIN(cond, bar) do { unsigned _sp = 0; while (cond) { __builtin_amdgcn_s_sleep(1); \
    if ((++_sp & 255u) == 0u) { if (xb_ld(&(bar)[XB_TMO])) break; if (_sp > XB_SPIN_CAP) { atomicAdd(&(bar)[XB_TMO], 1u); break; } } } } while (0)

struct XcdBarrier {
    unsigned* bar; unsigned x;
    volatile LAS unsigned* st;
};

__device__ __forceinline__ XcdBarrier xcd_barrier_post(unsigned* bar, volatile LAS unsigned* st) {
    XcdBarrier b; b.bar = bar; b.x = xb_xcc_id(); b.st = st;
    if (threadIdx.x == 0) (void)xb_add(&bar[XB_XCNT(b.x)], 1u);
    return b;
}
__device__ __forceinline__ void xcd_barrier_complete(unsigned* bar, unsigned x, unsigned& nloc, unsigned& nx) {
    const unsigned G = gridDim.x * gridDim.y * gridDim.z;
    unsigned sum, cnt, mine, sp = 0u;
    for (;;) {
        sum = 0u; cnt = 0u; mine = 0u;
#pragma unroll
        for (unsigned j = 0; j < 16; ++j) { const unsigned c = xb_ld(&bar[XB_XCNT(j)]); sum += c; cnt += (c > 0u) ? 1u : 0u; mine = (j == x) ? c : mine; }
        if (sum == G) break;
        __builtin_amdgcn_s_sleep(1);
        if ((++sp & 255u) == 0u) { if (xb_ld(&bar[XB_TMO])) break; if (sp > XB_SPIN_CAP) { atomicAdd(&bar[XB_TMO], 1u); break; } }
    }
    nloc = mine > 0u ? mine : 1u; nx = cnt > 0u ? cnt : 1u;
}

__device__ __forceinline__ void xcd_barrier(const XcdBarrier& b) {
    asm volatile("s_waitcnt vmcnt(0)" ::: "memory");
    __syncthreads();
    if (threadIdx.x == 0) {
        unsigned* bar = b.bar;
        __builtin_amdgcn_s_waitcnt(0);
        unsigned nloc = b.st[0], nx = b.st[1];
        if (nloc == 0u) { xcd_barrier_complete(bar, b.x, nloc, nx); b.st[0] = nloc; b.st[1] = nx; }
        const unsigned old = xb_add(&bar[XB_XSUB(b.x)], 1u);
        const unsigned gen = old / nloc;
        if (old + 1u == (gen + 1u) * nloc) {
            __builtin_amdgcn_fence(__ATOMIC_RELEASE, "agent");
            asm volatile("s_waitcnt vmcnt(0)" ::: "memory");
            const unsigned og = xb_add(&bar[XB_TOP], 1u);
            const unsigned tg = og / nx;
            if (og + 1u == (tg + 1u) * nx) xb_add(&bar[XB_TOPGEN], 1u);
            else XB_SPIN(xb_ld(&bar[XB_TOPGEN]) == tg, bar);
            __builtin_amdgcn_fence(__ATOMIC_ACQUIRE, "agent");
            xb_add(&bar[XB_XGEN(b.x)], 1u);
            asm volatile("s_waitcnt vmcnt(0)" ::: "memory");
        } else {
            XB_SPIN(xb_ld(&bar[XB_XGEN(b.x)]) == gen, bar);
            __builtin_amdgcn_fence(__ATOMIC_ACQUIRE, "agent");
            asm volatile("s_waitcnt vmcnt(0)" ::: "memory");
        }
    }
    __syncthreads();
}

#endif

#ifndef CPU_TEST
__global__ void __launch_bounds__(NT) mega(P p) {
  extern __shared__ __attribute__((aligned(16))) unsigned char lds[];
  cg::grid_group grid = cg::this_grid();
  const long nth = (long)gridDim.x * NT;
  const int bid = blockIdx.x, G = gridDim.x;
#define LDSP ((LAS unsigned char*)lds)
#define T_(stmt_) { const long tid = (long)blockIdx.x * NT + tidx(); stmt_; }
#define B_(stmt_) stmt_;
  volatile LAS unsigned* xb_st = (volatile LAS unsigned*)(LDSP + LDS_BYTES - 64);
  if (threadIdx.x < 2) xb_st[threadIdx.x] = 0u;
  if (blockIdx.x == 0) for (int i = threadIdx.x; i < XCD_BAR_WORDS; i += NT) ((unsigned*)(p.ws + WS_BAR))[i] = 0u;
  grid.sync();
  const XcdBarrier xbar = xcd_barrier_post((unsigned*)(p.ws + WS_BAR), xb_st);
#define S_ xcd_barrier(xbar);
  PROGRAM(T_, B_, S_)
}

extern "C" void kernel_launch(void* const* d_in, const int* in_sizes, int n_in, void* d_out, int out_size,
                              void* d_ws, size_t ws_size, hipStream_t stream) {
  static int grid_blocks = 0;
  if (!grid_blocks) {
    int dev = 0, cus = 0, per_cu = 0;
    (void)hipGetDevice(&dev);
    (void)hipDeviceGetAttribute(&cus, hipDeviceAttributeMultiprocessorCount, dev);
    (void)hipFuncSetAttribute((const void*)mega, hipFuncAttributeMaxDynamicSharedMemorySize, LDS_BYTES);
    (void)hipOccupancyMaxActiveBlocksPerMultiprocessor(&per_cu, (const void*)mega, NT, LDS_BYTES);
    if (per_cu < 1) per_cu = 1;
    grid_blocks = cus * per_cu;
    if (n_in != N_IN || out_size != TL * DM || ws_size < WS_NEED) { fprintf(stderr, "kernel_launch: bad sizes n_in=%d out=%d ws=%zu need=%zu\n", n_in, out_size, ws_size, (size_t)WS_NEED); grid_blocks = -1; }
  }
  if (grid_blocks < 0) return;
  P p{};
  for (int i = 0; i < N_IN; ++i) p.in[i] = (const float*)d_in[i];
  p.out = (float*)d_out; p.ws = (unsigned char*)d_ws;
  void* args[] = {&p};
  hipError_t e = hipLaunchCooperativeKernel((const void*)mega, dim3(grid_blocks), dim3(NT), args, LDS_BYTES, stream);
  if (e != hipSuccess) fprintf(stderr, "cooperative launch failed: %s (grid %d)\n", hipGetErrorString(e), grid_blocks);
}
#endif
```

```cpp
#ifndef CPU_TEST
#include <hip/hip_runtime.h>
#include <hip/hip_cooperative_groups.h>
namespace cg = cooperative_groups;
#define HD __host__ __device__ __forceinline__
#define DEV __device__ __forceinline__
#else
#define HD inline
#define DEV inline
#endif
#include <cstdio>
#include <cstdint>
#include <cmath>

#ifndef CFG_B
#define CFG_B 8
#define CFG_SEQ 2048
#define CFG_CTX 256
#endif
constexpr int NB = CFG_B, SEQ = CFG_SEQ, CTX = CFG_CTX, DM = 1024, GW = 64, ROWS = SEQ / GW;
constexpr int TL = NB * SEQ, TC = NB * CTX, TT = TL + TC;
constexpr int AB_IN = 5152, HG_IN = 5120, NE = 16, DE = 512;
constexpr float EPS = 1e-6f;
constexpr int NT = 512;
constexpr int LDS_BYTES = 147456;
static_assert(SEQ % 256 == 0 && CTX % 256 == 0, "token tiles of 256 must not straddle sequences");

typedef unsigned short bf16_t;
typedef float f32x4 __attribute__((ext_vector_type(4)));
typedef unsigned u32x4 __attribute__((ext_vector_type(4)));
HD float bf2f(bf16_t h) { unsigned u = (unsigned)h << 16; return __builtin_bit_cast(float, u); }
HD unsigned f2bfu(float f) { unsigned u = __builtin_bit_cast(unsigned, f); return (u + 0x7fffu + ((u >> 16) & 1u)) >> 16; }
HD bf16_t f2bf(float f) { return (bf16_t)f2bfu(f); }
#if defined(__HIP_DEVICE_COMPILE__)
typedef float f32x2_t __attribute__((ext_vector_type(2)));
typedef __bf16 bf16x2_t __attribute__((ext_vector_type(2)));
DEV unsigned pk2(float lo, float hi) { return __builtin_bit_cast(unsigned, __builtin_convertvector((f32x2_t){lo, hi}, bf16x2_t)); }
#else
HD unsigned pk2(float lo, float hi) { return f2bfu(lo) | (f2bfu(hi) << 16); }
#endif
HD float bflo(unsigned w) { return __builtin_bit_cast(float, w << 16); }
HD float bfhi(unsigned w) { return __builtin_bit_cast(float, w & 0xffff0000u); }
HD f32x4 bf4lo(u32x4 v) { return (f32x4){bflo(v.x), bfhi(v.x), bflo(v.y), bfhi(v.y)}; }
HD f32x4 bf4hi(u32x4 v) { return (f32x4){bflo(v.z), bfhi(v.z), bflo(v.w), bfhi(v.w)}; }
HD void store_bf16x8(bf16_t* dst, f32x4 a, f32x4 b) { u32x4 w; w.x = pk2(a[0], a[1]); w.y = pk2(a[2], a[3]); w.z = pk2(b[0], b[1]); w.w = pk2(b[2], b[3]); *(u32x4*)dst = w; }
#ifndef CPU_TEST
#define CHUNK_FENCE() asm volatile("" ::: "memory")
#define OPAQUE_INT(v) asm volatile("" : "+v"(v))
#define OPAQUE_ACC8(k, a0, a1, a2, a3, a4, a5, a6, a7) asm volatile("" : "+v"(k), "+v"(a0), "+v"(a1), "+v"(a2), "+v"(a3), "+v"(a4), "+v"(a5), "+v"(a6), "+v"(a7))
constexpr int LW = 64;
DEV int tidx() { int t = threadIdx.x; asm volatile("" : "+v"(t)); return t; }
#define LANE (tidx() & 63)
DEV float wsum(float v) { for (int o = 32; o; o >>= 1) v += __shfl_xor(v, o); return v; }
DEV float gsum16(float v) { for (int o = 8; o; o >>= 1) v += __shfl_xor(v, o); return v; }
DEV int atomic_inc_int(int* p) { return atomicAdd(p, 1); }
#else
inline int tidx() { return emu_tid(); }
#define CHUNK_FENCE()
#define OPAQUE_INT(v)
#define OPAQUE_ACC8(k, a0, a1, a2, a3, a4, a5, a6, a7)
constexpr int LW = 1;
#define LANE 0
inline float wsum(float v) { return v; }
inline float gsum16(float v) { return v; }
inline int atomic_inc_int(int* p) { return __atomic_fetch_add(p, 1, __ATOMIC_RELAXED); }
inline int atomicAdd(int* p, int v) { return __atomic_fetch_add(p, v, __ATOMIC_RELAXED); }
#endif
#if defined(__HIP_DEVICE_COMPILE__)
DEV float fexp(float x) { return __expf(x); }
DEV float flog(float x) { return __logf(x); }
DEV float fdiv(float a, float b) { return a * __builtin_amdgcn_rcpf(b); }
DEV float frsqrt(float x) { return __builtin_amdgcn_rsqf(x); }
#else
HD float fexp(float x) { return expf(x); }
HD float flog(float x) { return logf(x); }
HD float fdiv(float a, float b) { return a / b; }
HD float frsqrt(float x) { return 1.f / sqrtf(x); }
#endif
HD float sigmoidf_(float x) { return fdiv(1.f, 1.f + fexp(-x)); }
HD float siluf_(float x) { return fdiv(x, 1.f + fexp(-x)); }
HD float softplusf_(float x) { return x > 20.f ? x : flog(1.f + fexp(x)); }

enum { I_X, I_C, I_CTX, I_CCTX, I_MODW, I_MODB, I_NMIXG, I_NFFNG, I_RW, I_RB, I_WG, I_WU, I_WD, I_ABIN, I_SCW, I_SCB, I_DTB, I_ALOG, I_SSDD, I_SSDG,
       I_CFW, I_CFB, I_CFLG, I_CFLB, I_ABOUT, I_HGIN, I_HGLB, I_HGNG, I_HGOUT, I_FNG, N_IN };

constexpr size_t al256(size_t x) { return (x + 255) & ~(size_t)255; }
constexpr int NROWS_MAX = 2 * TT + NE * 256;
constexpr int N0P = 5376;
constexpr size_t WS_CTL = 0;
constexpr size_t WS_BAR = 1024;
constexpr size_t WS_LB = 16384;
constexpr size_t WS_MODV = 16384 + 4096;
constexpr size_t WS_DT = al256(WS_MODV + (size_t)2 * (NB + 1) * 6144 * 4);
constexpr size_t WS_XC = al256(WS_DT + (size_t)TT * 32 * 4);
constexpr size_t WS_EIDX = al256(WS_XC + (size_t)TC * DM * 4);
constexpr size_t WS_EW = al256(WS_EIDX + (size_t)TT * 2 * 4);
constexpr size_t WS_EPOS = al256(WS_EW + (size_t)TT * 2 * 4);
constexpr int MOE_CAP = TT;
constexpr size_t WS_RSLOT = al256(WS_EPOS + (size_t)TT * 2 * 4);
constexpr size_t WS_RW = al256(WS_RSLOT + (size_t)NE * MOE_CAP * 4);
constexpr size_t WS_WIN0 = al256(WS_RW + (size_t)NE * MOE_CAP * 4);
constexpr size_t WS_WOUT0 = al256(WS_WIN0 + (size_t)N0P * 1024 * 2);
constexpr size_t WS_WHGI = al256(WS_WOUT0 + (size_t)1024 * 2048 * 2);
constexpr size_t WS_WHGO = al256(WS_WHGI + (size_t)5120 * 1024 * 2);
constexpr size_t WS_H = al256(WS_WHGO + (size_t)1024 * 1024 * 2);
constexpr size_t WS_R = al256(WS_H + (size_t)TT * DM * 2);
constexpr size_t WS_Z = WS_R;
constexpr size_t WS_XR = al256(WS_Z + (size_t)TT * 1024 * 2);
constexpr size_t WS_U = al256(WS_XR + (size_t)TT * 2048 * 2);
constexpr size_t WS_XBC = al256(WS_U + (size_t)TT * 1024 * 2);
constexpr size_t WS_Y = al256(WS_XBC + (size_t)TT * 2048 * 2);
constexpr size_t WS_END0 = al256(WS_Y + (size_t)TT * 1024 * 4);
constexpr size_t WS_ACT = WS_R;
constexpr size_t WS_WGU = WS_XBC > al256(WS_ACT + (size_t)NROWS_MAX * 512 * 2) ? WS_XBC : al256(WS_ACT + (size_t)NROWS_MAX * 512 * 2);
constexpr size_t WS_WDT = al256(WS_WGU + (size_t)NE * 1024 * 1024 * 2);
constexpr size_t WS_YS = al256(WS_WDT + (size_t)NE * 1024 * 512 * 2);
constexpr size_t WS_ENDM = al256(WS_YS + (size_t)2 * TT * 1024 * 2);
static_assert(WS_ACT + (size_t)NROWS_MAX * 512 * 2 <= WS_WGU && (CFG_B != 8 || WS_WGU == WS_XBC), "MoE map");
constexpr size_t WS_P1 = WS_R;
constexpr size_t WS_O = al256(WS_P1 + (size_t)TT * 5120 * 2);
constexpr size_t WS_END1 = al256(WS_O + (size_t)TL * 1024 * 4);
constexpr size_t cmax(size_t a, size_t b) { return a > b ? a : b; }
constexpr size_t WS_NEED = cmax(WS_END0, cmax(WS_ENDM, WS_END1));
static_assert(WS_YS >= WS_O || true, "");

struct P { const float* in[N_IN]; float* out; unsigned char* ws; };

HD int tok_modrow(int r) { return r < TL ? r / SEQ : NB; }
HD const float* xin_row(const P& p, int r) { return r < TL ? p.in[I_X] + (size_t)r * DM : p.in[I_CTX] + (size_t)(r - TL) * DM; }
HD float* xcur_row(const P& p, int r) { return r < TL ? p.out + (size_t)r * DM : (float*)(p.ws + WS_XC) + (size_t)(r - TL) * DM; }
HD const float* modv(const P& p, int l, int row, int m) { return (const float*)(p.ws + WS_MODV) + ((size_t)(l * (NB + 1) + row) * 6 + m) * DM; }

struct SrcWin0 { const float* W; HD const float* operator()(int n) const {
    if (n < 3072) return W + n;
    if (n < 5120) { const int m = n - 3072, t = m >> 8, w = m & 255; return w < 128 ? W + 3104 + t * 128 + w : W + 4128 + t * 128 + (w - 128); }
    if (n < 5152) return W + 3072 + (n - 5120);
    return nullptr; } };
struct SrcId { const float* W; HD const float* operator()(int n) const { return W + n; } };
struct SrcGU { const float* Wg; const float* Wu; HD const float* operator()(int n) const { const int t = n >> 8, w = n & 255; return w < 128 ? Wg + t * 128 + w : Wu + t * 128 + (w - 128); } };


HD int moe_base(const int* CNT, int e) { int b = 0; for (int i = 0; i < NE; ++i) if (i < e) b += (CNT[i] + 255) & ~255; return b; }

typedef short bf16x8 __attribute__((ext_vector_type(8)));
typedef short s16x4 __attribute__((ext_vector_type(4)));
typedef unsigned u32x2 __attribute__((ext_vector_type(2)));
#ifndef CPU_TEST
#define LAS __attribute__((address_space(3)))
DEV void blk_sync() { asm volatile("s_waitcnt lgkmcnt(0)" ::: "memory"); __builtin_amdgcn_s_barrier(); asm volatile("" ::: "memory"); }
DEV float wshfl(float v, int src) { return __shfl(v, src); }
DEV unsigned long long wballot(bool pred) { return __ballot(pred); }
DEV void wave_sync() { asm volatile("s_waitcnt lgkmcnt(0)" ::: "memory"); __builtin_amdgcn_wave_barrier(); asm volatile("" ::: "memory"); }
DEV float bwsum(float v) { for (int o = 32; o; o >>= 1) v += __shfl_xor(v, o); return v; }
DEV f32x4 mfma16(bf16x8 a, bf16x8 b, f32x4 c) { return __builtin_amdgcn_mfma_f32_16x16x32_bf16(a, b, c, 0, 0, 0); }
DEV s16x4 lds_tr4(const LAS unsigned char* p) { return __builtin_amdgcn_ds_read_tr16_b64_v4i16((LAS s16x4*)p); }
#else
#define LAS
inline void blk_sync() { emu_block_barrier(); }
inline float wshfl(float v, int src) { return emu_shfl(v, src); }
inline unsigned long long wballot(bool pred) { return emu_ballot(pred); }
inline void wave_sync() { emu_wave_barrier(); }
inline float bwsum(float v) { for (int o = 32; o; o >>= 1) v += emu_shfl(v, (emu_tid() & 63) ^ o); return v; }
inline f32x4 mfma16(bf16x8 a, bf16x8 b, f32x4 c) { return emu_mfma_16x16x32(a, b, c); }
inline s16x4 lds_tr4(const unsigned char* p) { return emu_tr_read(p); }
#endif
DEV bf16x8 frag_row(const LAS unsigned char* m, int ld, int R0, int K0, int lane) { return *(const LAS bf16x8*)(m + ((R0 + (lane & 15)) * ld + K0 + 8 * (lane >> 4)) * 2); }
DEV bf16x8 frag_tr(const LAS unsigned char* m, int ld, int R0, int K0, int lane) {
  const int fq = lane >> 4, qq = (lane & 15) >> 2, pp = lane & 3;
  const LAS unsigned char* a = m + ((K0 + 8 * fq + qq) * ld + R0 + 4 * pp) * 2;
  const s16x4 lo = lds_tr4(a), hi = lds_tr4(a + 4 * ld * 2);
  return (bf16x8){lo[0], lo[1], lo[2], lo[3], hi[0], hi[1], hi[2], hi[3]};
}
#if defined(__HIP_DEVICE_COMPILE__)
DEV float dot2bf(unsigned a, unsigned b, float c) { return __builtin_amdgcn_fdot2_f32_bf16(__builtin_bit_cast(bf16x2_t, a), __builtin_bit_cast(bf16x2_t, b), c, false); }
#else
HD float dot2bf(unsigned a, unsigned b, float c) { return c + bflo(a) * bflo(b) + bfhi(a) * bfhi(b); }
#endif
DEV void store_lds8(LAS unsigned char* p, f32x4 a, f32x4 b) { u32x4 w; w.x = pk2(a[0], a[1]); w.y = pk2(a[2], a[3]); w.z = pk2(b[0], b[1]); w.w = pk2(b[2], b[3]); *(LAS u32x4*)p = w; }
DEV void lds_store_bf16x4(LAS unsigned char* p, f32x4 v) { u32x2 w; w.x = pk2(v[0], v[1]); w.y = pk2(v[2], v[3]); *(LAS u32x2*)p = w; }

namespace pg8 {
typedef short bf16x8 __attribute__((ext_vector_type(8)));
constexpr int BM = 256, BK = 64, HALF = 128, HTB = HALF * BK * 2, STAGE_BYTES = 8 * HTB, NXCD = 8, WGM = 8;
HD int lds_byte(int r, int c) { const int st = (r >> 4) * 2 + (c >> 5), rr = r & 15, cc = c & 31, ob = rr * 64 + cc * 2; return st * 1024 + (ob ^ (((ob >> 9) & 1) << 5)); }
HD void stage_rc(int b, int& R, int& C) { const int st = b / 1024, sb = b % 1024, swz = sb ^ (((sb >> 9) & 1) << 5); R = (st >> 1) * 16 + swz / 64; C = (st & 1) * 32 + (swz % 64) / 2; }
HD int perm32(int rho) { const int n = rho >> 4, i = rho & 15; return 8 * (i >> 2) + 4 * n + (i & 3); }
struct Unit { int pm, pn; const bf16_t* Bt; const int* rs; const float* rw; int nvalid; };
struct Gemm { const bf16_t* A; int K; };

HD void tile_order(int L, int nM, int nN, int& pm, int& pn) {
  const int nwg = nM * nN; int wgid = L;
  { const int q = nwg / NXCD, r = nwg % NXCD, xcd = wgid % NXCD, off = wgid / NXCD; wgid = (xcd < r ? xcd * (q + 1) : r * (q + 1) + (xcd - r) * q) + off; }
  const int nig = WGM * nN, gid = wgid / nig, fm = gid * WGM, gsz = (nM - fm) < WGM ? (nM - fm) : WGM;
  pm = fm + ((wgid % nig) % gsz); pn = (wgid % nig) / gsz;
}

#ifndef CPU_TEST
#define PG8_LAS __attribute__((address_space(3)))
#define PG8_GLDS(gp, lp) __builtin_amdgcn_global_load_lds((const unsigned*)(gp), (PG8_LAS unsigned*)(lp), 16, 0, 0)
#define PG8_WAIT_V(n) asm volatile("s_waitcnt vmcnt(" #n ")" ::: "memory")
#define PG8_WAIT_L(n) asm volatile("s_waitcnt lgkmcnt(" #n ")" ::: "memory")
#define PG8_BAR __builtin_amdgcn_s_barrier()
#define PG8_SCHED __builtin_amdgcn_sched_barrier(0)
#define PG8_PRIO(n) __builtin_amdgcn_s_setprio(n)
#define PG8_UNIFORM(x) __builtin_amdgcn_readfirstlane(x)
#define PG8_MFMA(a, b, c) __builtin_amdgcn_mfma_f32_16x16x32_bf16(a, b, c, 0, 0, 0)
#else
#define PG8_LAS
#define PG8_GLDS(gp, lp) emu_global_load_lds16((const void*)(gp), (void*)(lp))
#define PG8_WAIT_V(n)
#define PG8_WAIT_L(n)
#define PG8_BAR emu_block_barrier()
#define PG8_SCHED
#define PG8_PRIO(n)
#define PG8_UNIFORM(x) (x)
#define PG8_MFMA(a, b, c) emu_mfma_16x16x32(a, b, c)
#endif
template <class Epi, class Sched, bool GATHER = false, bool ALIGN_EPI = true, bool SP2 = true>
DEV void gemm_phase(PG8_LAS unsigned char* lds, const Gemm g, const Sched& S, const Epi& E) {
    const int tid = tidx(), wid = PG8_UNIFORM(tid >> 6), lane = tid & 63, wr = wid >> 2, wc = wid & 3, fr = lane & 15, fq = lane >> 4;
    const int K = g.K, nt = K / BK;
    unsigned voffA[2], voffB[2]; int stR[2], stC[2];
#pragma unroll
    for (int i = 0; i < 2; ++i) { int R, C; stage_rc(tid * 16 + i * 8192, R, C); const int Rb = Epi::PERM ? ((R & ~31) + perm32(R & 31)) : R; stR[i] = R; stC[i] = C;
        voffA[i] = (unsigned)(R * K + C) * 2u; voffB[i] = (unsigned)(Rb * K + C) * 2u; }
    const size_t kstep = (size_t)(BK * 2);
    const size_t hstep = (size_t)HALF * K * 2;
    const size_t tstep = 2 * hstep;
    const unsigned ldsw = (unsigned)wid * 1024u;
    const int aoff = lds_byte(wr * 64 + fr, fq * 8), boff = lds_byte(wc * 32 + fr, fq * 8);
#define PG8_SA(b, h) (((b) * 2 + (h)) * HTB)
#define PG8_SB(b, h) ((4 + (b) * 2 + (h)) * HTB)
#define PG8_STAGE(bufoff, gbase, voff) do { _Pragma("unroll") for (int _i = 0; _i < 2; ++_i) \
        PG8_GLDS((const char*)(gbase) + (voff)[_i], lds + (bufoff) + ldsw + _i * 8192); } while (0)
#define PG8_STAGE_A(bufoff, h, kb, vg0, vg1) do { if constexpr (GATHER) { if (h) PG8_STAGE(bufoff, kb, vg1); else PG8_STAGE(bufoff, kb, vg0); } else PG8_STAGE(bufoff, (kb) + (h) * hstep, voffA); } while (0)
#define PG8_ROWOFFS(U, v0, v1) do { if constexpr (GATHER) { _Pragma("unroll") for (int _i = 0; _i < 2; ++_i) { \
        const int l0_ = stR[_i], l1_ = HALF + stR[_i]; const int s0_ = l0_ < (U).nvalid ? (U).rs[l0_] : 0, s1_ = l1_ < (U).nvalid ? (U).rs[l1_] : 0; \
        v0[_i] = (unsigned)((s0_ >> 1) * K + stC[_i]) * 2u; v1[_i] = (unsigned)((s1_ >> 1) * K + stC[_i]) * 2u; } } } while (0)
#define PG8_LDA(dst, b, h) do { _Pragma("unroll") for (int m = 0; m < 4; ++m) _Pragma("unroll") for (int k = 0; k < 2; ++k) dst[m][k] = *(const PG8_LAS bf16x8*)(lds + PG8_SA(b, h) + aoff + m * 2048 + k * 1024); } while (0)
#define PG8_LDB(dst, b, h) do { _Pragma("unroll") for (int n = 0; n < 2; ++n) _Pragma("unroll") for (int k = 0; k < 2; ++k) dst[n][k] = *(const PG8_LAS bf16x8*)(lds + PG8_SB(b, h) + boff + n * 2048 + k * 1024); } while (0)
#define PG8_MMA(ai, bj, At, Bt) do { PG8_PRIO(1); _Pragma("unroll") for (int m = 0; m < 4; ++m) _Pragma("unroll") for (int n = 0; n < 2; ++n) _Pragma("unroll") for (int k = 0; k < 2; ++k) \
        acc[ai][bj][m][n] = PG8_MFMA(Bt[n][k], At[m][k], acc[ai][bj][m][n]); PG8_PRIO(0); } while (0)
    Unit cur, nxt; int ui = 0;
    if (!S.next(0, cur)) return;
    f32x4 acc[2][2][4][2];
#pragma unroll
    for (int a = 0; a < 2; ++a)
#pragma unroll
        for (int b = 0; b < 2; ++b)
#pragma unroll
            for (int m = 0; m < 4; ++m)
#pragma unroll
                for (int n = 0; n < 2; ++n) acc[a][b][m][n] = (f32x4){0.f, 0.f, 0.f, 0.f};
    bf16x8 At[4][2], B0[2][2], B1[2][2];
    unsigned cv0[2] = {0u, 0u}, cv1[2] = {0u, 0u}, nv0[2] = {0u, 0u}, nv1[2] = {0u, 0u};
    PG8_ROWOFFS(cur, cv0, cv1);
    const char* cA = GATHER ? (const char*)g.A : (const char*)g.A + (size_t)cur.pm * tstep; const char* cB = (const char*)cur.Bt + (size_t)cur.pn * tstep;
    if constexpr (SP2) {
        PG8_STAGE(PG8_SB(0, 0), cB, voffB); PG8_STAGE(PG8_SB(0, 1), cB + hstep, voffB); PG8_STAGE_A(PG8_SA(0, 0), 0, cA, cv0, cv1); PG8_STAGE_A(PG8_SA(0, 1), 1, cA, cv0, cv1);
        if (wr == 1) PG8_BAR;
        PG8_WAIT_V(2); PG8_BAR;
        PG8_STAGE(PG8_SB(1, 0), cB + kstep, voffB); PG8_STAGE_A(PG8_SA(1, 0), 0, cA + kstep, cv0, cv1); PG8_STAGE(PG8_SB(1, 1), cB + hstep + kstep, voffB);
        PG8_WAIT_V(6); PG8_BAR;
    } else {
        PG8_STAGE(PG8_SB(0, 0), cB, voffB); PG8_STAGE_A(PG8_SA(0, 0), 0, cA, cv0, cv1); PG8_STAGE(PG8_SB(0, 1), cB + hstep, voffB); PG8_STAGE_A(PG8_SA(0, 1), 1, cA, cv0, cv1);
        if (wr == 1) PG8_BAR;
        PG8_WAIT_V(4); PG8_BAR;
        PG8_STAGE(PG8_SB(1, 0), cB + kstep, voffB); PG8_STAGE_A(PG8_SA(1, 0), 0, cA + kstep, cv0, cv1); PG8_STAGE(PG8_SB(1, 1), cB + hstep + kstep, voffB);
        PG8_WAIT_V(6); PG8_BAR;
    }
    for (;;) {
        const bool has_next = S.next(ui + 1, nxt);
        if (has_next) PG8_ROWOFFS(nxt, nv0, nv1);
        else { nv0[0] = cv0[0]; nv0[1] = cv0[1]; nv1[0] = cv1[0]; nv1[1] = cv1[1]; }
        const char* nA = has_next ? (GATHER ? (const char*)g.A : (const char*)g.A + (size_t)nxt.pm * tstep) : cA; const char* nB = has_next ? (const char*)nxt.Bt + (size_t)nxt.pn * tstep : cB;
        for (int t = 0; t < nt; t += 2) {
            const bool last = (t == nt - 2);
            const char* a1 = cA + (size_t)(t + 1) * kstep;
            const char* a2 = last ? nA : cA + (size_t)(t + 2) * kstep; const char* b2 = last ? nB : cB + (size_t)(t + 2) * kstep;
            const char* a3 = a2 + kstep; const char* b3 = b2 + kstep;
            unsigned w0[2], w1[2];
            w0[0] = last ? nv0[0] : cv0[0]; w0[1] = last ? nv0[1] : cv0[1]; w1[0] = last ? nv1[0] : cv1[0]; w1[1] = last ? nv1[1] : cv1[1];
            if constexpr (SP2) {
            PG8_LDB(B0, 0, 0); PG8_LDB(B1, 0, 1); PG8_SCHED; PG8_LDA(At, 0, 0); PG8_STAGE_A(PG8_SA(1, 1), 1, a1, cv0, cv1);
            PG8_WAIT_V(8); PG8_WAIT_L(0); PG8_BAR; PG8_MMA(0, 0, At, B0); PG8_MMA(0, 1, At, B1); PG8_BAR; PG8_SCHED;
            PG8_LDA(At, 0, 1); PG8_STAGE(PG8_SB(0, 0), b2, voffB); PG8_STAGE(PG8_SB(0, 1), b2 + hstep, voffB); PG8_STAGE_A(PG8_SA(0, 0), 0, a2, w0, w1);
            PG8_WAIT_V(8); PG8_WAIT_L(0); PG8_BAR; PG8_MMA(1, 0, At, B0); PG8_MMA(1, 1, At, B1); PG8_BAR; PG8_SCHED;
            PG8_LDB(B0, 1, 0); PG8_LDB(B1, 1, 1); PG8_SCHED; PG8_LDA(At, 1, 0); PG8_STAGE_A(PG8_SA(0, 1), 1, a2, w0, w1);
            PG8_WAIT_V(8); PG8_WAIT_L(0); PG8_BAR; PG8_MMA(0, 0, At, B0); PG8_MMA(0, 1, At, B1); PG8_BAR; PG8_SCHED;
            PG8_LDA(At, 1, 1); PG8_STAGE(PG8_SB(1, 0), b3, voffB); PG8_STAGE(PG8_SB(1, 1), b3 + hstep, voffB); PG8_STAGE_A(PG8_SA(1, 0), 0, a3, w0, w1);
            PG8_WAIT_V(8); PG8_WAIT_L(0); PG8_BAR; PG8_MMA(1, 0, At, B0); PG8_MMA(1, 1, At, B1); PG8_BAR; PG8_SCHED;
            } else {
            PG8_LDB(B0, 0, 0); PG8_SCHED; PG8_LDA(At, 0, 0); PG8_STAGE_A(PG8_SA(1, 1), 1, a1, cv0, cv1);
            PG8_WAIT_L(8); PG8_BAR; PG8_WAIT_L(0); PG8_MMA(0, 0, At, B0); PG8_BAR; PG8_SCHED;
            PG8_LDB(B1, 0, 1); PG8_STAGE(PG8_SB(0, 0), b2, voffB);
            PG8_BAR; PG8_WAIT_L(0); PG8_MMA(0, 1, At, B1); PG8_BAR;
            PG8_LDA(At, 0, 1); PG8_STAGE_A(PG8_SA(0, 0), 0, a2, w0, w1);
            PG8_BAR; PG8_WAIT_L(0); PG8_MMA(1, 0, At, B0); PG8_BAR; PG8_SCHED;
            PG8_STAGE(PG8_SB(0, 1), b2 + hstep, voffB);
            PG8_WAIT_V(6); PG8_BAR; PG8_MMA(1, 1, At, B1); PG8_BAR;
            PG8_LDB(B0, 1, 0); PG8_SCHED; PG8_LDA(At, 1, 0); PG8_STAGE_A(PG8_SA(0, 1), 1, a2, w0, w1);
            PG8_WAIT_L(8); PG8_BAR; PG8_WAIT_L(0); PG8_MMA(0, 0, At, B0); PG8_BAR; PG8_SCHED;
            PG8_LDB(B1, 1, 1); PG8_STAGE(PG8_SB(1, 0), b3, voffB);
            PG8_BAR; PG8_WAIT_L(0); PG8_MMA(0, 1, At, B1); PG8_BAR;
            PG8_LDA(At, 1, 1); PG8_STAGE_A(PG8_SA(1, 0), 0, a3, w0, w1);
            PG8_BAR; PG8_WAIT_L(0); PG8_MMA(1, 0, At, B0); PG8_BAR; PG8_SCHED;
            PG8_STAGE(PG8_SB(1, 1), b3 + hstep, voffB);
            PG8_WAIT_V(6); PG8_BAR; PG8_MMA(1, 1, At, B1); PG8_BAR;
            }
        }
        if constexpr (ALIGN_EPI) { if (wr == 0) PG8_BAR; }
        E(acc, cur, wr, wc, fr, fq);
        if (!has_next) break;
#pragma unroll
        for (int a = 0; a < 2; ++a)
#pragma unroll
            for (int b = 0; b < 2; ++b)
#pragma unroll
                for (int m = 0; m < 4; ++m)
#pragma unroll
                    for (int n = 0; n < 2; ++n) acc[a][b][m][n] = (f32x4){0.f, 0.f, 0.f, 0.f};
        cur = nxt; cA = nA; cB = nB; ++ui; cv0[0] = nv0[0]; cv0[1] = nv0[1]; cv1[0] = nv1[0]; cv1[1] = nv1[1];
        if constexpr (ALIGN_EPI) { if (wr == 1) PG8_BAR; }
    }
    PG8_WAIT_V(0);
    if constexpr (!ALIGN_EPI) { if (wr == 0) PG8_BAR; }
    PG8_BAR;
#undef PG8_SA
#undef PG8_SB
#undef PG8_STAGE
#undef PG8_STAGE_A
#undef PG8_ROWOFFS
#undef PG8_LDA
#undef PG8_LDB
#undef PG8_MMA
}
#ifdef CPU_TEST
template <class Epi, class Sched> void gemm_phase_ref(const Gemm g, const Sched& S, const Epi& E) {
  Unit u;
  for (int ui = 0; S.next(ui, u); ++ui)
    for (int wid = 0; wid < 8; ++wid) for (int lane = 0; lane < 64; ++lane) {
      const int wr = wid >> 2, wc = wid & 3, fr = lane & 15, fq = lane >> 4;
      f32x4 acc[2][2][4][2];
      for (int ai = 0; ai < 2; ++ai) for (int bj = 0; bj < 2; ++bj) for (int m = 0; m < 4; ++m) for (int n = 0; n < 2; ++n) for (int i = 0; i < 4; ++i) {
        const size_t row = (size_t)u.pm * 256 + ai * 128 + wr * 64 + m * 16 + fr;
        const size_t col = (size_t)u.pn * 256 + bj * 128 + wc * 32 + (Epi::PERM ? 8 * fq + 4 * n + i : 16 * n + 4 * fq + i);
        const bf16_t* a = g.A + row * g.K, *b = u.Bt + col * g.K; float s = 0.f;
        for (int k = 0; k < g.K; ++k) s += bf2f(a[k]) * bf2f(b[k]);
        acc[ai][bj][m][n][i] = s;
      }
      E(acc, u, wr, wc, fr, fq);
    }
}
#define GEMM_RUN(lds, g, S, E) do { if (tidx() == 0) pg8::gemm_phase_ref(g, S, E); } while (0)
#define GEMM_RUN_GATHER(lds, g, S, E) pg8::gemm_phase<decltype(E), decltype(S), true>((unsigned char*)(lds), g, S, E)
#else
#define GEMM_RUN(lds, g, S, E) pg8::gemm_phase<decltype(E), decltype(S), false>((PG8_LAS unsigned char*)(lds), g, S, E)
#define GEMM_RUN_GATHER(lds, g, S, E) pg8::gemm_phase<decltype(E), decltype(S), true>((PG8_LAS unsigned char*)(lds), g, S, E)
#endif
}
using pg8::Unit; using pg8::Gemm;

struct DenseOrder { int nM, nN, G, c; const bf16_t* Bt;
  HD bool next(int i, Unit& u) const { const long L = (long)i * G + c; if (L >= (long)nM * nN) return false; pg8::tile_order((int)L, nM, nN, u.pm, u.pn); u.Bt = Bt; u.rs = nullptr; u.rw = nullptr; u.nvalid = 256; return true; } };
struct Inproj1Order { int G, c; const bf16_t* Bt;
  HD bool next(int i, Unit& u) const { const long L = (long)i * G + c; const int n1 = (TL / 256) * 20, n2 = (TC / 256) * 12; if (L >= n1 + n2) return false;
    if (L < n1) pg8::tile_order((int)L, TL / 256, 20, u.pm, u.pn); else { const int q = (int)L - n1; u.pm = TL / 256 + q % (TC / 256); u.pn = 8 + q / (TC / 256); }
    u.Bt = Bt; u.rs = nullptr; u.rw = nullptr; u.nvalid = 256; return true; } };
struct MoeOrder { int G, c; const int* CNT; const bf16_t* Bt; size_t estride; const int* RS; const float* RW;
  HD bool next(int i, Unit& u) const { const long L = (long)i * G + c; const int t = (int)(L >> 2); int tb = 0, e = -1, j = 0, ce = 0;
    for (int q = 0; q < NE; ++q) { const int cq = CNT[q], nt = (cq + 255) >> 8; if (e < 0 && t < tb + nt) { e = q; j = t - tb; ce = cq; } tb += nt; }
    if (e < 0) return false; u.pm = t; u.pn = (int)(L & 3); u.Bt = Bt + (size_t)e * estride;
    u.rs = RS + (size_t)e * MOE_CAP + 256 * j; u.rw = RW + (size_t)e * MOE_CAP + 256 * j; u.nvalid = ce - 256 * j < 256 ? ce - 256 * j : 256; return true; } };

HD f32x4 silu4(f32x4 v) { return (f32x4){siluf_(v[0]), siluf_(v[1]), siluf_(v[2]), siluf_(v[3])}; }
HD f32x4 sigm4(f32x4 v) { return (f32x4){sigmoidf_(v[0]), sigmoidf_(v[1]), sigmoidf_(v[2]), sigmoidf_(v[3])}; }
struct EpiInproj0 { static constexpr bool PERM = true; bf16_t* Z; bf16_t* XR; bf16_t* U; float* DT; const float* dtb;
  HD void operator()(const f32x4 (&acc)[2][2][4][2], const Unit& u, int wr, int wc, int fr, int fq) const {
#pragma unroll
    for (int ai = 0; ai < 2; ++ai)
#pragma unroll
      for (int m = 0; m < 4; ++m) {
        const size_t row = (size_t)u.pm * 256 + ai * 128 + wr * 64 + m * 16 + fr; const int cl = wc * 32 + 8 * fq;
        if (u.pn < 12) { bf16_t* base = u.pn < 4 ? Z + row * 1024 + u.pn * 256 : XR + row * 2048 + (u.pn - 4) * 256;
#pragma unroll
          for (int bj = 0; bj < 2; ++bj) store_bf16x8(base + bj * 128 + cl, acc[ai][bj][m][0], acc[ai][bj][m][1]); }
        else if (u.pn < 20) store_bf16x8(U + row * 1024 + (u.pn - 12) * 128 + cl, acc[ai][0][m][0] * sigm4(acc[ai][1][m][0]), acc[ai][0][m][1] * sigm4(acc[ai][1][m][1]));
        else if (wc == 0) {
#pragma unroll
          for (int n = 0; n < 2; ++n)
#pragma unroll
            for (int i = 0; i < 4; ++i) { const int j = 8 * fq + 4 * n + i; DT[row * 32 + j] = softplusf_(acc[ai][0][m][n][i] + dtb[j]); } }
      }
  } };
struct EpiResid { static constexpr bool PERM = false; const P* p; int l; bool from_input;
  HD void operator()(const f32x4 (&acc)[2][2][4][2], const Unit& u, int wr, int wc, int fr, int fq) const {
    const float* gate = modv(*p, l, tok_modrow(u.pm * 256), 2) + u.pn * 256 + wc * 32 + 4 * fq;
    f32x4 g4[2][2];
#pragma unroll
    for (int bj = 0; bj < 2; ++bj)
#pragma unroll
      for (int n = 0; n < 2; ++n) g4[bj][n] = *(const f32x4*)(gate + bj * 128 + 16 * n);
#pragma unroll
    for (int ai = 0; ai < 2; ++ai)
#pragma unroll
      for (int m = 0; m < 4; ++m) {
        const int row = u.pm * 256 + ai * 128 + wr * 64 + m * 16 + fr;
        const float* base = from_input ? xin_row(*p, row) : xcur_row(*p, row); float* dst = xcur_row(*p, row);
#pragma unroll
        for (int bj = 0; bj < 2; ++bj)
#pragma unroll
          for (int n = 0; n < 2; ++n) { const int c = u.pn * 256 + bj * 128 + wc * 32 + 16 * n + 4 * fq;
            *(f32x4*)(dst + c) = *(const f32x4*)(base + c) + g4[bj][n] * acc[ai][bj][m][n]; }
      }
  } };
struct EpiMoe1 { static constexpr bool PERM = true; bf16_t* ACT;
  HD void operator()(const f32x4 (&acc)[2][2][4][2], const Unit& u, int wr, int wc, int fr, int fq) const {
#pragma unroll
    for (int ai = 0; ai < 2; ++ai)
#pragma unroll
      for (int m = 0; m < 4; ++m) { const size_t row = (size_t)u.pm * 256 + ai * 128 + wr * 64 + m * 16 + fr;
        store_bf16x8(ACT + row * 512 + u.pn * 128 + wc * 32 + 8 * fq, silu4(acc[ai][0][m][0]) * acc[ai][1][m][0], silu4(acc[ai][0][m][1]) * acc[ai][1][m][1]); }
  } };
struct EpiMoe2 { static constexpr bool PERM = true; bf16_t* YS;
  HD void operator()(const f32x4 (&acc)[2][2][4][2], const Unit& u, int wr, int wc, int fr, int fq) const {
#pragma unroll
    for (int ai = 0; ai < 2; ++ai)
#pragma unroll
      for (int m = 0; m < 4; ++m) { const int li = ai * 128 + wr * 64 + m * 16 + fr;
        if (li < u.nvalid) { const int slot = u.rs[li]; const float w = u.rw[li]; bf16_t* dst = YS + (size_t)slot * 1024 + u.pn * 256 + wc * 32 + 8 * fq;
#pragma unroll
          for (int bj = 0; bj < 2; ++bj) store_bf16x8(dst + bj * 128, acc[ai][bj][m][0] * w, acc[ai][bj][m][1] * w); } }
  } };
struct EpiInproj1 { static constexpr bool PERM = true; bf16_t* P1; const float* lbt;
  HD void operator()(const f32x4 (&acc)[2][2][4][2], const Unit& u, int wr, int wc, int fr, int fq) const {
#pragma unroll
    for (int bj = 0; bj < 2; ++bj) { const int c = u.pn * 256 + bj * 128 + wc * 32 + 8 * fq;
      f32x4 lb0 = {0.f, 0.f, 0.f, 0.f}, lb1 = {0.f, 0.f, 0.f, 0.f};
      if (u.pn >= 12) { lb0 = *(const f32x4*)(lbt + (c & 1023)); lb1 = *(const f32x4*)(lbt + (c & 1023) + 4); }
#pragma unroll
      for (int ai = 0; ai < 2; ++ai)
#pragma unroll
        for (int m = 0; m < 4; ++m) { const size_t row = (size_t)u.pm * 256 + ai * 128 + wr * 64 + m * 16 + fr; f32x4 v0 = acc[ai][bj][m][0], v1 = acc[ai][bj][m][1];
          if (u.pn < 4) { v0 = silu4(v0); v1 = silu4(v1); }
          else if (u.pn >= 12) {
#pragma unroll
            for (int i = 0; i < 4; ++i) { v0[i] = (1.f - lb0[i]) * sigmoidf_(-v0[i]); v1[i] = (1.f - lb1[i]) * sigmoidf_(-v1[i]); } }
          store_bf16x8(P1 + row * 5120 + c, v0, v1); } }
  } };

DEV void ph_gemm_inproj0(const P& p, void* lds, int bid, int G) {
  Gemm g{(const bf16_t*)(p.ws + WS_H), 1024}; DenseOrder S{TT / 256, N0P / 256, G, bid, (const bf16_t*)(p.ws + WS_WIN0)};
  EpiInproj0 E{(bf16_t*)(p.ws + WS_Z), (bf16_t*)(p.ws + WS_XR), (bf16_t*)(p.ws + WS_U), (float*)(p.ws + WS_DT), p.in[I_DTB]};
  GEMM_RUN(lds, g, S, E);
}
DEV void ph_gemm_outproj0(const P& p, void* lds, int bid, int G) {
  Gemm g{(const bf16_t*)(p.ws + WS_XR), 2048}; DenseOrder S{TT / 256, 4, G, bid, (const bf16_t*)(p.ws + WS_WOUT0)}; EpiResid E{&p, 0, true};
  GEMM_RUN(lds, g, S, E);
}
DEV void ph_gemm_moe1(const P& p, int l, void* lds, int bid, int G) {
  Gemm g{(const bf16_t*)(p.ws + WS_H), 1024}; MoeOrder S{G, bid, (const int*)(p.ws + WS_CTL) + l * NE, (const bf16_t*)(p.ws + WS_WGU), (size_t)1024 * 1024, (const int*)(p.ws + WS_RSLOT), (const float*)(p.ws + WS_RW)}; EpiMoe1 E{(bf16_t*)(p.ws + WS_ACT)};
  GEMM_RUN_GATHER(lds, g, S, E);
}
DEV void ph_gemm_moe2(const P& p, int l, void* lds, int bid, int G) {
  Gemm g{(const bf16_t*)(p.ws + WS_ACT), 512}; MoeOrder S{G, bid, (const int*)(p.ws + WS_CTL) + l * NE, (const bf16_t*)(p.ws + WS_WDT), (size_t)1024 * 512, (const int*)(p.ws + WS_RSLOT), (const float*)(p.ws + WS_RW)};
  EpiMoe2 E{(bf16_t*)(p.ws + WS_YS)};
  GEMM_RUN(lds, g, S, E);
}
DEV void ph_gemm_inproj1(const P& p, void* lds, int bid, int G) {
  Gemm g{(const bf16_t*)(p.ws + WS_H), 1024}; Inproj1Order S{G, bid, (const bf16_t*)(p.ws + WS_WHGI)}; EpiInproj1 E{(bf16_t*)(p.ws + WS_P1), (const float*)(p.ws + WS_LB)};
  GEMM_RUN(lds, g, S, E);
}
DEV void ph_gemm_outproj1(const P& p, void* lds, int bid, int G) {
  Gemm g{(const bf16_t*)(p.ws + WS_H), 1024}; DenseOrder S{TL / 256, 4, G, bid, (const bf16_t*)(p.ws + WS_WHGO)}; EpiResid E{&p, 1, false};
  GEMM_RUN(lds, g, S, E);
}

HD void tok_pos(int r, int& t, int& L) { if (r < TL) { t = r % SEQ; L = SEQ; } else { t = (r - TL) % CTX; L = CTX; } }


constexpr int SSD_LD = 136, SSD_LDX = 72;
constexpr int SSD_OFF_C = 0, SSD_OFF_B = SSD_OFF_C + 128 * SSD_LD * 2, SSD_OFF_X = SSD_OFF_B + 128 * SSD_LD * 2, SSD_OFF_XW = SSD_OFF_X + 128 * SSD_LDX * 2,
              SSD_OFF_S = SSD_OFF_XW + 128 * SSD_LDX * 2, SSD_OFF_F = SSD_OFF_S + 64 * SSD_LD * 2, SSD_LDS_END = SSD_OFF_F + 2 * 520 * 4;
static_assert(SSD_LDS_END <= LDS_BYTES - 64, "SSD LDS map");
DEV void ph_ssd_chunked(const P& p, LAS unsigned char* lds, int bid, int G) {
  const int t = tidx(), wid = PG8_UNIFORM(t >> 6), lane = t & 63, fr = lane & 15, fq = lane >> 4;
  constexpr int LD = SSD_LD, LDX = SSD_LDX;
  LAS unsigned char* Cm = lds + SSD_OFF_C; LAS unsigned char* Bm = lds + SSD_OFF_B; LAS unsigned char* Xm = lds + SSD_OFF_X; LAS unsigned char* XWm = lds + SSD_OFF_XW; LAS unsigned char* Sb = lds + SSD_OFF_S;
  LAS float* fab = (LAS float*)(lds + SSD_OFF_F);
  const bf16_t* XBC = (const bf16_t*)(p.ws + WS_XBC); const float* DT = (const float*)(p.ws + WS_DT);
  constexpr int NCH = (CTX + SEQ) / 128;
  for (int u = bid; u < NB * 32; u += G) {
    const int b = u >> 5, d = (u >> 4) & 1, h = u & 15, g = h >> 2, sgn = d ? -1 : 1;
    const float a = -fexp(p.in[I_ALOG][d * 16 + h]), Dk = p.in[I_SSDD][h];
    bf16_t* Yd = (bf16_t*)(p.ws + WS_Y) + (size_t)d * TT * 1024;
    f32x4 ST[2][2];
#pragma unroll
    for (int i = 0; i < 2; ++i)
#pragma unroll
      for (int j = 0; j < 2; ++j) ST[i][j] = (f32x4){0.f, 0.f, 0.f, 0.f};
    blk_sync();
    for (int i = t; i < 64 * LD / 2; i += NT) ((LAS unsigned*)Sb)[i] = 0u;
    u32x4 nC[4], nB[4], nX[2]; float ndt0 = 0.f, ndt1 = 0.f;
#define SSD_R0(cc) ((cc) * 128 < CTX ? TL + b * CTX + (d ? CTX - 1 - (cc) * 128 : (cc) * 128) : b * SEQ + (d ? SEQ - 1 - ((cc) * 128 - CTX) : ((cc) * 128 - CTX)))
#define SSD_LOAD(cc) do { const int r0_ = SSD_R0(cc); \
      _Pragma("unroll") for (int i_ = 0; i_ < 4; ++i_) { const int v_ = t + NT * i_; const bf16_t* s_ = XBC + (size_t)(r0_ + sgn * (v_ >> 4)) * 2048 + g * 128 + (v_ & 15) * 8; nC[i_] = *(const u32x4*)(s_ + 1536); nB[i_] = *(const u32x4*)(s_ + 1024); } \
      _Pragma("unroll") for (int i_ = 0; i_ < 2; ++i_) { const int v_ = t + NT * i_; nX[i_] = *(const u32x4*)(XBC + (size_t)(r0_ + sgn * (v_ >> 3)) * 2048 + h * 64 + (v_ & 7) * 8); } \
      if (wid == 0) { ndt0 = DT[(size_t)(r0_ + sgn * (2 * lane)) * 32 + d * 16 + h]; ndt1 = DT[(size_t)(r0_ + sgn * (2 * lane + 1)) * 32 + d * 16 + h]; } } while (0)
    SSD_LOAD(0);
#define SSD_TABLE(dst) do { if (wid == 0) { LAS float* f_ = (dst); const int j0 = 2 * lane; const float dt0 = ndt0, dt1 = ndt1, la0 = dt0 * a, la1 = dt1 * a; float ps = la0 + la1; \
      _Pragma("unroll") for (int o = 1; o < 64; o <<= 1) { const float n_ = wshfl(ps, lane - o); if (lane >= o) ps += n_; } \
      const float end = wshfl(ps, 63), ac0 = ps - la1, ac1 = ps; \
      f_[j0] = dt0; f_[j0 + 1] = dt1; f_[128 + j0] = ac0; f_[129 + j0] = ac1; f_[256 + j0] = dt0 * fexp(end - ac0); f_[257 + j0] = dt1 * fexp(end - ac1); \
      f_[384 + j0] = fexp(ac0); f_[385 + j0] = fexp(ac1); if (lane == 0) f_[512] = fexp(end); } } while (0)
    SSD_TABLE(fab);
    for (int c = 0; c < NCH; ++c) {
      const int s0 = c * 128;
      const int r0 = s0 < CTX ? TL + b * CTX + (d ? CTX - 1 - s0 : s0) : b * SEQ + (d ? SEQ - 1 - (s0 - CTX) : (s0 - CTX));
      u32x4 xv[2];
#pragma unroll
      for (int i = 0; i < 4; ++i) { const int v = t + NT * i, row = v >> 4, c16 = v & 15; *(LAS u32x4*)(Cm + row * LD * 2 + c16 * 16) = nC[i]; *(LAS u32x4*)(Bm + row * LD * 2 + c16 * 16) = nB[i]; }
#pragma unroll
      for (int i = 0; i < 2; ++i) { const int v = t + NT * i, row = v >> 3, c8 = v & 7; xv[i] = nX[i]; *(LAS u32x4*)(Xm + row * LDX * 2 + c8 * 16) = xv[i]; }
      if (c + 1 < NCH) SSD_LOAD(c + 1);
      LAS float* fa = fab + (c & 1) * 520;
      blk_sync();
#pragma unroll
      for (int i = 0; i < 2; ++i) { const int v = t + NT * i, row = v >> 3, c8 = v & 7; const float w = fa[256 + row]; u32x4 o;
        o.x = pk2(bflo(xv[i].x) * w, bfhi(xv[i].x) * w); o.y = pk2(bflo(xv[i].y) * w, bfhi(xv[i].y) * w); o.z = pk2(bflo(xv[i].z) * w, bfhi(xv[i].z) * w); o.w = pk2(bflo(xv[i].w) * w, bfhi(xv[i].w) * w);
        *(LAS u32x4*)(XWm + row * LDX * 2 + c8 * 16) = o; }
      const int I1 = (0x22331100 >> (4 * wid)) & 3, J1 = (0x01011010 >> (4 * wid)) & 1;
      f32x4 cb[2][4];
#pragma unroll
      for (int i = 0; i < 2; ++i)
#pragma unroll
        for (int j = 0; j < 4; ++j) cb[i][j] = (f32x4){0.f, 0.f, 0.f, 0.f};
      if (2 * I1 <= ((4 * J1 + 3) | 1)) {
#pragma unroll
        for (int q = 0; q < 4; ++q) {
          bf16x8 af[2], bfm[4];
#pragma unroll
          for (int i = 0; i < 2; ++i) af[i] = frag_row(Bm, LD, 16 * (2 * I1 + i), 32 * q, lane);
#pragma unroll
          for (int j = 0; j < 4; ++j) bfm[j] = frag_row(Cm, LD, 16 * (4 * J1 + j), 32 * q, lane);
#pragma unroll
          for (int i = 0; i < 2; ++i)
#pragma unroll
            for (int j = 0; j < 4; ++j) if (2 * I1 + i <= ((4 * J1 + j) | 1)) cb[i][j] = mfma16(af[i], bfm[j], cb[i][j]);
        }
      }
      blk_sync();
      const int NI = wid & 3, PJ = wid >> 2;
      { const float dec = fa[512];
#pragma unroll
        for (int i = 0; i < 2; ++i)
#pragma unroll
          for (int j = 0; j < 2; ++j) ST[i][j] *= dec;
#pragma unroll
        for (int q = 0; q < 4; ++q) {
          bf16x8 af[2], bfm[2];
#pragma unroll
          for (int i = 0; i < 2; ++i) af[i] = frag_tr(Bm, LD, 16 * (2 * NI + i), 32 * q, lane);
#pragma unroll
          for (int j = 0; j < 2; ++j) bfm[j] = frag_tr(XWm, LDX, 16 * (2 * PJ + j), 32 * q, lane);
#pragma unroll
          for (int i = 0; i < 2; ++i)
#pragma unroll
            for (int j = 0; j < 2; ++j) ST[i][j] = mfma16(af[i], bfm[j], ST[i][j]);
        }
      }
      blk_sync();
#pragma unroll
      for (int i = 0; i < 2; ++i)
#pragma unroll
        for (int j = 0; j < 4; ++j) if (2 * I1 + i <= ((4 * J1 + j) | 1)) {
          const int s = 16 * (2 * I1 + i) + 4 * fq, l = 16 * (4 * J1 + j) + fr; const float al = fa[128 + l];
          const f32x4 as = *(const LAS f32x4*)(fa + 128 + s), ds = *(const LAS f32x4*)(fa + s); f32x4 m;
#pragma unroll
          for (int e = 0; e < 4; ++e) m[e] = (s + e <= l) ? cb[i][j][e] * fexp(al - as[e]) * ds[e] : 0.f;
          lds_store_bf16x4(Bm + (l * LD + s) * 2, m);
        }
      blk_sync();
      { const int PI = wid & 1, JJ = wid >> 1;
        f32x4 yd[2][2], yo[2][2];
#pragma unroll
        for (int i = 0; i < 2; ++i)
#pragma unroll
          for (int j = 0; j < 2; ++j) { yd[i][j] = (f32x4){0.f, 0.f, 0.f, 0.f}; yo[i][j] = (f32x4){0.f, 0.f, 0.f, 0.f}; }
        for (int q = 0; q <= JJ; ++q) {
          bf16x8 af[2], bfm[2];
#pragma unroll
          for (int i = 0; i < 2; ++i) af[i] = frag_tr(Xm, LDX, 16 * (2 * PI + i), 32 * q, lane);
#pragma unroll
          for (int j = 0; j < 2; ++j) bfm[j] = frag_row(Bm, LD, 16 * (2 * JJ + j), 32 * q, lane);
#pragma unroll
          for (int i = 0; i < 2; ++i)
#pragma unroll
            for (int j = 0; j < 2; ++j) yd[i][j] = mfma16(af[i], bfm[j], yd[i][j]);
        }
#pragma unroll
        for (int q = 0; q < 4; ++q) {
          bf16x8 af[2], bfm[2];
#pragma unroll
          for (int i = 0; i < 2; ++i) af[i] = frag_row(Sb, LD, 16 * (2 * PI + i), 32 * q, lane);
#pragma unroll
          for (int j = 0; j < 2; ++j) bfm[j] = frag_row(Cm, LD, 16 * (2 * JJ + j), 32 * q, lane);
#pragma unroll
          for (int i = 0; i < 2; ++i)
#pragma unroll
            for (int j = 0; j < 2; ++j) yo[i][j] = mfma16(af[i], bfm[j], yo[i][j]);
        }
#pragma unroll
        for (int i = 0; i < 2; ++i)
#pragma unroll
          for (int j = 0; j < 2; ++j) { const int pb = 16 * (2 * PI + i) + 4 * fq, l = 16 * (2 * JJ + j) + fr; const float e = fa[384 + l];
            f32x4 y = yd[i][j] + yo[i][j] * e;
            if (d == 0) { const u32x2 xs = *(const LAS u32x2*)(Xm + (l * LDX + pb) * 2); y += (f32x4){bflo(xs.x), bfhi(xs.x), bflo(xs.y), bfhi(xs.y)} * Dk; }
            u32x2 o; o.x = pk2(y[0], y[1]); o.y = pk2(y[2], y[3]); *(u32x2*)(Yd + (size_t)(r0 + sgn * l) * 1024 + h * 64 + pb) = o; }
      }
      blk_sync();
      if (c + 1 < NCH) SSD_TABLE(fab + ((c + 1) & 1) * 520);
#pragma unroll
      for (int i = 0; i < 2; ++i)
#pragma unroll
        for (int j = 0; j < 2; ++j) lds_store_bf16x4(Sb + ((16 * (2 * PJ + j) + fr) * LD + 16 * (2 * NI + i) + 4 * fq) * 2, ST[i][j]);
    }
  }
}


constexpr int HG_LD = 136, HG_LDV = 72;
constexpr int HG_OFF_G = 0, HG_OFF_QR = HG_OFF_G + 64 * 128 * 4, HG_OFF_KR = HG_OFF_QR + 64 * HG_LD * 2, HG_OFF_QG = HG_OFF_KR + 64 * HG_LD * 2, HG_OFF_KE = HG_OFF_QG + 64 * HG_LD * 2,
              HG_OFF_V = HG_OFF_KE + 64 * HG_LD * 2, HG_OFF_AT = HG_OFF_V + 64 * HG_LDV * 2, HG_OFF_S = HG_OFF_AT + 64 * HG_LDV * 2, HG_LDS_END = HG_OFF_S + 64 * HG_LD * 2;
static_assert(HG_LDS_END <= LDS_BYTES, "HGRN2 LDS map");
HD int hg_row(int b, int d, int s) { if (s < CTX) return TL + b * CTX + (d ? CTX - 1 - s : s); int tp = s - CTX; if (d) tp = SEQ - 1 - tp; return b * SEQ + (tp % ROWS) * GW + tp / ROWS; }
DEV void ph_hg_chunked(const P& p, LAS unsigned char* lds, int bid, int G) {
  const int t = tidx(), wid = PG8_UNIFORM(t >> 6), lane = t & 63, fr = lane & 15, fq = lane >> 4;
  constexpr int LD = HG_LD, LDV = HG_LDV;
  LAS float* Gm = (LAS float*)(lds + HG_OFF_G); LAS unsigned char* QRm = lds + HG_OFF_QR; LAS unsigned char* KRm = lds + HG_OFF_KR; LAS unsigned char* QGm = lds + HG_OFF_QG; LAS unsigned char* KEm = lds + HG_OFF_KE;
  LAS unsigned char* Vm = lds + HG_OFF_V; LAS unsigned char* ATm = lds + HG_OFF_AT; LAS unsigned char* Sb = lds + HG_OFF_S; LAS float* PT = (LAS float*)ATm;
  const bf16_t* P1 = (const bf16_t*)(p.ws + WS_P1);
  constexpr int NCH = (CTX + SEQ) / 64;
  for (int u = bid; u < NB * 32; u += G) {
    const int b = u >> 5, d = (u >> 4) & 1, h = (u >> 1) & 7, vh = u & 1;
    bf16_t* Od = (bf16_t*)(p.ws + WS_O) + (size_t)d * TL * 1024;
    f32x4 ST[2][2];
#pragma unroll
    for (int i = 0; i < 2; ++i)
#pragma unroll
      for (int j = 0; j < 2; ++j) ST[i][j] = (f32x4){0.f, 0.f, 0.f, 0.f};
    blk_sync();
    for (int i = t; i < 64 * LD / 2; i += NT) ((LAS unsigned*)Sb)[i] = 0u;
    u32x4 nlf[2], nq[2], nv;
#define HG_LOAD(cc) do { _Pragma("unroll") for (int i_ = 0; i_ < 2; ++i_) { const int v_ = t + NT * i_; const bf16_t* s_ = P1 + (size_t)hg_row(b, d, (cc) * 64 + (v_ >> 4)) * 5120 + h * 128 + (v_ & 15) * 8; \
        nlf[i_] = *(const u32x4*)(s_ + 3072 + d * 1024); nq[i_] = ((cc) * 64 >= CTX) ? *(const u32x4*)s_ : (u32x4){0u, 0u, 0u, 0u}; } \
      nv = *(const u32x4*)(P1 + (size_t)hg_row(b, d, (cc) * 64 + (t >> 3)) * 5120 + 2048 + h * 128 + vh * 64 + (t & 7) * 8); } while (0)
    HG_LOAD(0);
    for (int c = 0; c < NCH; ++c) {
      const bool lat = c * 64 >= CTX;
      u32x4 lfv[2], qv[2];
#pragma unroll
      for (int i = 0; i < 2; ++i) { const int v = t + NT * i, j = v >> 4, c16 = v & 15; lfv[i] = nlf[i]; qv[i] = nq[i];
        LAS float* gp = Gm + j * 128 + c16 * 8;
        *(LAS f32x4*)gp = 1.f - (f32x4){bflo(lfv[i].x), bfhi(lfv[i].x), bflo(lfv[i].y), bfhi(lfv[i].y)}; *(LAS f32x4*)(gp + 4) = 1.f - (f32x4){bflo(lfv[i].z), bfhi(lfv[i].z), bflo(lfv[i].w), bfhi(lfv[i].w)}; }
      { const int j = t >> 3, c8 = t & 7; *(LAS u32x4*)(Vm + (j * LDV + c8 * 8) * 2) = nv; }
      if (c + 1 < NCH) HG_LOAD(c + 1);
      blk_sync();
      { const int k = t & 127, part = t >> 7; float gv[16];
#pragma unroll
        for (int j = 0; j < 16; ++j) gv[j] = Gm[(part * 16 + j) * 128 + k];
#pragma unroll
        for (int j = 1; j < 16; ++j) gv[j] *= gv[j - 1];
        PT[part * 128 + k] = gv[15];
        blk_sync();
        float pre = 1.f;
#pragma unroll
        for (int q = 0; q < 3; ++q) pre *= (q < part) ? PT[q * 128 + k] : 1.f;
#pragma unroll
        for (int j = 0; j < 16; ++j) Gm[(part * 16 + j) * 128 + k] = gv[j] * pre;
      }
      blk_sync();
#pragma unroll
      for (int hh = 0; hh < 2; ++hh) {
        const int k0 = (t & 15) * 8 + hh * 4;
        const f32x4 p31 = *(const LAS f32x4*)(Gm + 31 * 128 + k0), p63 = *(const LAS f32x4*)(Gm + 63 * 128 + k0);
        f32x4 ip31;
#pragma unroll
        for (int e = 0; e < 4; ++e) ip31[e] = fdiv(1.f, p31[e]);
#pragma unroll
        for (int i = 0; i < 2; ++i) { const int v = t + NT * i, j = v >> 4;
          const f32x4 pc = *(const LAS f32x4*)(Gm + j * 128 + k0);
          const unsigned kw0 = hh ? lfv[i].z : lfv[i].x, kw1 = hh ? lfv[i].w : lfv[i].y, qw0 = hh ? qv[i].z : qv[i].x, qw1 = hh ? qv[i].w : qv[i].y;
          const f32x4 k4 = (f32x4){bflo(kw0), bfhi(kw0), bflo(kw1), bfhi(kw1)}, q4 = (f32x4){bflo(qw0), bfhi(qw0), bflo(qw1), bfhi(qw1)};
          f32x4 kip;
#pragma unroll
          for (int e = 0; e < 4; ++e) kip[e] = fdiv(k4[e], pc[e]);
          const f32x4 qg = q4 * pc;
          const int off = (j * LD + k0) * 2;
          lds_store_bf16x4(QRm + off, qg * ip31); lds_store_bf16x4(KRm + off, kip * p31); lds_store_bf16x4(QGm + off, qg); lds_store_bf16x4(KEm + off, kip * p63); }
      }
      blk_sync();
      const int TI = wid & 3, TJ = wid >> 2;
      if (lat && TI <= ((2 * TJ + 1) | 1)) {
        f32x4 at[2] = {(f32x4){0.f, 0.f, 0.f, 0.f}, (f32x4){0.f, 0.f, 0.f, 0.f}};
#pragma unroll
        for (int q = 0; q < 4; ++q) { const bf16x8 af = frag_row(KRm, LD, 16 * TI, 32 * q, lane);
#pragma unroll
          for (int j = 0; j < 2; ++j) at[j] = mfma16(af, frag_row(QRm, LD, 16 * (2 * TJ + j), 32 * q, lane), at[j]); }
#pragma unroll
        for (int j = 0; j < 2; ++j) { const int s = 16 * TI + 4 * fq, l = 16 * (2 * TJ + j) + fr; f32x4 m;
#pragma unroll
          for (int e = 0; e < 4; ++e) m[e] = (s + e <= l) ? at[j][e] : 0.f;
          lds_store_bf16x4(ATm + (l * LDV + s) * 2, m); }
      }
      const int KI = wid & 3, VJ = wid >> 2;
      f32x4 SN[2][2];
#pragma unroll
      for (int i = 0; i < 2; ++i) { const f32x4 dec = *(const LAS f32x4*)(Gm + 63 * 128 + 16 * (2 * KI + i) + 4 * fq);
#pragma unroll
        for (int j = 0; j < 2; ++j) SN[i][j] = ST[i][j] * dec; }
#pragma unroll
      for (int q = 0; q < 2; ++q) { bf16x8 af[2], bfm[2];
#pragma unroll
        for (int i = 0; i < 2; ++i) af[i] = frag_tr(KEm, LD, 16 * (2 * KI + i), 32 * q, lane);
#pragma unroll
        for (int j = 0; j < 2; ++j) bfm[j] = frag_tr(Vm, LDV, 16 * (2 * VJ + j), 32 * q, lane);
#pragma unroll
        for (int i = 0; i < 2; ++i)
#pragma unroll
          for (int j = 0; j < 2; ++j) SN[i][j] = mfma16(af[i], bfm[j], SN[i][j]); }
#pragma unroll
      for (int i = 0; i < 2; ++i)
#pragma unroll
        for (int j = 0; j < 2; ++j) ST[i][j] = SN[i][j];
      blk_sync();
      if (lat) { const int VI = wid & 3; f32x4 o[2] = {(f32x4){0.f, 0.f, 0.f, 0.f}, (f32x4){0.f, 0.f, 0.f, 0.f}};
        for (int q = 0; q <= TJ; ++q) { const bf16x8 af = frag_tr(Vm, LDV, 16 * VI, 32 * q, lane);
#pragma unroll
          for (int j = 0; j < 2; ++j) o[j] = mfma16(af, frag_row(ATm, LDV, 16 * (2 * TJ + j), 32 * q, lane), o[j]); }
#pragma unroll
        for (int q = 0; q < 4; ++q) { const bf16x8 af = frag_row(Sb, LD, 16 * VI, 32 * q, lane);
#pragma unroll
          for (int j = 0; j < 2; ++j) o[j] = mfma16(af, frag_row(QGm, LD, 16 * (2 * TJ + j), 32 * q, lane), o[j]); }
#pragma unroll
        for (int j = 0; j < 2; ++j) { const int l = 16 * (2 * TJ + j) + fr; u32x2 w; w.x = pk2(o[j][0], o[j][1]); w.y = pk2(o[j][2], o[j][3]);
          *(u32x2*)(Od + (size_t)hg_row(b, d, c * 64 + l) * 1024 + h * 128 + vh * 64 + 16 * VI + 4 * fq) = w; }
      }
      blk_sync();
#pragma unroll
      for (int i = 0; i < 2; ++i)
#pragma unroll
        for (int j = 0; j < 2; ++j) lds_store_bf16x4(Sb + ((16 * (2 * VJ + j) + fr) * LD + 16 * (2 * KI + i) + 4 * fq) * 2, ST[i][j]);
    }
  }
}


constexpr int MODL_SC = 0, MODL_PART = (NB + 1) * DM * 4;
static_assert(MODL_PART + 32 * (NB + 1) * 48 * 4 <= LDS_BYTES, "mod LDS map");
DEV void ph_mod2(const P& p, LAS unsigned char* lds, int bid, int G) {
  const int t = tidx();
  LAS float* SC = (LAS float*)(lds + MODL_SC); LAS float* PART = (LAS float*)(lds + MODL_PART);
  if (bid == 0 && t < 64) ((int*)(p.ws + WS_CTL))[t] = 0;
  if (bid == 0) for (int i = t; i < 1024; i += NT) ((float*)(p.ws + WS_LB))[i] = fdiv(1.f, 1.f + fexp(p.in[I_HGLB][i] - p.in[I_HGLB][1024 + i]));
  for (int i = t; i < (NB + 1) * DM; i += NT) { const int r = i / DM, k = i % DM; SC[i] = siluf_(r < NB ? p.in[I_C][r * DM + k] : p.in[I_CCTX][k]); }
  blk_sync();
  for (int cg = bid; cg < 2 * 6144 / 48; cg += G) {
    const int l = cg / 128, col0 = (cg % 128) * 48;
    if (t < 384) { const int c4 = t % 12, ks = t / 12; const float* W = p.in[I_MODW] + (size_t)l * DM * 6144 + col0 + 4 * c4;
      f32x4 acc[NB + 1];
#pragma unroll
      for (int r = 0; r <= NB; ++r) acc[r] = (f32x4){0.f, 0.f, 0.f, 0.f};
#pragma unroll
      for (int k8 = 0; k8 < 32; k8 += 16) { f32x4 w[16];
#pragma unroll
        for (int kk = 0; kk < 16; ++kk) w[kk] = *(const f32x4*)(W + (size_t)(ks * 32 + k8 + kk) * 6144);
#pragma unroll
        for (int kk = 0; kk < 16; ++kk) { const int k = ks * 32 + k8 + kk;
#pragma unroll
          for (int r = 0; r <= NB; ++r) acc[r] += w[kk] * SC[r * DM + k]; } }
#pragma unroll
      for (int r = 0; r <= NB; ++r) *(LAS f32x4*)(PART + (ks * (NB + 1) + r) * 48 + 4 * c4) = acc[r];
    }
    blk_sync();
    if (t < (NB + 1) * 48) { const int r = t / 48, c = t % 48; float s = 0.f;
#pragma unroll 8
      for (int ks = 0; ks < 32; ++ks) s += PART[(ks * (NB + 1) + r) * 48 + c];
      ((float*)(p.ws + WS_MODV))[(size_t)(l * (NB + 1) + r) * 6144 + col0 + c] = s + p.in[I_MODB][l * 6144 + col0 + c]; }
    blk_sync();
  }
}

constexpr int CVT_LDT = 72;
template <class Src> DEV void cvt_tiles(LAS unsigned char* lds, bf16_t* Bt, int N, int K, int ldw, const Src& src, int first, int step) {
  const int t = tidx(), lane = t & 63, wid = t >> 6; const int ntn = N / 64, ntk = K / 256;
  for (int tile = first; tile < ntn * ntk; tile += step) {
    const int n0 = (tile % ntn) * 64, k0 = (tile / ntn) * 256;
    f32x4 v[8];
#pragma unroll
    for (int i = 0; i < 8; ++i) { const int kk = (t >> 4) + 32 * i, n4 = (t & 15) * 4; const float* s = src(n0 + n4);
      v[i] = (f32x4){0.f, 0.f, 0.f, 0.f}; if (s) v[i] = *(const f32x4*)(s + (size_t)(k0 + kk) * ldw); }
#pragma unroll
    for (int i = 0; i < 8; ++i) { const int kk = (t >> 4) + 32 * i, n4 = (t & 15) * 4; u32x2 o; o.x = pk2(v[i][0], v[i][1]); o.y = pk2(v[i][2], v[i][3]); *(LAS u32x2*)(lds + (kk * CVT_LDT + n4) * 2) = o; }
    blk_sync();
#pragma unroll
    for (int g = 0; g < 4; ++g) { const bf16x8 f = frag_tr(lds, CVT_LDT, 16 * g, 32 * wid, lane);
      *(bf16x8*)(Bt + (size_t)(n0 + 16 * g + (lane & 15)) * K + k0 + 32 * wid + 8 * (lane >> 4)) = f; }
    blk_sync();
  }
}
DEV void ph_convert_dense2(const P& p, LAS unsigned char* lds, int bid, int G) {
  cvt_tiles(lds, (bf16_t*)(p.ws + WS_WIN0), N0P, 1024, AB_IN, SrcWin0{p.in[I_ABIN]}, bid, G);
  cvt_tiles(lds, (bf16_t*)(p.ws + WS_WOUT0), 1024, 2048, 1024, SrcId{p.in[I_ABOUT]}, bid, G);
  cvt_tiles(lds, (bf16_t*)(p.ws + WS_WHGI), 5120, 1024, HG_IN, SrcId{p.in[I_HGIN]}, bid, G);
  cvt_tiles(lds, (bf16_t*)(p.ws + WS_WHGO), 1024, 1024, 1024, SrcId{p.in[I_HGOUT]}, bid, G);
}
DEV void ph_convert_moe2(const P& p, int l, LAS unsigned char* lds, int rank, int nconv) {
  if (rank < 0) return;
  for (int e = 0; e < NE; ++e) { const size_t eo = (size_t)(l * NE + e); const int first = (rank + nconv - (e * 16) % nconv) % nconv;
    cvt_tiles(lds, (bf16_t*)(p.ws + WS_WGU) + (size_t)e * 1024 * 1024, 1024, 1024, DE, SrcGU{p.in[I_WG] + eo * DM * DE, p.in[I_WU] + eo * DM * DE}, first, nconv);
    cvt_tiles(lds, (bf16_t*)(p.ws + WS_WDT) + (size_t)e * 1024 * 512, 1024, 512, DM, SrcId{p.in[I_WD] + eo * DE * DM}, (first + 64) % nconv, nconv); }
}

template <int LWX> DEV float wsumT(float v) { if constexpr (LWX == 1) return v; else return bwsum(v); }
DEV float reduce16_scatter(const float (&v)[16], int lane) {
  float a[8], b[4], c[2];
  { const bool hi = (lane & 32) != 0;
#pragma unroll
    for (int j = 0; j < 8; ++j) { const float mine = hi ? v[8 + j] : v[j], other = hi ? v[j] : v[8 + j]; a[j] = mine + wshfl(other, lane ^ 32); } }
  { const bool hi = (lane & 16) != 0;
#pragma unroll
    for (int j = 0; j < 4; ++j) { const float mine = hi ? a[4 + j] : a[j], other = hi ? a[j] : a[4 + j]; b[j] = mine + wshfl(other, lane ^ 16); } }
  { const bool hi = (lane & 8) != 0;
#pragma unroll
    for (int j = 0; j < 2; ++j) { const float mine = hi ? b[2 + j] : b[j], other = hi ? b[j] : b[2 + j]; c[j] = mine + wshfl(other, lane ^ 8); } }
  float d;
  { const bool hi = (lane & 4) != 0; const float mine = hi ? c[1] : c[0], other = hi ? c[0] : c[1]; d = mine + wshfl(other, lane ^ 4); }
  d += wshfl(d, lane ^ 2); d += wshfl(d, lane ^ 1);
  return d;
}
constexpr int RT_OFF_RW = 0, RT_OFF_LG = 16 * 1024 * 4, RT_OFF_LE = RT_OFF_LG + 8 * 2 * 16 * 4;
template <int LWX> DEV void norm_tokens(const P& p, int l, int mb, bool from_input, int comb, bool route, int r_begin, int r_end, int wave, int nwaves, int lane, LAS unsigned char* lds) {
  constexpr int NV = DM / 4 / LWX;
  bf16_t* H = (bf16_t*)(p.ws + WS_H);
  const float* g = p.in[mb == 0 ? I_NMIXG : I_NFFNG] + l * DM;
  const bf16_t* YS = (const bf16_t*)(p.ws + WS_YS);
  f32x4 pa[NV], pb[NV], pg5[NV]; int cur_mr = -1;
  for (long r0 = r_begin + 2 * wave; r0 < r_end; r0 += 2 * nwaves) {
    f32x4 xv[2][NV]; float ss[2];
#pragma unroll
    for (int q = 0; q < 2; ++q) { const long r = r0 + q; const int mr = tok_modrow((int)r); float* xc = xcur_row(p, (int)r); const float* x = from_input ? xin_row(p, (int)r) : xc;
      if (mr != cur_mr) { cur_mr = mr; const float* sh = modv(p, l, mr, mb), *sc = modv(p, l, mr, mb + 1);
#pragma unroll
        for (int i = 0; i < NV; ++i) { const int k = 4 * (lane + LWX * i); pa[i] = *(const f32x4*)(g + k) * (*(const f32x4*)(sc + k) + 1.f); pb[i] = *(const f32x4*)(sh + k); pg5[i] = comb >= 0 ? *(const f32x4*)(modv(p, comb, mr, 5) + k) : (f32x4){0.f, 0.f, 0.f, 0.f}; } }
      ss[q] = 0.f;
#pragma unroll
      for (int i = 0; i < NV; ++i) { const int k = 4 * (lane + LWX * i); f32x4 v = *(const f32x4*)(x + k);
        if (comb >= 0) { const u32x2 a = *(const u32x2*)(YS + (size_t)(2 * r) * DM + k), b = *(const u32x2*)(YS + (size_t)(2 * r + 1) * DM + k);
          v += pg5[i] * ((f32x4){bflo(a.x), bfhi(a.x), bflo(a.y), bfhi(a.y)} + (f32x4){bflo(b.x), bfhi(b.x), bflo(b.y), bfhi(b.y)}); }
        xv[q][i] = v; ss[q] += v[0] * v[0] + v[1] * v[1] + v[2] * v[2] + v[3] * v[3]; } }
    if (comb >= 0) {
#pragma unroll
      for (int q = 0; q < 2; ++q) { float* xc = xcur_row(p, (int)(r0 + q));
#pragma unroll
        for (int i = 0; i < NV; ++i) *(f32x4*)(xc + 4 * (lane + LWX * i)) = xv[q][i]; } }
#pragma unroll
    for (int q = 0; q < 2; ++q) { const long r = r0 + q;
      const float rstd = frsqrt(wsumT<LWX>(ss[q]) / DM + EPS);
#pragma unroll
      for (int i = 0; i < NV; ++i) { const int k = 4 * (lane + LWX * i);
        const f32x4 h = xv[q][i] * rstd * pa[i] + pb[i];
        u32x2 o; o.x = pk2(h[0], h[1]); o.y = pk2(h[2], h[3]); *(u32x2*)(H + (size_t)r * DM + k) = o; xv[q][i] = h; } }
    if constexpr (LWX == 64) if (route) {
      float lg[2][NE];
#pragma unroll
      for (int e = 0; e < NE; ++e) { lg[0][e] = 0.f; lg[1][e] = 0.f; }
      const LAS float* RWt = (const LAS float*)(lds + RT_OFF_RW);
#pragma unroll
      for (int i = 0; i < NV; ++i) { int k = 4 * (lane + LWX * i);
#pragma unroll
        for (int e = 0; e < NE; ++e) {
          const f32x4 w = *(const LAS f32x4*)(RWt + e * DM + k); const f32x4 a = xv[0][i] * w, b = xv[1][i] * w;
          lg[0][e] += (a[0] + a[1]) + (a[2] + a[3]); lg[1][e] += (b[0] + b[1]) + (b[2] + b[3]);
          if ((e & 3) == 3) OPAQUE_ACC8(k, lg[0][e - 3], lg[0][e - 2], lg[0][e - 1], lg[0][e], lg[1][e - 3], lg[1][e - 2], lg[1][e - 1], lg[1][e]); } }
      LAS float* LG = (LAS float*)(lds + RT_OFF_LG) + wave * 32;
#pragma unroll
      for (int q = 0; q < 2; ++q) { const float tot = reduce16_scatter(lg[q], lane); if ((lane & 3) == 0) LG[q * 16 + (lane >> 2)] = tot; }
      wave_sync();
      if (lane < 2) { const int q = lane; const long r = r0 + q; float s[NE], sel[NE];
#pragma unroll
        for (int e4 = 0; e4 < 4; ++e4) { const f32x4 v = *(const LAS f32x4*)(LG + q * 16 + 4 * e4);
#pragma unroll
          for (int j = 0; j < 4; ++j) { s[4 * e4 + j] = sigmoidf_(v[j]); sel[4 * e4 + j] = s[4 * e4 + j] + p.in[I_RB][4 * e4 + j]; } }
        int bg = 0; float bgs = -1e30f;
#pragma unroll
        for (int gq = 0; gq < 4; ++gq) {
          float m1 = -1e30f, m2 = -1e30f;
#pragma unroll
          for (int i = 0; i < 4; ++i) { const float v = sel[gq * 4 + i]; if (v > m1) { m2 = m1; m1 = v; } else if (v > m2) m2 = v; }
          const float gs = m1 + m2;
          if (gs > bgs) { bgs = gs; bg = gq; }
        }
        int i1 = 0, i2 = 0; float v1 = -1e30f, v2 = -1e30f; float s1 = 0.f, s2 = 0.f;
#pragma unroll
        for (int gq = 0; gq < 4; ++gq) if (gq == bg) {
#pragma unroll
          for (int i = 0; i < 4; ++i) { const float v = sel[gq * 4 + i]; if (v > v1) { v1 = v; i1 = i; s1 = s[gq * 4 + i]; } }
#pragma unroll
          for (int i = 0; i < 4; ++i) { const float v = sel[gq * 4 + i]; if (i != i1 && v > v2) { v2 = v; i2 = i; s2 = s[gq * 4 + i]; } }
        }
        int* EI = (int*)(p.ws + WS_EIDX); float* EW = (float*)(p.ws + WS_EW); LAS int* LE = (LAS int*)(lds + RT_OFF_LE);
        const int e1 = bg * 4 + i1, e2 = bg * 4 + i2;
        EI[r * 2] = e1; EI[r * 2 + 1] = e2;
        const float inv = fdiv(1.f, s1 + s2);
        EW[r * 2] = s1 * inv; EW[r * 2 + 1] = s2 * inv;
        LE[2 * (r - r_begin)] = e1; LE[2 * (r - r_begin) + 1] = e2; LAS float* LWt = (LAS float*)(LE + 256); LWt[2 * (r - r_begin)] = s1 * inv; LWt[2 * (r - r_begin) + 1] = s2 * inv;
      }
      wave_sync();
    }
  }
}
HD void ph_norm2(const P& p, int l, int mb, bool from_input, int ntok, int comb, long tid, long nth) {
  const int nblk = (int)(nth / NT), blk = (int)(tid / NT), wpb = NT / LW, tpb = ((ntok + nblk - 1) / nblk + 1) & ~1, rb = blk * tpb, re = rb + tpb < ntok ? rb + tpb : ntok;
  if (rb < re) norm_tokens<LW>(p, l, mb, from_input, comb, false, rb, re, (int)((tid % NT) / LW), wpb, LANE, nullptr);
}
DEV void ph_norm_route(const P& p, int l, int ntok, LAS unsigned char* lds, int bid, int G) {
  const int t = tidx(); LAS int* LE = (LAS int*)(lds + RT_OFF_LE);
  const int tpb = ((ntok + G - 1) / G + 1) & ~1, rb = bid * tpb, re = rb + tpb < ntok ? rb + tpb : ntok;
  { LAS float* RWt = (LAS float*)(lds + RT_OFF_RW); for (int i = t; i < NE * DM; i += NT) RWt[i] = p.in[I_RW][(i & (DM - 1)) * NE + (i >> 10)]; }
  blk_sync();
  if (rb < re) norm_tokens<64>(p, l, 3, false, -1, true, rb, re, t >> 6, NT / 64, t & 63, lds);
  blk_sync();
  { LAS int* WC = (LAS int*)(lds + RT_OFF_LG);
    const LAS float* LWt = (const LAS float*)(LE + 256); const int ns = 2 * (re - rb), wv = t >> 6, ln = t & 63;
    const int e = (rb < re && t < ns) ? LE[t] : -1; int rank = 0;
#pragma unroll
    for (int q = 0; q < NE; ++q) { const unsigned long long m = wballot(e == q); if (e == q) rank = __builtin_popcountll(m & ((1ull << ln) - 1ull)); if (ln == 0) WC[wv * NE + q] = __builtin_popcountll(m); }
    blk_sync();
    if (t < NE) { int tot = 0;
#pragma unroll
      for (int w = 0; w < NT / 64; ++w) tot += WC[w * NE + t];
      WC[128 + t] = tot > 0 ? atomicAdd((int*)(p.ws + WS_CTL) + l * NE + t, tot) : 0; }
    blk_sync();
    if (e >= 0) { int pos = WC[128 + e] + rank; for (int w = 0; w < wv; ++w) pos += WC[w * NE + e];
      ((int*)(p.ws + WS_RSLOT))[(size_t)e * MOE_CAP + pos] = 2 * rb + t; ((float*)(p.ws + WS_RW))[(size_t)e * MOE_CAP + pos] = LWt[t]; } }
  blk_sync();
}

HD void ph_conv5b(const P& p, long tid, long nth) {
  const bf16_t* XR = (const bf16_t*)(p.ws + WS_XR); bf16_t* XBC = (bf16_t*)(p.ws + WS_XBC);
  for (long it = tid; it < (long)(TT / 8) * 256; it += nth) {
    const int c = (int)(it & 255) * 8, r0 = (int)(it >> 8) * 8;
    int t0, L; tok_pos(r0, t0, L);
    u32x4 win[12];
#pragma unroll
    for (int k = 0; k < 12; ++k) { const int tt = t0 + k - 2; const bool ok = tt >= 0 && tt < L; const int tc = tt < 0 ? 0 : (tt >= L ? L - 1 : tt);
      u32x4 v = *(const u32x4*)(XR + (size_t)(r0 - t0 + tc) * 2048 + c); v.x = ok ? v.x : 0u; v.y = ok ? v.y : 0u; v.z = ok ? v.z : 0u; v.w = ok ? v.w : 0u; win[k] = v; }
    f32x4 w0[5], w1[5];
#pragma unroll
    for (int k = 0; k < 5; ++k) { w0[k] = *(const f32x4*)(p.in[I_SCW] + k * 2048 + c); w1[k] = *(const f32x4*)(p.in[I_SCW] + k * 2048 + c + 4); }
    const f32x4 b0 = *(const f32x4*)(p.in[I_SCB] + c), b1 = *(const f32x4*)(p.in[I_SCB] + c + 4);
#pragma unroll
    for (int j = 0; j < 8; ++j) {
      f32x4 a0 = b0, a1 = b1;
#pragma unroll
      for (int k = 0; k < 5; ++k) { a0 += bf4lo(win[j + k]) * w0[k]; a1 += bf4hi(win[j + k]) * w1[k]; }
      store_bf16x8(XBC + (size_t)(r0 + j) * 2048 + c, silu4(a0), silu4(a1));
    }
  }
}

constexpr int CF_TILES = TL / 64 + TC / 32;
DEV void ph_cf_fused(const P& p, LAS unsigned char* lds, int bid, int G) {
  const int t = tidx(), lane = t & 63, grp = t >> 6;
  const bf16_t* U = (const bf16_t*)(p.ws + WS_U); bf16_t* OC = (bf16_t*)(p.ws + WS_XR);
  for (int tile = bid; tile < CF_TILES; tile += G) {
    int row0, nout, wlo, whi;
    if (tile < TL / 64) { row0 = tile * 64; nout = 64; wlo = row0; whi = row0 + 64; }
    else { const int q = tile - TL / 64; row0 = TL + q * 32; nout = 32; const int seg0 = TL + (q * 32 / CTX) * CTX; wlo = row0 - 15 < seg0 ? seg0 : row0 - 15; whi = row0 + 32 + 15 > seg0 + CTX ? seg0 + CTX : row0 + 32 + 15; }
    const int nw = whi - wlo;
    { u32x4 xr[16];
#pragma unroll
      for (int i = 0; i < 16; ++i) { int v = (t + NT * i) & 4095; const int sl = i >> 3; v = v < nw * 64 ? v : nw * 64 - 1; xr[i] = *(const u32x4*)(U + (size_t)(wlo + (v >> 6)) * 1024 + sl * 512 + (v & 63) * 8); }
#pragma unroll
      for (int i = 0; i < 16; ++i) { const int v = (t + NT * i) & 4095, sl = i >> 3; if (v < nw * 64) *(LAS u32x4*)(lds + sl * 65536 + (v >> 6) * 1024 + (v & 63) * 16) = xr[i]; } }
    blk_sync();
#pragma unroll
    for (int sl = 0; sl < 2; ++sl) {
      const int ch = sl * 512 + t; LAS unsigned char* slab = lds + sl * 65536;
      unsigned WE[16], WO[16];
      { float w[32];
#pragma unroll
        for (int j = 0; j < 31; ++j) w[j] = p.in[I_CFW][j * 1024 + ch];
        w[31] = 0.f;
#pragma unroll
        for (int q = 0; q < 16; ++q) { WE[q] = pk2(q ? w[2 * q - 1] : 0.f, w[2 * q]); WO[q] = pk2(w[2 * q], w[2 * q + 1]); } }
      unsigned X[48];
#pragma unroll
      for (int w = 0; w < 48; ++w) { const int r0_ = row0 + 2 * w - 16, r1_ = r0_ + 1; const bool ok0 = r0_ >= wlo && r0_ < whi, ok1 = r1_ >= wlo && r1_ < whi;
        const int c0 = r0_ < wlo ? wlo : (r0_ >= whi ? whi - 1 : r0_), c1 = r1_ < wlo ? wlo : (r1_ >= whi ? whi - 1 : r1_);
        const unsigned lo = *(const LAS bf16_t*)(slab + (c0 - wlo) * 1024 + t * 2), hi = *(const LAS bf16_t*)(slab + (c1 - wlo) * 1024 + t * 2);
        X[w] = (ok0 ? lo : 0u) | ((ok1 ? hi : 0u) << 16); }
      blk_sync();
      const float cb = p.in[I_CFB][ch];
#pragma unroll
      for (int l = 0; l < 64; l += 2) {
        float ae = cb, ao = cb;
#pragma unroll
        for (int q = 0; q < 16; ++q) { ae = dot2bf(X[l / 2 + q], WE[q], ae); ao = dot2bf(X[l / 2 + 1 + q], WO[q], ao); }
        const unsigned pr = pk2(ae, ao);
        *(LAS bf16_t*)(slab + l * 1024 + t * 2) = (bf16_t)(pr & 0xffffu); *(LAS bf16_t*)(slab + (l + 1) * 1024 + t * 2) = (bf16_t)(pr >> 16);
      }
    }
    blk_sync();
    {
      for (int i0 = 0; i0 < nout / 8; i0 += 2) {
        f32x4 a[2][4], g4[4], b4[4]; float s[2], q[2]; int lc = lane * 8; OPAQUE_INT(lc);
#pragma unroll
        for (int k = 0; k < 4; ++k) { const int c = (k >> 1) * 512 + lc + (k & 1) * 4; g4[k] = *(const f32x4*)(p.in[I_CFLG] + c); b4[k] = *(const f32x4*)(p.in[I_CFLB] + c); }
#pragma unroll
        for (int u = 0; u < 2; ++u) { const int l = grp + 8 * (i0 + u);
          const u32x4 v0 = *(const LAS u32x4*)(lds + l * 1024 + lane * 16), v1 = *(const LAS u32x4*)(lds + 65536 + l * 1024 + lane * 16);
          a[u][0] = bf4lo(v0); a[u][1] = bf4hi(v0); a[u][2] = bf4lo(v1); a[u][3] = bf4hi(v1); s[u] = 0.f;
#pragma unroll
          for (int k = 0; k < 4; ++k) s[u] += (a[u][k][0] + a[u][k][1]) + (a[u][k][2] + a[u][k][3]); }
#pragma unroll
        for (int u = 0; u < 2; ++u) s[u] = bwsum(s[u]) * (1.f / 1024.f);
#pragma unroll
        for (int u = 0; u < 2; ++u) { q[u] = 0.f;
#pragma unroll
          for (int k = 0; k < 4; ++k) { a[u][k] -= s[u]; q[u] += (a[u][k][0] * a[u][k][0] + a[u][k][1] * a[u][k][1]) + (a[u][k][2] * a[u][k][2] + a[u][k][3] * a[u][k][3]); } }
#pragma unroll
        for (int u = 0; u < 2; ++u) q[u] = frsqrt(bwsum(q[u]) * (1.f / 1024.f) + EPS);
#pragma unroll
        for (int u = 0; u < 2; ++u) { const int l = grp + 8 * (i0 + u);
#pragma unroll
          for (int sl = 0; sl < 2; ++sl) store_bf16x8(OC + (size_t)(row0 + l) * 2048 + 1024 + sl * 512 + lane * 8, silu4(a[u][2 * sl] * q[u] * g4[2 * sl] + b4[2 * sl]), silu4(a[u][2 * sl + 1] * q[u] * g4[2 * sl + 1] + b4[2 * sl + 1])); }
      } }
    blk_sync();
  }
}

HD void ph_ssd_readout3(const P& p, long tid, long nth) {
  constexpr int NV = 1024 / 8 / LW;
  const bf16_t* Y0 = (const bf16_t*)(p.ws + WS_Y); const bf16_t* Y1 = Y0 + (size_t)TT * 1024; const bf16_t* Z = (const bf16_t*)(p.ws + WS_Z); bf16_t* OC = (bf16_t*)(p.ws + WS_XR);
  const int lane = LANE;
  f32x4 gn0[NV], gn1[NV];
#pragma unroll
  for (int i = 0; i < NV; ++i) { const int k = 8 * (lane + LW * i); gn0[i] = *(const f32x4*)(p.in[I_SSDG] + k); gn1[i] = *(const f32x4*)(p.in[I_SSDG] + k + 4); }
  for (long r = tid / LW; r < TT; r += nth / LW) {
    f32x4 v0[NV], v1[NV]; float ss = 0.f;
#pragma unroll
    for (int i = 0; i < NV; ++i) { const size_t o = (size_t)r * 1024 + 8 * (lane + LW * i); const u32x4 a = *(const u32x4*)(Y0 + o), b = *(const u32x4*)(Y1 + o), z = *(const u32x4*)(Z + o);
      v0[i] = (bf4lo(a) + bf4lo(b)) * silu4(bf4lo(z)); v1[i] = (bf4hi(a) + bf4hi(b)) * silu4(bf4hi(z));
      ss += (v0[i][0] * v0[i][0] + v0[i][1] * v0[i][1]) + (v0[i][2] * v0[i][2] + v0[i][3] * v0[i][3]) + (v1[i][0] * v1[i][0] + v1[i][1] * v1[i][1]) + (v1[i][2] * v1[i][2] + v1[i][3] * v1[i][3]); }
    const float rstd = frsqrt(wsum(ss) / 1024.f + EPS);
#pragma unroll
    for (int i = 0; i < NV; ++i) { const int k = 8 * (lane + LW * i); store_bf16x8(OC + (size_t)r * 2048 + k, v0[i] * rstd * gn0[i], v1[i] * rstd * gn1[i]); }
  }
}
HD void ph_hg_readout3(const P& p, long tid, long nth) {
  constexpr int GL = LW >= 16 ? 16 : 1;
  constexpr int NV = 16 / GL;
  const bf16_t* O0 = (const bf16_t*)(p.ws + WS_O); const bf16_t* O1 = O0 + (size_t)TL * 1024; const bf16_t* P1 = (const bf16_t*)(p.ws + WS_P1); bf16_t* RO = (bf16_t*)(p.ws + WS_H);
  const int sub = (int)(tid % GL);
  f32x4 hn0[NV], hn1[NV];
#pragma unroll
  for (int i = 0; i < NV; ++i) { const int vv = 8 * (sub + GL * i); hn0[i] = *(const f32x4*)(p.in[I_HGNG] + vv); hn1[i] = *(const f32x4*)(p.in[I_HGNG] + vv + 4); }
  for (long it = tid / GL; it < (long)TL * 8; it += nth / GL) {
    const size_t base = (size_t)(it >> 3) * 1024 + (it & 7) * 128;
    f32x4 v0[NV], v1[NV]; float ss = 0.f;
#pragma unroll
    for (int i = 0; i < NV; ++i) { const size_t o = base + 8 * (sub + GL * i); const u32x4 a = *(const u32x4*)(O0 + o), b = *(const u32x4*)(O1 + o);
      v0[i] = bf4lo(a) + bf4lo(b); v1[i] = bf4hi(a) + bf4hi(b);
      ss += (v0[i][0] * v0[i][0] + v0[i][1] * v0[i][1]) + (v0[i][2] * v0[i][2] + v0[i][3] * v0[i][3]) + (v1[i][0] * v1[i][0] + v1[i][1] * v1[i][1]) + (v1[i][2] * v1[i][2] + v1[i][3] * v1[i][3]); }
    ss = gsum16(ss);
    const float rstd = frsqrt(ss / 128.f + EPS);
#pragma unroll
    for (int i = 0; i < NV; ++i) { const int vv = 8 * (sub + GL * i); const u32x4 gt = *(const u32x4*)(P1 + (size_t)(it >> 3) * 5120 + 1024 + (it & 7) * 128 + vv);
      store_bf16x8(RO + base + vv, v0[i] * rstd * hn0[i] * silu4(bf4lo(gt)), v1[i] * rstd * hn1[i] * silu4(bf4hi(gt))); }
  }
}
HD void ph_final2(const P& p, long tid, long nth) {
  constexpr int NV = DM / 4 / LW;
  const bf16_t* YS = (const bf16_t*)(p.ws + WS_YS); const int lane = LANE;
  f32x4 fg[NV];
#pragma unroll
  for (int i = 0; i < NV; ++i) fg[i] = *(const f32x4*)(p.in[I_FNG] + 4 * (lane + LW * i));
  for (long r = tid / LW; r < TL; r += nth / LW) {
    float* x = p.out + (size_t)r * DM; const float* g5 = modv(p, 1, tok_modrow((int)r), 5); f32x4 xv[NV]; float ss = 0.f;
#pragma unroll
    for (int i = 0; i < NV; ++i) { const int k = 4 * (lane + LW * i); const u32x2 a = *(const u32x2*)(YS + (size_t)(2 * r) * DM + k), b = *(const u32x2*)(YS + (size_t)(2 * r + 1) * DM + k);
      const f32x4 v = *(const f32x4*)(x + k) + *(const f32x4*)(g5 + k) * ((f32x4){bflo(a.x), bfhi(a.x), bflo(a.y), bfhi(a.y)} + (f32x4){bflo(b.x), bfhi(b.x), bflo(b.y), bfhi(b.y)});
      xv[i] = v; ss += v[0] * v[0] + v[1] * v[1] + v[2] * v[2] + v[3] * v[3]; }
    const float rstd = frsqrt(wsum(ss) / DM + EPS);
#pragma unroll
    for (int i = 0; i < NV; ++i) { const int k = 4 * (lane + LW * i); *(f32x4*)(x + k) = xv[i] * rstd * fg[i]; }
  }
}

#define OUTPROJ0_CVT_N(G) (((TT / 256) * 4 > (G) && (TT / 256) * 4 < 2 * (G)) ? 2 * (G) - (TT / 256) * 4 : (G))
#define OUTPROJ0_CVT_RANK(bid, G) (((TT / 256) * 4 > (G) && (TT / 256) * 4 < 2 * (G)) ? (bid) - ((TT / 256) * 4 - (G)) : (bid))
#define PROGRAM(T, B, SYNC) \
  B(ph_mod2(p, LDSP, bid, G)) B(ph_convert_dense2(p, LDSP, bid, G)) SYNC \
  T(ph_norm2(p, 0, 0, true, TT, -1, tid, nth)) SYNC \
  B(ph_gemm_inproj0(p, lds, bid, G)) SYNC \
  T(ph_conv5b(p, tid, nth)) SYNC \
  B(ph_ssd_chunked(p, LDSP, bid, G)) B(ph_cf_fused(p, LDSP, bid, G)) SYNC \
  T(ph_ssd_readout3(p, tid, nth)) SYNC \
  B(ph_gemm_outproj0(p, lds, bid, G)) B(ph_convert_moe2(p, 0, LDSP, OUTPROJ0_CVT_RANK(bid, G), OUTPROJ0_CVT_N(G))) SYNC \
  B(ph_norm_route(p, 0, TT, LDSP, bid, G)) SYNC \
  B(ph_gemm_moe1(p, 0, lds, bid, G)) SYNC \
  B(ph_gemm_moe2(p, 0, lds, bid, G)) SYNC \
  T(ph_norm2(p, 1, 0, false, TT, 0, tid, nth)) SYNC \
  B(ph_gemm_inproj1(p, lds, bid, G)) SYNC \
  B(ph_hg_chunked(p, LDSP, bid, G)) SYNC \
  T(ph_hg_readout3(p, tid, nth)) SYNC \
  B(ph_gemm_outproj1(p, lds, bid, G)) SYNC \
  B(ph_norm_route(p, 1, TL, LDSP, bid, G)) B(ph_convert_moe2(p, 1, LDSP, bid, G)) SYNC \
  B(ph_gemm_moe1(p, 1, lds, bid, G)) SYNC \
  B(ph_gemm_moe2(p, 1, lds, bid, G)) SYNC \
  T(ph_final2(p, tid, nth))

#ifndef CPU_TEST
#define XB_TMO      128
#define XB_XCNT(j)  (256  + 64 * (j))
#define XB_XSUB(j)  (1280 + 64 * (j))
#define XB_XGEN(j)  (2304 + 64 * (j))
#define XB_TOP      3328
#define XB_TOPGEN   3392
#define XCD_BAR_WORDS 3456
#define XB_SPIN_CAP (1u << 18)

__device__ __forceinline__ unsigned xb_ld(unsigned* p)              { return __hip_atomic_load(p, __ATOMIC_RELAXED, __HIP_MEMORY_SCOPE_AGENT); }
__device__ __forceinline__ unsigned xb_add(unsigned* p, unsigned v) { return __hip_atomic_fetch_add(p, v, __ATOMIC_RELAXED, __HIP_MEMORY_SCOPE_AGENT); }
__device__ __forceinline__ unsigned xb_xcc_id() { return (unsigned)__builtin_amdgcn_s_getreg((3 << 11) | 20) & 0xFu; }
#define XB_SPIN(cond, bar) do { unsigned _sp = 0; while (cond) { __builtin_amdgcn_s_sleep(1); \
    if ((++_sp & 255u) == 0u) { if (xb_ld(&(bar)[XB_TMO])) break; if (_sp > XB_SPIN_CAP) { atomicAdd(&(bar)[XB_TMO], 1u); break; } } } } while (0)

struct XcdBarrier {
    unsigned* bar; unsigned x;
    volatile LAS unsigned* st;
};

__device__ __forceinline__ XcdBarrier xcd_barrier_post(unsigned* bar, volatile LAS unsigned* st) {
    XcdBarrier b; b.bar = bar; b.x = xb_xcc_id(); b.st = st;
    if (threadIdx.x == 0) (void)xb_add(&bar[XB_XCNT(b.x)], 1u);
    return b;
}
__device__ __forceinline__ void xcd_barrier_complete(unsigned* bar, unsigned x, unsigned& nloc, unsigned& nx) {
    const unsigned G = gridDim.x * gridDim.y * gridDim.z;
    unsigned sum, cnt, mine, sp = 0u;
    for (;;) {
        sum = 0u; cnt = 0u; mine = 0u;
#pragma unroll
        for (unsigned j = 0; j < 16; ++j) { const unsigned c = xb_ld(&bar[XB_XCNT(j)]); sum += c; cnt += (c > 0u) ? 1u : 0u; mine = (j == x) ? c : mine; }
        if (sum == G) break;
        __builtin_amdgcn_s_sleep(1);
        if ((++sp & 255u) == 0u) { if (xb_ld(&bar[XB_TMO])) break; if (sp > XB_SPIN_CAP) { atomicAdd(&bar[XB_TMO], 1u); break; } }
    }
    nloc = mine > 0u ? mine : 1u; nx = cnt > 0u ? cnt : 1u;
}

__device__ __forceinline__ void xcd_barrier(const XcdBarrier& b) {
    asm volatile("s_waitcnt vmcnt(0)" ::: "memory");
    __syncthreads();
    if (threadIdx.x == 0) {
        unsigned* bar = b.bar;
        __builtin_amdgcn_s_waitcnt(0);
        unsigned nloc = b.st[0], nx = b.st[1];
        if (nloc == 0u) { xcd_barrier_complete(bar, b.x, nloc, nx); b.st[0] = nloc; b.st[1] = nx; }
        const unsigned old = xb_add(&bar[XB_XSUB(b.x)], 1u);
        const unsigned gen = old / nloc;
        if (old + 1u == (gen + 1u) * nloc) {
            __builtin_amdgcn_fence(__ATOMIC_RELEASE, "agent");
            asm volatile("s_waitcnt vmcnt(0)" ::: "memory");
            const unsigned og = xb_add(&bar[XB_TOP], 1u);
            const unsigned tg = og / nx;
            if (og + 1u == (tg + 1u) * nx) xb_add(&bar[XB_TOPGEN], 1u);
            else XB_SPIN(xb_ld(&bar[XB_TOPGEN]) == tg, bar);
            __builtin_amdgcn_fence(__ATOMIC_ACQUIRE, "agent");
            xb_add(&bar[XB_XGEN(b.x)], 1u);
            asm volatile("s_waitcnt vmcnt(0)" ::: "memory");
        } else {
            XB_SPIN(xb_ld(&bar[XB_XGEN(b.x)]) == gen, bar);
            __builtin_amdgcn_fence(__ATOMIC_ACQUIRE, "agent");
            asm volatile("s_waitcnt vmcnt(0)" ::: "memory");
        }
    }
    __syncthreads();
}

#endif

#ifndef CPU_TEST
__global__ void __launch_bounds__(NT) mega(P p) {
  extern __shared__ __attribute__((aligned(16))) unsigned char lds[];
  const long nth = (long)gridDim.x * NT;
  const int bid = blockIdx.x, G = gridDim.x;
#define LDSP ((LAS unsigned char*)lds)
#define T_(stmt_) { const long tid = (long)blockIdx.x * NT + tidx(); stmt_; }
#define B_(stmt_) stmt_;
  volatile LAS unsigned* xb_st = (volatile LAS unsigned*)(LDSP + LDS_BYTES - 64);
  if (threadIdx.x < 2) xb_st[threadIdx.x] = 0u;
  __syncthreads();
  const XcdBarrier xbar = xcd_barrier_post((unsigned*)(p.ws + WS_BAR), xb_st);
#define S_ xcd_barrier(xbar);
  PROGRAM(T_, B_, S_)
}

extern "C" void kernel_launch(void* const* d_in, const int* in_sizes, int n_in, void* d_out, int out_size,
                              void* d_ws, size_t ws_size, hipStream_t stream) {
  static int grid_blocks = 0;
  if (!grid_blocks) {
    int dev = 0, cus = 0, per_cu = 0;
    (void)hipGetDevice(&dev);
    (void)hipDeviceGetAttribute(&cus, hipDeviceAttributeMultiprocessorCount, dev);
    (void)hipFuncSetAttribute((const void*)mega, hipFuncAttributeMaxDynamicSharedMemorySize, LDS_BYTES);
    (void)hipOccupancyMaxActiveBlocksPerMultiprocessor(&per_cu, (const void*)mega, NT, LDS_BYTES);
    if (per_cu < 1) per_cu = 1;
    grid_blocks = cus * per_cu;
    if (n_in != N_IN || out_size != TL * DM || ws_size < WS_NEED) { fprintf(stderr, "kernel_launch: bad sizes n_in=%d out=%d ws=%zu need=%zu\n", n_in, out_size, ws_size, (size_t)WS_NEED); grid_blocks = -1; }
  }
  if (grid_blocks < 0) return;
  P p{};
  for (int i = 0; i < N_IN; ++i) p.in[i] = (const float*)d_in[i];
  p.out = (float*)d_out; p.ws = (unsigned char*)d_ws;
  (void)hipMemsetAsync((unsigned char*)d_ws + WS_BAR, 0, (size_t)XCD_BAR_WORDS * 4, stream);
  void* args[] = {&p};
  hipError_t e = hipLaunchCooperativeKernel((const void*)mega, dim3(grid_blocks), dim3(NT), args, LDS_BYTES, stream);
  if (e != hipSuccess) fprintf(stderr, "cooperative launch failed: %s (grid %d)\n", hipGetErrorString(e), grid_blocks);
}
#endif
```

```cpp
#ifndef CPU_TEST
#include <hip/hip_runtime.h>
#include <hip/hip_cooperative_groups.h>
namespace cg = cooperative_groups;
#define HD __host__ __device__ __forceinline__
#define DEV __device__ __forceinline__
#else
#define HD inline
#define DEV inline
#endif
#include <cstdio>
#include <cstdint>
#include <cmath>

#ifndef CFG_B
#define CFG_B 8
#define CFG_SEQ 2048
#define CFG_CTX 256
#endif
constexpr int NB = CFG_B, SEQ = CFG_SEQ, CTX = CFG_CTX, DM = 1024, GW = 64, ROWS = SEQ / GW;
constexpr int TL = NB * SEQ, TC = NB * CTX, TT = TL + TC;
constexpr int AB_IN = 5152, HG_IN = 5120, NE = 16, DE = 512;
constexpr float EPS = 1e-6f;
constexpr int NT = 512;
constexpr int LDS_BYTES = 147456;
static_assert(SEQ % 256 == 0 && CTX % 256 == 0, "token tiles of 256 must not straddle sequences");

typedef unsigned short bf16_t;
typedef float f32x4 __attribute__((ext_vector_type(4)));
typedef unsigned u32x4 __attribute__((ext_vector_type(4)));
HD float bf2f(bf16_t h) { unsigned u = (unsigned)h << 16; return __builtin_bit_cast(float, u); }
HD unsigned f2bfu(float f) { unsigned u = __builtin_bit_cast(unsigned, f); return (u + 0x7fffu + ((u >> 16) & 1u)) >> 16; }
HD bf16_t f2bf(float f) { return (bf16_t)f2bfu(f); }
#if defined(__HIP_DEVICE_COMPILE__)
typedef float f32x2_t __attribute__((ext_vector_type(2)));
typedef __bf16 bf16x2_t __attribute__((ext_vector_type(2)));
DEV unsigned pk2(float lo, float hi) { return __builtin_bit_cast(unsigned, __builtin_convertvector((f32x2_t){lo, hi}, bf16x2_t)); }
#else
HD unsigned pk2(float lo, float hi) { return f2bfu(lo) | (f2bfu(hi) << 16); }
#endif
HD float bflo(unsigned w) { return __builtin_bit_cast(float, w << 16); }
HD float bfhi(unsigned w) { return __builtin_bit_cast(float, w & 0xffff0000u); }
HD f32x4 bf4lo(u32x4 v) { return (f32x4){bflo(v.x), bfhi(v.x), bflo(v.y), bfhi(v.y)}; }
HD f32x4 bf4hi(u32x4 v) { return (f32x4){bflo(v.z), bfhi(v.z), bflo(v.w), bfhi(v.w)}; }
HD void store_bf16x8(bf16_t* dst, f32x4 a, f32x4 b) { u32x4 w; w.x = pk2(a[0], a[1]); w.y = pk2(a[2], a[3]); w.z = pk2(b[0], b[1]); w.w = pk2(b[2], b[3]); *(u32x4*)dst = w; }
#ifndef CPU_TEST
#define CHUNK_FENCE() asm volatile("" ::: "memory")
#define OPAQUE_INT(v) asm volatile("" : "+v"(v))
#define OPAQUE_ACC8(k, a0, a1, a2, a3, a4, a5, a6, a7) asm volatile("" : "+v"(k), "+v"(a0), "+v"(a1), "+v"(a2), "+v"(a3), "+v"(a4), "+v"(a5), "+v"(a6), "+v"(a7))
constexpr int LW = 64;
DEV int tidx() { int t = threadIdx.x; asm volatile("" : "+v"(t)); return t; }
#define LANE (tidx() & 63)
DEV float wsum(float v) { for (int o = 32; o; o >>= 1) v += __shfl_xor(v, o); return v; }
DEV float gsum16(float v) { for (int o = 8; o; o >>= 1) v += __shfl_xor(v, o); return v; }
DEV int atomic_inc_int(int* p) { return atomicAdd(p, 1); }
#else
inline int tidx() { return emu_tid(); }
#define CHUNK_FENCE()
#define OPAQUE_INT(v)
#define OPAQUE_ACC8(k, a0, a1, a2, a3, a4, a5, a6, a7)
constexpr int LW = 1;
#define LANE 0
inline float wsum(float v) { return v; }
inline float gsum16(float v) { return v; }
inline int atomic_inc_int(int* p) { return __atomic_fetch_add(p, 1, __ATOMIC_RELAXED); }
inline int atomicAdd(int* p, int v) { return __atomic_fetch_add(p, v, __ATOMIC_RELAXED); }
#endif
#if defined(__HIP_DEVICE_COMPILE__)
DEV float fexp(float x) { return __expf(x); }
DEV float flog(float x) { return __logf(x); }
DEV float fdiv(float a, float b) { return a * __builtin_amdgcn_rcpf(b); }
DEV float frsqrt(float x) { return __builtin_amdgcn_rsqf(x); }
#else
HD float fexp(float x) { return expf(x); }
HD float flog(float x) { return logf(x); }
HD float fdiv(float a, float b) { return a / b; }
HD float frsqrt(float x) { return 1.f / sqrtf(x); }
#endif
HD float sigmoidf_(float x) { return fdiv(1.f, 1.f + fexp(-x)); }
HD float siluf_(float x) { return fdiv(x, 1.f + fexp(-x)); }
HD float softplusf_(float x) { return x > 20.f ? x : flog(1.f + fexp(x)); }

enum { I_X, I_C, I_CTX, I_CCTX, I_MODW, I_MODB, I_NMIXG, I_NFFNG, I_RW, I_RB, I_WG, I_WU, I_WD, I_ABIN, I_SCW, I_SCB, I_DTB, I_ALOG, I_SSDD, I_SSDG,
       I_CFW, I_CFB, I_CFLG, I_CFLB, I_ABOUT, I_HGIN, I_HGLB, I_HGNG, I_HGOUT, I_FNG, N_IN };

constexpr size_t al256(size_t x) { return (x + 255) & ~(size_t)255; }
constexpr int NROWS_MAX = 2 * TT + NE * 256;
constexpr int N0P = 5376;
constexpr size_t WS_CTL = 0;
constexpr size_t WS_BAR = 1024;
constexpr size_t WS_LB = 16384;
constexpr size_t WS_MODV = 16384 + 4096;
constexpr size_t WS_DT = al256(WS_MODV + (size_t)2 * (NB + 1) * 6144 * 4);
constexpr size_t WS_XC = al256(WS_DT + (size_t)TT * 32 * 4);
constexpr size_t WS_EIDX = al256(WS_XC + (size_t)TC * DM * 4);
constexpr size_t WS_EW = al256(WS_EIDX + (size_t)TT * 2 * 4);
constexpr size_t WS_EPOS = al256(WS_EW + (size_t)TT * 2 * 4);
constexpr int MOE_CAP = TT;
constexpr size_t WS_RSLOT = al256(WS_EPOS + (size_t)TT * 2 * 4);
constexpr size_t WS_RW = al256(WS_RSLOT + (size_t)NE * MOE_CAP * 4);
constexpr size_t WS_WIN0 = al256(WS_RW + (size_t)NE * MOE_CAP * 4);
constexpr size_t WS_WOUT0 = al256(WS_WIN0 + (size_t)N0P * 1024 * 2);
constexpr size_t WS_WHGI = al256(WS_WOUT0 + (size_t)1024 * 2048 * 2);
constexpr size_t WS_WHGO = al256(WS_WHGI + (size_t)5120 * 1024 * 2);
constexpr size_t WS_H = al256(WS_WHGO + (size_t)1024 * 1024 * 2);
constexpr size_t WS_R = al256(WS_H + (size_t)TT * DM * 2);
constexpr size_t WS_Z = WS_R;
constexpr size_t WS_XR = al256(WS_Z + (size_t)TT * 1024 * 2);
constexpr size_t WS_U = al256(WS_XR + (size_t)TT * 2048 * 2);
constexpr size_t WS_XBC = al256(WS_U + (size_t)TT * 1024 * 2);
constexpr size_t WS_Y = al256(WS_XBC + (size_t)TT * 2048 * 2);
constexpr size_t WS_END0 = al256(WS_Y + (size_t)TT * 1024 * 4);
constexpr size_t WS_ACT = WS_R;
constexpr size_t WS_WGU = WS_XBC > al256(WS_ACT + (size_t)NROWS_MAX * 512 * 2) ? WS_XBC : al256(WS_ACT + (size_t)NROWS_MAX * 512 * 2);
constexpr size_t WS_WDT = al256(WS_WGU + (size_t)NE * 1024 * 1024 * 2);
constexpr size_t WS_YS = al256(WS_WDT + (size_t)NE * 1024 * 512 * 2);
constexpr size_t WS_ENDM = al256(WS_YS + (size_t)2 * TT * 1024 * 2);
static_assert(WS_ACT + (size_t)NROWS_MAX * 512 * 2 <= WS_WGU && (CFG_B != 8 || WS_WGU == WS_XBC), "MoE map");
constexpr size_t WS_P1 = WS_R;
constexpr size_t WS_O = al256(WS_P1 + (size_t)TT * 5120 * 2);
constexpr size_t WS_END1 = al256(WS_O + (size_t)TL * 1024 * 4);
constexpr size_t cmax(size_t a, size_t b) { return a > b ? a : b; }
constexpr size_t WS_NEED = cmax(WS_END0, cmax(WS_ENDM, WS_END1));
static_assert(WS_YS >= WS_O || true, "");

struct P { const float* in[N_IN]; float* out; unsigned char* ws; };

HD int tok_modrow(int r) { return r < TL ? r / SEQ : NB; }
HD const float* xin_row(const P& p, int r) { return r < TL ? p.in[I_X] + (size_t)r * DM : p.in[I_CTX] + (size_t)(r - TL) * DM; }
HD float* xcur_row(const P& p, int r) { return r < TL ? p.out + (size_t)r * DM : (float*)(p.ws + WS_XC) + (size_t)(r - TL) * DM; }
HD const float* modv(const P& p, int l, int row, int m) { return (const float*)(p.ws + WS_MODV) + ((size_t)(l * (NB + 1) + row) * 6 + m) * DM; }

struct SrcWin0 { const float* W; HD const float* operator()(int n) const {
    if (n < 3072) return W + n;
    if (n < 5120) { const int m = n - 3072, t = m >> 8, w = m & 255; return w < 128 ? W + 3104 + t * 128 + w : W + 4128 + t * 128 + (w - 128); }
    if (n < 5152) return W + 3072 + (n - 5120);
    return nullptr; } };
struct SrcId { const float* W; HD const float* operator()(int n) const { return W + n; } };
struct SrcGU { const float* Wg; const float* Wu; HD const float* operator()(int n) const { const int t = n >> 8, w = n & 255; return w < 128 ? Wg + t * 128 + w : Wu + t * 128 + (w - 128); } };


HD int moe_base(const int* CNT, int e) { int b = 0; for (int i = 0; i < NE; ++i) if (i < e) b += (CNT[i] + 255) & ~255; return b; }

typedef short bf16x8 __attribute__((ext_vector_type(8)));
typedef short s16x4 __attribute__((ext_vector_type(4)));
typedef unsigned u32x2 __attribute__((ext_vector_type(2)));
#ifndef CPU_TEST
#define LAS __attribute__((address_space(3)))
DEV void blk_sync() { asm volatile("s_waitcnt lgkmcnt(0)" ::: "memory"); __builtin_amdgcn_s_barrier(); asm volatile("" ::: "memory"); }
DEV float wshfl(float v, int src) { return __shfl(v, src); }
DEV unsigned long long wballot(bool pred) { return __ballot(pred); }
DEV void wave_sync() { asm volatile("s_waitcnt lgkmcnt(0)" ::: "memory"); __builtin_amdgcn_wave_barrier(); asm volatile("" ::: "memory"); }
DEV float bwsum(float v) { for (int o = 32; o; o >>= 1) v += __shfl_xor(v, o); return v; }
DEV f32x4 mfma16(bf16x8 a, bf16x8 b, f32x4 c) { return __builtin_amdgcn_mfma_f32_16x16x32_bf16(a, b, c, 0, 0, 0); }
DEV s16x4 lds_tr4(const LAS unsigned char* p) { return __builtin_amdgcn_ds_read_tr16_b64_v4i16((LAS s16x4*)p); }
#else
#define LAS
inline void blk_sync() { emu_block_barrier(); }
inline float wshfl(float v, int src) { return emu_shfl(v, src); }
inline unsigned long long wballot(bool pred) { return emu_ballot(pred); }
inline void wave_sync() { emu_wave_barrier(); }
inline float bwsum(float v) { for (int o = 32; o; o >>= 1) v += emu_shfl(v, (emu_tid() & 63) ^ o); return v; }
inline f32x4 mfma16(bf16x8 a, bf16x8 b, f32x4 c) { return emu_mfma_16x16x32(a, b, c); }
inline s16x4 lds_tr4(const unsigned char* p) { return emu_tr_read(p); }
#endif
#ifndef CPU_TEST
#define PIN4(a, b, c, d) asm volatile("" : "+v"(a), "+v"(b), "+v"(c), "+v"(d))
#define PIN8(a, b, c, d, e, f, g, h) asm volatile("" : "+v"(a), "+v"(b), "+v"(c), "+v"(d), "+v"(e), "+v"(f), "+v"(g), "+v"(h))
#define PIN12(a, b, c, d, e, f, g, h, i, j, k, l) asm volatile("" : "+v"(a), "+v"(b), "+v"(c), "+v"(d), "+v"(e), "+v"(f), "+v"(g), "+v"(h), "+v"(i), "+v"(j), "+v"(k), "+v"(l))
#else
#define PIN4(a, b, c, d)
#define PIN8(a, b, c, d, e, f, g, h)
#define PIN12(a, b, c, d, e, f, g, h, i, j, k, l)
#endif
DEV bf16x8 frag_row(const LAS unsigned char* m, int ld, int R0, int K0, int lane) { return *(const LAS bf16x8*)(m + ((R0 + (lane & 15)) * ld + K0 + 8 * (lane >> 4)) * 2); }
DEV bf16x8 frag_tr(const LAS unsigned char* m, int ld, int R0, int K0, int lane) {
  const int fq = lane >> 4, qq = (lane & 15) >> 2, pp = lane & 3;
  const LAS unsigned char* a = m + ((K0 + 8 * fq + qq) * ld + R0 + 4 * pp) * 2;
  const s16x4 lo = lds_tr4(a), hi = lds_tr4(a + 4 * ld * 2);
  return (bf16x8){lo[0], lo[1], lo[2], lo[3], hi[0], hi[1], hi[2], hi[3]};
}
#if defined(__HIP_DEVICE_COMPILE__)
DEV float dot2bf(unsigned a, unsigned b, float c) { return __builtin_amdgcn_fdot2_f32_bf16(__builtin_bit_cast(bf16x2_t, a), __builtin_bit_cast(bf16x2_t, b), c, false); }
#else
HD float dot2bf(unsigned a, unsigned b, float c) { return c + bflo(a) * bflo(b) + bfhi(a) * bfhi(b); }
#endif
DEV void store_lds8(LAS unsigned char* p, f32x4 a, f32x4 b) { u32x4 w; w.x = pk2(a[0], a[1]); w.y = pk2(a[2], a[3]); w.z = pk2(b[0], b[1]); w.w = pk2(b[2], b[3]); *(LAS u32x4*)p = w; }
DEV void lds_store_bf16x4(LAS unsigned char* p, f32x4 v) { u32x2 w; w.x = pk2(v[0], v[1]); w.y = pk2(v[2], v[3]); *(LAS u32x2*)p = w; }

namespace pg8 {
typedef short bf16x8 __attribute__((ext_vector_type(8)));
constexpr int BM = 256, BK = 64, HALF = 128, HTB = HALF * BK * 2, STAGE_BYTES = 8 * HTB, NXCD = 8, WGM = 8;
HD int lds_byte(int r, int c) { const int st = (r >> 4) * 2 + (c >> 5), rr = r & 15, cc = c & 31, ob = rr * 64 + cc * 2; return st * 1024 + (ob ^ (((ob >> 9) & 1) << 5)); }
HD void stage_rc(int b, int& R, int& C) { const int st = b / 1024, sb = b % 1024, swz = sb ^ (((sb >> 9) & 1) << 5); R = (st >> 1) * 16 + swz / 64; C = (st & 1) * 32 + (swz % 64) / 2; }
HD int perm32(int rho) { const int n = rho >> 4, i = rho & 15; return 8 * (i >> 2) + 4 * n + (i & 3); }
struct Unit { int pm, pn; const bf16_t* Bt; const int* rs; const float* rw; int nvalid; };
struct Gemm { const bf16_t* A; int K; };

HD void tile_order(int L, int nM, int nN, int& pm, int& pn) {
  const int nwg = nM * nN; int wgid = L;
  { const int q = nwg / NXCD, r = nwg % NXCD, xcd = wgid % NXCD, off = wgid / NXCD; wgid = (xcd < r ? xcd * (q + 1) : r * (q + 1) + (xcd - r) * q) + off; }
  const int nig = WGM * nN, gid = wgid / nig, fm = gid * WGM, gsz = (nM - fm) < WGM ? (nM - fm) : WGM;
  pm = fm + ((wgid % nig) % gsz); pn = (wgid % nig) / gsz;
}

#ifndef CPU_TEST
#define PG8_LAS __attribute__((address_space(3)))
#define PG8_GLDS(gp, lp) __builtin_amdgcn_global_load_lds((const unsigned*)(gp), (PG8_LAS unsigned*)(lp), 16, 0, 0)
#define PG8_WAIT_V(n) asm volatile("s_waitcnt vmcnt(" #n ")" ::: "memory")
#define PG8_WAIT_L(n) asm volatile("s_waitcnt lgkmcnt(" #n ")" ::: "memory")
#define PG8_BAR __builtin_amdgcn_s_barrier()
#define PG8_SCHED __builtin_amdgcn_sched_barrier(0)
#define PG8_PRIO(n) __builtin_amdgcn_s_setprio(n)
#define PG8_UNIFORM(x) __builtin_amdgcn_readfirstlane(x)
#define PG8_MFMA(a, b, c) __builtin_amdgcn_mfma_f32_16x16x32_bf16(a, b, c, 0, 0, 0)
#else
#define PG8_LAS
#define PG8_GLDS(gp, lp) emu_global_load_lds16((const void*)(gp), (void*)(lp))
#define PG8_WAIT_V(n)
#define PG8_WAIT_L(n)
#define PG8_BAR emu_block_barrier()
#define PG8_SCHED
#define PG8_PRIO(n)
#define PG8_UNIFORM(x) (x)
#define PG8_MFMA(a, b, c) emu_mfma_16x16x32(a, b, c)
#endif
template <class Epi, class Sched, bool GATHER = false, bool ALIGN_EPI = true, bool SP2 = true>
DEV void gemm_phase(PG8_LAS unsigned char* lds, const Gemm g, const Sched& S, const Epi& E) {
    const int tid = tidx(), wid = PG8_UNIFORM(tid >> 6), lane = tid & 63, wr = wid >> 2, wc = wid & 3, fr = lane & 15, fq = lane >> 4;
    const int K = g.K, nt = K / BK;
    unsigned voffA[2], voffB[2]; int stR[2], stC[2];
#pragma unroll
    for (int i = 0; i < 2; ++i) { int R, C; stage_rc(tid * 16 + i * 8192, R, C); const int Rb = Epi::PERM ? ((R & ~31) + perm32(R & 31)) : R; stR[i] = R; stC[i] = C;
        voffA[i] = (unsigned)(R * K + C) * 2u; voffB[i] = (unsigned)(Rb * K + C) * 2u; }
    const size_t kstep = (size_t)(BK * 2);
    const size_t hstep = (size_t)HALF * K * 2;
    const size_t tstep = 2 * hstep;
    const unsigned ldsw = (unsigned)wid * 1024u;
    const int aoff = lds_byte(wr * 64 + fr, fq * 8), boff = lds_byte(wc * 32 + fr, fq * 8);
#define PG8_SA(b, h) (((b) * 2 + (h)) * HTB)
#define PG8_SB(b, h) ((4 + (b) * 2 + (h)) * HTB)
#define PG8_STAGE(bufoff, gbase, voff) do { _Pragma("unroll") for (int _i = 0; _i < 2; ++_i) \
        PG8_GLDS((const char*)(gbase) + (voff)[_i], lds + (bufoff) + ldsw + _i * 8192); } while (0)
#define PG8_STAGE_A(bufoff, h, kb, vg0, vg1) do { if constexpr (GATHER) { if (h) PG8_STAGE(bufoff, kb, vg1); else PG8_STAGE(bufoff, kb, vg0); } else PG8_STAGE(bufoff, (kb) + (h) * hstep, voffA); } while (0)
#define PG8_ROWOFFS(U, v0, v1) do { if constexpr (GATHER) { _Pragma("unroll") for (int _i = 0; _i < 2; ++_i) { \
        const int l0_ = stR[_i], l1_ = HALF + stR[_i]; const int s0_ = l0_ < (U).nvalid ? (U).rs[l0_] : 0, s1_ = l1_ < (U).nvalid ? (U).rs[l1_] : 0; \
        v0[_i] = (unsigned)((s0_ >> 1) * K + stC[_i]) * 2u; v1[_i] = (unsigned)((s1_ >> 1) * K + stC[_i]) * 2u; } } } while (0)
#define PG8_LDA(dst, b, h) do { _Pragma("unroll") for (int m = 0; m < 4; ++m) _Pragma("unroll") for (int k = 0; k < 2; ++k) dst[m][k] = *(const PG8_LAS bf16x8*)(lds + PG8_SA(b, h) + aoff + m * 2048 + k * 1024); } while (0)
#define PG8_LDB(dst, b, h) do { _Pragma("unroll") for (int n = 0; n < 2; ++n) _Pragma("unroll") for (int k = 0; k < 2; ++k) dst[n][k] = *(const PG8_LAS bf16x8*)(lds + PG8_SB(b, h) + boff + n * 2048 + k * 1024); } while (0)
#define PG8_MMA(ai, bj, At, Bt) do { PG8_PRIO(1); _Pragma("unroll") for (int m = 0; m < 4; ++m) _Pragma("unroll") for (int n = 0; n < 2; ++n) _Pragma("unroll") for (int k = 0; k < 2; ++k) \
        acc[ai][bj][m][n] = PG8_MFMA(Bt[n][k], At[m][k], acc[ai][bj][m][n]); PG8_PRIO(0); } while (0)
    Unit cur, nxt; int ui = 0;
    if (!S.next(0, cur)) return;
    f32x4 acc[2][2][4][2];
#pragma unroll
    for (int a = 0; a < 2; ++a)
#pragma unroll
        for (int b = 0; b < 2; ++b)
#pragma unroll
            for (int m = 0; m < 4; ++m)
#pragma unroll
                for (int n = 0; n < 2; ++n) acc[a][b][m][n] = (f32x4){0.f, 0.f, 0.f, 0.f};
    bf16x8 At[4][2], B0[2][2], B1[2][2];
    unsigned cv0[2] = {0u, 0u}, cv1[2] = {0u, 0u}, nv0[2] = {0u, 0u}, nv1[2] = {0u, 0u};
    PG8_ROWOFFS(cur, cv0, cv1);
    const char* cA = GATHER ? (const char*)g.A : (const char*)g.A + (size_t)cur.pm * tstep; const char* cB = (const char*)cur.Bt + (size_t)cur.pn * tstep;
    if constexpr (SP2) {
        PG8_STAGE(PG8_SB(0, 0), cB, voffB); PG8_STAGE(PG8_SB(0, 1), cB + hstep, voffB); PG8_STAGE_A(PG8_SA(0, 0), 0, cA, cv0, cv1); PG8_STAGE_A(PG8_SA(0, 1), 1, cA, cv0, cv1);
        if (wr == 1) PG8_BAR;
        PG8_WAIT_V(2); PG8_BAR;
        PG8_STAGE(PG8_SB(1, 0), cB + kstep, voffB); PG8_STAGE_A(PG8_SA(1, 0), 0, cA + kstep, cv0, cv1); PG8_STAGE(PG8_SB(1, 1), cB + hstep + kstep, voffB);
        PG8_WAIT_V(6); PG8_BAR;
    } else {
        PG8_STAGE(PG8_SB(0, 0), cB, voffB); PG8_STAGE_A(PG8_SA(0, 0), 0, cA, cv0, cv1); PG8_STAGE(PG8_SB(0, 1), cB + hstep, voffB); PG8_STAGE_A(PG8_SA(0, 1), 1, cA, cv0, cv1);
        if (wr == 1) PG8_BAR;
        PG8_WAIT_V(4); PG8_BAR;
        PG8_STAGE(PG8_SB(1, 0), cB + kstep, voffB); PG8_STAGE_A(PG8_SA(1, 0), 0, cA + kstep, cv0, cv1); PG8_STAGE(PG8_SB(1, 1), cB + hstep + kstep, voffB);
        PG8_WAIT_V(6); PG8_BAR;
    }
    for (;;) {
        const bool has_next = S.next(ui + 1, nxt);
        if (has_next) PG8_ROWOFFS(nxt, nv0, nv1);
        else { nv0[0] = cv0[0]; nv0[1] = cv0[1]; nv1[0] = cv1[0]; nv1[1] = cv1[1]; }
        const char* nA = has_next ? (GATHER ? (const char*)g.A : (const char*)g.A + (size_t)nxt.pm * tstep) : cA; const char* nB = has_next ? (const char*)nxt.Bt + (size_t)nxt.pn * tstep : cB;
        for (int t = 0; t < nt; t += 2) {
            const bool last = (t == nt - 2);
            const char* a1 = cA + (size_t)(t + 1) * kstep;
            const char* a2 = last ? nA : cA + (size_t)(t + 2) * kstep; const char* b2 = last ? nB : cB + (size_t)(t + 2) * kstep;
            const char* a3 = a2 + kstep; const char* b3 = b2 + kstep;
            unsigned w0[2], w1[2];
            w0[0] = last ? nv0[0] : cv0[0]; w0[1] = last ? nv0[1] : cv0[1]; w1[0] = last ? nv1[0] : cv1[0]; w1[1] = last ? nv1[1] : cv1[1];
            if constexpr (SP2) {
            PG8_LDB(B0, 0, 0); PG8_LDB(B1, 0, 1); PG8_SCHED; PG8_LDA(At, 0, 0); PG8_STAGE_A(PG8_SA(1, 1), 1, a1, cv0, cv1);
            PG8_WAIT_V(8); PG8_WAIT_L(0); PG8_BAR; PG8_MMA(0, 0, At, B0); PG8_MMA(0, 1, At, B1); PG8_BAR; PG8_SCHED;
            PG8_LDA(At, 0, 1); PG8_STAGE(PG8_SB(0, 0), b2, voffB); PG8_STAGE(PG8_SB(0, 1), b2 + hstep, voffB); PG8_STAGE_A(PG8_SA(0, 0), 0, a2, w0, w1);
            PG8_WAIT_V(8); PG8_WAIT_L(0); PG8_BAR; PG8_MMA(1, 0, At, B0); PG8_MMA(1, 1, At, B1); PG8_BAR; PG8_SCHED;
            PG8_LDB(B0, 1, 0); PG8_LDB(B1, 1, 1); PG8_SCHED; PG8_LDA(At, 1, 0); PG8_STAGE_A(PG8_SA(0, 1), 1, a2, w0, w1);
            PG8_WAIT_V(8); PG8_WAIT_L(0); PG8_BAR; PG8_MMA(0, 0, At, B0); PG8_MMA(0, 1, At, B1); PG8_BAR; PG8_SCHED;
            PG8_LDA(At, 1, 1); PG8_STAGE(PG8_SB(1, 0), b3, voffB); PG8_STAGE(PG8_SB(1, 1), b3 + hstep, voffB); PG8_STAGE_A(PG8_SA(1, 0), 0, a3, w0, w1);
            PG8_WAIT_V(8); PG8_WAIT_L(0); PG8_BAR; PG8_MMA(1, 0, At, B0); PG8_MMA(1, 1, At, B1); PG8_BAR; PG8_SCHED;
            } else {
            PG8_LDB(B0, 0, 0); PG8_SCHED; PG8_LDA(At, 0, 0); PG8_STAGE_A(PG8_SA(1, 1), 1, a1, cv0, cv1);
            PG8_WAIT_L(8); PG8_BAR; PG8_WAIT_L(0); PG8_MMA(0, 0, At, B0); PG8_BAR; PG8_SCHED;
            PG8_LDB(B1, 0, 1); PG8_STAGE(PG8_SB(0, 0), b2, voffB);
            PG8_BAR; PG8_WAIT_L(0); PG8_MMA(0, 1, At, B1); PG8_BAR;
            PG8_LDA(At, 0, 1); PG8_STAGE_A(PG8_SA(0, 0), 0, a2, w0, w1);
            PG8_BAR; PG8_WAIT_L(0); PG8_MMA(1, 0, At, B0); PG8_BAR; PG8_SCHED;
            PG8_STAGE(PG8_SB(0, 1), b2 + hstep, voffB);
            PG8_WAIT_V(6); PG8_BAR; PG8_MMA(1, 1, At, B1); PG8_BAR;
            PG8_LDB(B0, 1, 0); PG8_SCHED; PG8_LDA(At, 1, 0); PG8_STAGE_A(PG8_SA(0, 1), 1, a2, w0, w1);
            PG8_WAIT_L(8); PG8_BAR; PG8_WAIT_L(0); PG8_MMA(0, 0, At, B0); PG8_BAR; PG8_SCHED;
            PG8_LDB(B1, 1, 1); PG8_STAGE(PG8_SB(1, 0), b3, voffB);
            PG8_BAR; PG8_WAIT_L(0); PG8_MMA(0, 1, At, B1); PG8_BAR;
            PG8_LDA(At, 1, 1); PG8_STAGE_A(PG8_SA(1, 0), 0, a3, w0, w1);
            PG8_BAR; PG8_WAIT_L(0); PG8_MMA(1, 0, At, B0); PG8_BAR; PG8_SCHED;
            PG8_STAGE(PG8_SB(1, 1), b3 + hstep, voffB);
            PG8_WAIT_V(6); PG8_BAR; PG8_MMA(1, 1, At, B1); PG8_BAR;
            }
        }
        if constexpr (ALIGN_EPI) { if (wr == 0) PG8_BAR; }
        E(acc, cur, wr, wc, fr, fq);
        if (!has_next) break;
#pragma unroll
        for (int a = 0; a < 2; ++a)
#pragma unroll
            for (int b = 0; b < 2; ++b)
#pragma unroll
                for (int m = 0; m < 4; ++m)
#pragma unroll
                    for (int n = 0; n < 2; ++n) acc[a][b][m][n] = (f32x4){0.f, 0.f, 0.f, 0.f};
        cur = nxt; cA = nA; cB = nB; ++ui; cv0[0] = nv0[0]; cv0[1] = nv0[1]; cv1[0] = nv1[0]; cv1[1] = nv1[1];
        if constexpr (ALIGN_EPI) { if (wr == 1) PG8_BAR; }
    }
    PG8_WAIT_V(0);
    if constexpr (!ALIGN_EPI) { if (wr == 0) PG8_BAR; }
    PG8_BAR;
#undef PG8_SA
#undef PG8_SB
#undef PG8_STAGE
#undef PG8_STAGE_A
#undef PG8_ROWOFFS
#undef PG8_LDA
#undef PG8_LDB
#undef PG8_MMA
}
#ifdef CPU_TEST
template <class Epi, class Sched> void gemm_phase_ref(const Gemm g, const Sched& S, const Epi& E) {
  Unit u;
  for (int ui = 0; S.next(ui, u); ++ui)
    for (int wid = 0; wid < 8; ++wid) for (int lane = 0; lane < 64; ++lane) {
      const int wr = wid >> 2, wc = wid & 3, fr = lane & 15, fq = lane >> 4;
      f32x4 acc[2][2][4][2];
      for (int ai = 0; ai < 2; ++ai) for (int bj = 0; bj < 2; ++bj) for (int m = 0; m < 4; ++m) for (int n = 0; n < 2; ++n) for (int i = 0; i < 4; ++i) {
        const size_t row = (size_t)u.pm * 256 + ai * 128 + wr * 64 + m * 16 + fr;
        const size_t col = (size_t)u.pn * 256 + bj * 128 + wc * 32 + (Epi::PERM ? 8 * fq + 4 * n + i : 16 * n + 4 * fq + i);
        const bf16_t* a = g.A + row * g.K, *b = u.Bt + col * g.K; float s = 0.f;
        for (int k = 0; k < g.K; ++k) s += bf2f(a[k]) * bf2f(b[k]);
        acc[ai][bj][m][n][i] = s;
      }
      E(acc, u, wr, wc, fr, fq);
    }
}
#define GEMM_RUN(lds, g, S, E) do { if (tidx() == 0) pg8::gemm_phase_ref(g, S, E); } while (0)
#define GEMM_RUN_GATHER(lds, g, S, E) pg8::gemm_phase<decltype(E), decltype(S), true>((unsigned char*)(lds), g, S, E)
#else
#define GEMM_RUN(lds, g, S, E) pg8::gemm_phase<decltype(E), decltype(S), false>((PG8_LAS unsigned char*)(lds), g, S, E)
#define GEMM_RUN_GATHER(lds, g, S, E) pg8::gemm_phase<decltype(E), decltype(S), true>((PG8_LAS unsigned char*)(lds), g, S, E)
#endif
}
using pg8::Unit; using pg8::Gemm;

struct DenseOrder { int nM, nN, G, c; const bf16_t* Bt;
  HD bool next(int i, Unit& u) const { const long L = (long)i * G + c; if (L >= (long)nM * nN) return false; pg8::tile_order((int)L, nM, nN, u.pm, u.pn); u.Bt = Bt; u.rs = nullptr; u.rw = nullptr; u.nvalid = 256; return true; } };
struct Inproj1Order { int G, c; const bf16_t* Bt;
  HD bool next(int i, Unit& u) const { const long L = (long)i * G + c; const int n1 = (TL / 256) * 20, n2 = (TC / 256) * 12; if (L >= n1 + n2) return false;
    if (L < n1) pg8::tile_order((int)L, TL / 256, 20, u.pm, u.pn); else { const int q = (int)L - n1; u.pm = TL / 256 + q % (TC / 256); u.pn = 8 + q / (TC / 256); }
    u.Bt = Bt; u.rs = nullptr; u.rw = nullptr; u.nvalid = 256; return true; } };
struct MoeOrder { int G, c; const int* CNT; const bf16_t* Bt; size_t estride; const int* RS; const float* RW;
  HD bool next(int i, Unit& u) const { const long L = (long)i * G + c; const int t = (int)(L >> 2); int tb = 0, e = -1, j = 0, ce = 0;
    for (int q = 0; q < NE; ++q) { const int cq = CNT[q], nt = (cq + 255) >> 8; if (e < 0 && t < tb + nt) { e = q; j = t - tb; ce = cq; } tb += nt; }
    if (e < 0) return false; u.pm = t; u.pn = (int)(L & 3); u.Bt = Bt + (size_t)e * estride;
    u.rs = RS + (size_t)e * MOE_CAP + 256 * j; u.rw = RW + (size_t)e * MOE_CAP + 256 * j; u.nvalid = ce - 256 * j < 256 ? ce - 256 * j : 256; return true; } };

HD f32x4 silu4(f32x4 v) { return (f32x4){siluf_(v[0]), siluf_(v[1]), siluf_(v[2]), siluf_(v[3])}; }
HD f32x4 sigm4(f32x4 v) { return (f32x4){sigmoidf_(v[0]), sigmoidf_(v[1]), sigmoidf_(v[2]), sigmoidf_(v[3])}; }
struct EpiInproj0 { static constexpr bool PERM = true; bf16_t* Z; bf16_t* XR; bf16_t* U; float* DT; const float* dtb;
  HD void operator()(const f32x4 (&acc)[2][2][4][2], const Unit& u, int wr, int wc, int fr, int fq) const {
#pragma unroll
    for (int ai = 0; ai < 2; ++ai)
#pragma unroll
      for (int m = 0; m < 4; ++m) {
        const size_t row = (size_t)u.pm * 256 + ai * 128 + wr * 64 + m * 16 + fr; const int cl = wc * 32 + 8 * fq;
        if (u.pn < 12) { bf16_t* base = u.pn < 4 ? Z + row * 1024 + u.pn * 256 : XR + row * 2048 + (u.pn - 4) * 256;
#pragma unroll
          for (int bj = 0; bj < 2; ++bj) store_bf16x8(base + bj * 128 + cl, acc[ai][bj][m][0], acc[ai][bj][m][1]); }
        else if (u.pn < 20) store_bf16x8(U + row * 1024 + (u.pn - 12) * 128 + cl, acc[ai][0][m][0] * sigm4(acc[ai][1][m][0]), acc[ai][0][m][1] * sigm4(acc[ai][1][m][1]));
        else if (wc == 0) {
#pragma unroll
          for (int n = 0; n < 2; ++n)
#pragma unroll
            for (int i = 0; i < 4; ++i) { const int j = 8 * fq + 4 * n + i; DT[row * 32 + j] = softplusf_(acc[ai][0][m][n][i] + dtb[j]); } }
      }
  } };
struct EpiResid { static constexpr bool PERM = false; const P* p; int l; bool from_input;
  HD void operator()(const f32x4 (&acc)[2][2][4][2], const Unit& u, int wr, int wc, int fr, int fq) const {
    const float* gate = modv(*p, l, tok_modrow(u.pm * 256), 2) + u.pn * 256 + wc * 32 + 4 * fq;
    f32x4 g4[2][2];
#pragma unroll
    for (int bj = 0; bj < 2; ++bj)
#pragma unroll
      for (int n = 0; n < 2; ++n) g4[bj][n] = *(const f32x4*)(gate + bj * 128 + 16 * n);
#pragma unroll
    for (int ai = 0; ai < 2; ++ai)
#pragma unroll
      for (int m = 0; m < 4; ++m) {
        const int row = u.pm * 256 + ai * 128 + wr * 64 + m * 16 + fr;
        const float* base = from_input ? xin_row(*p, row) : xcur_row(*p, row); float* dst = xcur_row(*p, row);
#pragma unroll
        for (int bj = 0; bj < 2; ++bj)
#pragma unroll
          for (int n = 0; n < 2; ++n) { const int c = u.pn * 256 + bj * 128 + wc * 32 + 16 * n + 4 * fq;
            *(f32x4*)(dst + c) = *(const f32x4*)(base + c) + g4[bj][n] * acc[ai][bj][m][n]; }
      }
  } };
struct EpiMoe1 { static constexpr bool PERM = true; bf16_t* ACT;
  HD void operator()(const f32x4 (&acc)[2][2][4][2], const Unit& u, int wr, int wc, int fr, int fq) const {
#pragma unroll
    for (int ai = 0; ai < 2; ++ai)
#pragma unroll
      for (int m = 0; m < 4; ++m) { const size_t row = (size_t)u.pm * 256 + ai * 128 + wr * 64 + m * 16 + fr;
        store_bf16x8(ACT + row * 512 + u.pn * 128 + wc * 32 + 8 * fq, silu4(acc[ai][0][m][0]) * acc[ai][1][m][0], silu4(acc[ai][0][m][1]) * acc[ai][1][m][1]); }
  } };
struct EpiMoe2 { static constexpr bool PERM = true; bf16_t* YS;
  HD void operator()(const f32x4 (&acc)[2][2][4][2], const Unit& u, int wr, int wc, int fr, int fq) const {
#pragma unroll
    for (int ai = 0; ai < 2; ++ai)
#pragma unroll
      for (int m = 0; m < 4; ++m) { const int li = ai * 128 + wr * 64 + m * 16 + fr;
        if (li < u.nvalid) { const int slot = u.rs[li]; const float w = u.rw[li]; bf16_t* dst = YS + (size_t)slot * 1024 + u.pn * 256 + wc * 32 + 8 * fq;
#pragma unroll
          for (int bj = 0; bj < 2; ++bj) store_bf16x8(dst + bj * 128, acc[ai][bj][m][0] * w, acc[ai][bj][m][1] * w); } }
  } };
struct EpiInproj1 { static constexpr bool PERM = true; bf16_t* P1; const float* lbt;
  HD void operator()(const f32x4 (&acc)[2][2][4][2], const Unit& u, int wr, int wc, int fr, int fq) const {
#pragma unroll
    for (int bj = 0; bj < 2; ++bj) { const int c = u.pn * 256 + bj * 128 + wc * 32 + 8 * fq;
      f32x4 lb0 = {0.f, 0.f, 0.f, 0.f}, lb1 = {0.f, 0.f, 0.f, 0.f};
      if (u.pn >= 12) { lb0 = *(const f32x4*)(lbt + (c & 1023)); lb1 = *(const f32x4*)(lbt + (c & 1023) + 4); }
#pragma unroll
      for (int ai = 0; ai < 2; ++ai)
#pragma unroll
        for (int m = 0; m < 4; ++m) { const size_t row = (size_t)u.pm * 256 + ai * 128 + wr * 64 + m * 16 + fr; f32x4 v0 = acc[ai][bj][m][0], v1 = acc[ai][bj][m][1];
          if (u.pn < 4) { v0 = silu4(v0); v1 = silu4(v1); }
          else if (u.pn >= 12) {
#pragma unroll
            for (int i = 0; i < 4; ++i) { v0[i] = (1.f - lb0[i]) * sigmoidf_(-v0[i]); v1[i] = (1.f - lb1[i]) * sigmoidf_(-v1[i]); } }
          store_bf16x8(P1 + row * 5120 + c, v0, v1); } }
  } };

DEV void ph_gemm_inproj0(const P& p, void* lds, int bid, int G) {
  Gemm g{(const bf16_t*)(p.ws + WS_H), 1024}; DenseOrder S{TT / 256, N0P / 256, G, bid, (const bf16_t*)(p.ws + WS_WIN0)};
  EpiInproj0 E{(bf16_t*)(p.ws + WS_Z), (bf16_t*)(p.ws + WS_XR), (bf16_t*)(p.ws + WS_U), (float*)(p.ws + WS_DT), p.in[I_DTB]};
  GEMM_RUN(lds, g, S, E);
}
DEV void ph_gemm_outproj0(const P& p, void* lds, int bid, int G) {
  Gemm g{(const bf16_t*)(p.ws + WS_XR), 2048}; DenseOrder S{TT / 256, 4, G, bid, (const bf16_t*)(p.ws + WS_WOUT0)}; EpiResid E{&p, 0, true};
  GEMM_RUN(lds, g, S, E);
}
DEV void ph_gemm_moe1(const P& p, int l, void* lds, int bid, int G) {
  Gemm g{(const bf16_t*)(p.ws + WS_H), 1024}; MoeOrder S{G, bid, (const int*)(p.ws + WS_CTL) + l * NE, (const bf16_t*)(p.ws + WS_WGU), (size_t)1024 * 1024, (const int*)(p.ws + WS_RSLOT), (const float*)(p.ws + WS_RW)}; EpiMoe1 E{(bf16_t*)(p.ws + WS_ACT)};
  GEMM_RUN_GATHER(lds, g, S, E);
}
DEV void ph_gemm_moe2(const P& p, int l, void* lds, int bid, int G) {
  Gemm g{(const bf16_t*)(p.ws + WS_ACT), 512}; MoeOrder S{G, bid, (const int*)(p.ws + WS_CTL) + l * NE, (const bf16_t*)(p.ws + WS_WDT), (size_t)1024 * 512, (const int*)(p.ws + WS_RSLOT), (const float*)(p.ws + WS_RW)};
  EpiMoe2 E{(bf16_t*)(p.ws + WS_YS)};
  GEMM_RUN(lds, g, S, E);
}
DEV void ph_gemm_inproj1(const P& p, void* lds, int bid, int G) {
  Gemm g{(const bf16_t*)(p.ws + WS_H), 1024}; Inproj1Order S{G, bid, (const bf16_t*)(p.ws + WS_WHGI)}; EpiInproj1 E{(bf16_t*)(p.ws + WS_P1), (const float*)(p.ws + WS_LB)};
  GEMM_RUN(lds, g, S, E);
}
DEV void ph_gemm_outproj1(const P& p, void* lds, int bid, int G) {
  Gemm g{(const bf16_t*)(p.ws + WS_H), 1024}; DenseOrder S{TL / 256, 4, G, bid, (const bf16_t*)(p.ws + WS_WHGO)}; EpiResid E{&p, 1, false};
  GEMM_RUN(lds, g, S, E);
}

HD void tok_pos(int r, int& t, int& L) { if (r < TL) { t = r % SEQ; L = SEQ; } else { t = (r - TL) % CTX; L = CTX; } }


constexpr int SSD_LD = 136, SSD_LDX = 72;
constexpr int SSD_OFF_C = 0, SSD_OFF_B = SSD_OFF_C + 128 * SSD_LD * 2, SSD_OFF_X = SSD_OFF_B + 128 * SSD_LD * 2, SSD_OFF_XW = SSD_OFF_X + 128 * SSD_LDX * 2,
              SSD_OFF_S = SSD_OFF_XW + 128 * SSD_LDX * 2, SSD_OFF_F = SSD_OFF_S + 64 * SSD_LD * 2, SSD_LDS_END = SSD_OFF_F + 2 * 520 * 4;
static_assert(SSD_LDS_END <= LDS_BYTES - 64, "SSD LDS map");
DEV void ph_ssd_chunked(const P& p, LAS unsigned char* lds, int bid, int G) {
  const int t = tidx(), wid = PG8_UNIFORM(t >> 6), lane = t & 63, fr = lane & 15, fq = lane >> 4;
  constexpr int LD = SSD_LD, LDX = SSD_LDX;
  LAS unsigned char* Cm = lds + SSD_OFF_C; LAS unsigned char* Bm = lds + SSD_OFF_B; LAS unsigned char* Xm = lds + SSD_OFF_X; LAS unsigned char* XWm = lds + SSD_OFF_XW; LAS unsigned char* Sb = lds + SSD_OFF_S;
  LAS float* fab = (LAS float*)(lds + SSD_OFF_F);
  const bf16_t* XBC = (const bf16_t*)(p.ws + WS_XBC); const float* DT = (const float*)(p.ws + WS_DT);
  constexpr int NCH = (CTX + SEQ) / 128;
  for (int u = bid; u < NB * 32; u += G) {
    const int b = u >> 5, d = (u >> 4) & 1, h = u & 15, g = h >> 2, sgn = d ? -1 : 1;
    const float a = -fexp(p.in[I_ALOG][d * 16 + h]), Dk = p.in[I_SSDD][h];
    bf16_t* Yd = (bf16_t*)(p.ws + WS_Y) + (size_t)d * TT * 1024;
    f32x4 ST[2][2];
#pragma unroll
    for (int i = 0; i < 2; ++i)
#pragma unroll
      for (int j = 0; j < 2; ++j) ST[i][j] = (f32x4){0.f, 0.f, 0.f, 0.f};
    blk_sync();
    for (int i = t; i < 64 * LD / 2; i += NT) ((LAS unsigned*)Sb)[i] = 0u;
    u32x4 nC[4], nB[4], nX[2]; float ndt0 = 0.f, ndt1 = 0.f;
#define SSD_R0(cc) ((cc) * 128 < CTX ? TL + b * CTX + (d ? CTX - 1 - (cc) * 128 : (cc) * 128) : b * SEQ + (d ? SEQ - 1 - ((cc) * 128 - CTX) : ((cc) * 128 - CTX)))
#define SSD_LOAD(cc) do { const int r0_ = SSD_R0(cc); \
      _Pragma("unroll") for (int i_ = 0; i_ < 4; ++i_) { const int v_ = t + NT * i_; const bf16_t* s_ = XBC + (size_t)(r0_ + sgn * (v_ >> 4)) * 2048 + g * 128 + (v_ & 15) * 8; nC[i_] = *(const u32x4*)(s_ + 1536); nB[i_] = *(const u32x4*)(s_ + 1024); } \
      _Pragma("unroll") for (int i_ = 0; i_ < 2; ++i_) { const int v_ = t + NT * i_; nX[i_] = *(const u32x4*)(XBC + (size_t)(r0_ + sgn * (v_ >> 3)) * 2048 + h * 64 + (v_ & 7) * 8); } \
      if (wid == 0) { ndt0 = DT[(size_t)(r0_ + sgn * (2 * lane)) * 32 + d * 16 + h]; ndt1 = DT[(size_t)(r0_ + sgn * (2 * lane + 1)) * 32 + d * 16 + h]; } } while (0)
    SSD_LOAD(0);
#define SSD_TABLE(dst) do { if (wid == 0) { LAS float* f_ = (dst); const int j0 = 2 * lane; const float dt0 = ndt0, dt1 = ndt1, la0 = dt0 * a, la1 = dt1 * a; float ps = la0 + la1; \
      _Pragma("unroll") for (int o = 1; o < 64; o <<= 1) { const float n_ = wshfl(ps, lane - o); if (lane >= o) ps += n_; } \
      const float end = wshfl(ps, 63), ac0 = ps - la1, ac1 = ps; \
      f_[j0] = dt0; f_[j0 + 1] = dt1; f_[128 + j0] = ac0; f_[129 + j0] = ac1; f_[256 + j0] = dt0 * fexp(end - ac0); f_[257 + j0] = dt1 * fexp(end - ac1); \
      f_[384 + j0] = fexp(ac0); f_[385 + j0] = fexp(ac1); if (lane == 0) f_[512] = fexp(end); } } while (0)
    SSD_TABLE(fab);
    for (int c = 0; c < NCH; ++c) {
      const int s0 = c * 128;
      const int r0 = s0 < CTX ? TL + b * CTX + (d ? CTX - 1 - s0 : s0) : b * SEQ + (d ? SEQ - 1 - (s0 - CTX) : (s0 - CTX));
      u32x4 xv[2];
#pragma unroll
      for (int i = 0; i < 4; ++i) { const int v = t + NT * i, row = v >> 4, c16 = v & 15; *(LAS u32x4*)(Cm + row * LD * 2 + c16 * 16) = nC[i]; *(LAS u32x4*)(Bm + row * LD * 2 + c16 * 16) = nB[i]; }
#pragma unroll
      for (int i = 0; i < 2; ++i) { const int v = t + NT * i, row = v >> 3, c8 = v & 7; xv[i] = nX[i]; *(LAS u32x4*)(Xm + row * LDX * 2 + c8 * 16) = xv[i]; }
      if (c + 1 < NCH) SSD_LOAD(c + 1);
      LAS float* fa = fab + (c & 1) * 520;
      blk_sync();
#pragma unroll
      for (int i = 0; i < 2; ++i) { const int v = t + NT * i, row = v >> 3, c8 = v & 7; const float w = fa[256 + row]; u32x4 o;
        o.x = pk2(bflo(xv[i].x) * w, bfhi(xv[i].x) * w); o.y = pk2(bflo(xv[i].y) * w, bfhi(xv[i].y) * w); o.z = pk2(bflo(xv[i].z) * w, bfhi(xv[i].z) * w); o.w = pk2(bflo(xv[i].w) * w, bfhi(xv[i].w) * w);
        *(LAS u32x4*)(XWm + row * LDX * 2 + c8 * 16) = o; }
      const int I1 = (0x22331100 >> (4 * wid)) & 3, J1 = (0x01011010 >> (4 * wid)) & 1;
      f32x4 cb[2][4];
#pragma unroll
      for (int i = 0; i < 2; ++i)
#pragma unroll
        for (int j = 0; j < 4; ++j) cb[i][j] = (f32x4){0.f, 0.f, 0.f, 0.f};
      if (2 * I1 <= ((4 * J1 + 3) | 1)) {
#pragma unroll
        for (int q = 0; q < 4; ++q) {
          bf16x8 af[2], bfm[4];
#pragma unroll
          for (int i = 0; i < 2; ++i) af[i] = frag_row(Bm, LD, 16 * (2 * I1 + i), 32 * q, lane);
#pragma unroll
          for (int j = 0; j < 4; ++j) bfm[j] = frag_row(Cm, LD, 16 * (4 * J1 + j), 32 * q, lane);
#pragma unroll
          for (int i = 0; i < 2; ++i)
#pragma unroll
            for (int j = 0; j < 4; ++j) if (2 * I1 + i <= ((4 * J1 + j) | 1)) cb[i][j] = mfma16(af[i], bfm[j], cb[i][j]);
        }
      }
      blk_sync();
      const int NI = wid & 3, PJ = wid >> 2;
      { const float dec = fa[512];
#pragma unroll
        for (int i = 0; i < 2; ++i)
#pragma unroll
          for (int j = 0; j < 2; ++j) ST[i][j] *= dec;
#pragma unroll
        for (int q = 0; q < 4; ++q) {
          bf16x8 af[2], bfm[2];
#pragma unroll
          for (int i = 0; i < 2; ++i) af[i] = frag_tr(Bm, LD, 16 * (2 * NI + i), 32 * q, lane);
#pragma unroll
          for (int j = 0; j < 2; ++j) bfm[j] = frag_tr(XWm, LDX, 16 * (2 * PJ + j), 32 * q, lane);
#pragma unroll
          for (int i = 0; i < 2; ++i)
#pragma unroll
            for (int j = 0; j < 2; ++j) ST[i][j] = mfma16(af[i], bfm[j], ST[i][j]);
        }
      }
      blk_sync();
#pragma unroll
      for (int i = 0; i < 2; ++i)
#pragma unroll
        for (int j = 0; j < 4; ++j) if (2 * I1 + i <= ((4 * J1 + j) | 1)) {
          const int s = 16 * (2 * I1 + i) + 4 * fq, l = 16 * (4 * J1 + j) + fr; const float al = fa[128 + l];
          const f32x4 as = *(const LAS f32x4*)(fa + 128 + s), ds = *(const LAS f32x4*)(fa + s); f32x4 m;
#pragma unroll
          for (int e = 0; e < 4; ++e) m[e] = (s + e <= l) ? cb[i][j][e] * fexp(al - as[e]) * ds[e] : 0.f;
          lds_store_bf16x4(Bm + (l * LD + s) * 2, m);
        }
      blk_sync();
      { const int PI = wid & 1, JJ = wid >> 1;
        f32x4 yd[2][2], yo[2][2];
#pragma unroll
        for (int i = 0; i < 2; ++i)
#pragma unroll
          for (int j = 0; j < 2; ++j) { yd[i][j] = (f32x4){0.f, 0.f, 0.f, 0.f}; yo[i][j] = (f32x4){0.f, 0.f, 0.f, 0.f}; }
        for (int q = 0; q <= JJ; ++q) {
          bf16x8 af[2], bfm[2];
#pragma unroll
          for (int i = 0; i < 2; ++i) af[i] = frag_tr(Xm, LDX, 16 * (2 * PI + i), 32 * q, lane);
#pragma unroll
          for (int j = 0; j < 2; ++j) bfm[j] = frag_row(Bm, LD, 16 * (2 * JJ + j), 32 * q, lane);
#pragma unroll
          for (int i = 0; i < 2; ++i)
#pragma unroll
            for (int j = 0; j < 2; ++j) yd[i][j] = mfma16(af[i], bfm[j], yd[i][j]);
        }
#pragma unroll
        for (int q = 0; q < 4; ++q) {
          bf16x8 af[2], bfm[2];
#pragma unroll
          for (int i = 0; i < 2; ++i) af[i] = frag_row(Sb, LD, 16 * (2 * PI + i), 32 * q, lane);
#pragma unroll
          for (int j = 0; j < 2; ++j) bfm[j] = frag_row(Cm, LD, 16 * (2 * JJ + j), 32 * q, lane);
#pragma unroll
          for (int i = 0; i < 2; ++i)
#pragma unroll
            for (int j = 0; j < 2; ++j) yo[i][j] = mfma16(af[i], bfm[j], yo[i][j]);
        }
#pragma unroll
        for (int i = 0; i < 2; ++i)
#pragma unroll
          for (int j = 0; j < 2; ++j) { const int pb = 16 * (2 * PI + i) + 4 * fq, l = 16 * (2 * JJ + j) + fr; const float e = fa[384 + l];
            f32x4 y = yd[i][j] + yo[i][j] * e;
            if (d == 0) { const u32x2 xs = *(const LAS u32x2*)(Xm + (l * LDX + pb) * 2); y += (f32x4){bflo(xs.x), bfhi(xs.x), bflo(xs.y), bfhi(xs.y)} * Dk; }
            u32x2 o; o.x = pk2(y[0], y[1]); o.y = pk2(y[2], y[3]); *(u32x2*)(Yd + (size_t)(r0 + sgn * l) * 1024 + h * 64 + pb) = o; }
      }
      blk_sync();
      if (c + 1 < NCH) SSD_TABLE(fab + ((c + 1) & 1) * 520);
#pragma unroll
      for (int i = 0; i < 2; ++i)
#pragma unroll
        for (int j = 0; j < 2; ++j) lds_store_bf16x4(Sb + ((16 * (2 * PJ + j) + fr) * LD + 16 * (2 * NI + i) + 4 * fq) * 2, ST[i][j]);
    }
  }
}


constexpr int HG_LD = 136, HG_LDV = 72;
constexpr int HG_OFF_G = 0, HG_OFF_QR = HG_OFF_G + 64 * 128 * 4, HG_OFF_KR = HG_OFF_QR + 64 * HG_LD * 2, HG_OFF_QG = HG_OFF_KR + 64 * HG_LD * 2, HG_OFF_KE = HG_OFF_QG + 64 * HG_LD * 2,
              HG_OFF_V = HG_OFF_KE + 64 * HG_LD * 2, HG_OFF_AT = HG_OFF_V + 64 * HG_LDV * 2, HG_OFF_S = HG_OFF_AT + 64 * HG_LDV * 2, HG_LDS_END = HG_OFF_S + 64 * HG_LD * 2;
static_assert(HG_LDS_END <= LDS_BYTES, "HGRN2 LDS map");
HD int hg_row(int b, int d, int s) { if (s < CTX) return TL + b * CTX + (d ? CTX - 1 - s : s); int tp = s - CTX; if (d) tp = SEQ - 1 - tp; return b * SEQ + (tp % ROWS) * GW + tp / ROWS; }
DEV void ph_hg_chunked(const P& p, LAS unsigned char* lds, int bid, int G) {
  const int t = tidx(), wid = PG8_UNIFORM(t >> 6), lane = t & 63, fr = lane & 15, fq = lane >> 4;
  constexpr int LD = HG_LD, LDV = HG_LDV;
  LAS float* Gm = (LAS float*)(lds + HG_OFF_G); LAS unsigned char* QRm = lds + HG_OFF_QR; LAS unsigned char* KRm = lds + HG_OFF_KR; LAS unsigned char* QGm = lds + HG_OFF_QG; LAS unsigned char* KEm = lds + HG_OFF_KE;
  LAS unsigned char* Vm = lds + HG_OFF_V; LAS unsigned char* ATm = lds + HG_OFF_AT; LAS unsigned char* Sb = lds + HG_OFF_S; LAS float* PT = (LAS float*)ATm;
  const bf16_t* P1 = (const bf16_t*)(p.ws + WS_P1);
  constexpr int NCH = (CTX + SEQ) / 64;
  for (int u = bid; u < NB * 32; u += G) {
    const int b = u >> 5, d = (u >> 4) & 1, h = (u >> 1) & 7, vh = u & 1;
    bf16_t* Od = (bf16_t*)(p.ws + WS_O) + (size_t)d * TL * 1024;
    f32x4 ST[2][2];
#pragma unroll
    for (int i = 0; i < 2; ++i)
#pragma unroll
      for (int j = 0; j < 2; ++j) ST[i][j] = (f32x4){0.f, 0.f, 0.f, 0.f};
    blk_sync();
    for (int i = t; i < 64 * LD / 2; i += NT) ((LAS unsigned*)Sb)[i] = 0u;
    u32x4 nlf[2], nq[2], nv;
#define HG_LOAD(cc) do { _Pragma("unroll") for (int i_ = 0; i_ < 2; ++i_) { const int v_ = t + NT * i_; const bf16_t* s_ = P1 + (size_t)hg_row(b, d, (cc) * 64 + (v_ >> 4)) * 5120 + h * 128 + (v_ & 15) * 8; \
        nlf[i_] = *(const u32x4*)(s_ + 3072 + d * 1024); nq[i_] = ((cc) * 64 >= CTX) ? *(const u32x4*)s_ : (u32x4){0u, 0u, 0u, 0u}; } \
      nv = *(const u32x4*)(P1 + (size_t)hg_row(b, d, (cc) * 64 + (t >> 3)) * 5120 + 2048 + h * 128 + vh * 64 + (t & 7) * 8); } while (0)
    HG_LOAD(0);
    for (int c = 0; c < NCH; ++c) {
      const bool lat = c * 64 >= CTX;
      u32x4 lfv[2], qv[2];
#pragma unroll
      for (int i = 0; i < 2; ++i) { const int v = t + NT * i, j = v >> 4, c16 = v & 15; lfv[i] = nlf[i]; qv[i] = nq[i];
        LAS float* gp = Gm + j * 128 + c16 * 8;
        *(LAS f32x4*)gp = 1.f - (f32x4){bflo(lfv[i].x), bfhi(lfv[i].x), bflo(lfv[i].y), bfhi(lfv[i].y)}; *(LAS f32x4*)(gp + 4) = 1.f - (f32x4){bflo(lfv[i].z), bfhi(lfv[i].z), bflo(lfv[i].w), bfhi(lfv[i].w)}; }
      { const int j = t >> 3, c8 = t & 7; *(LAS u32x4*)(Vm + (j * LDV + c8 * 8) * 2) = nv; }
      if (c + 1 < NCH) HG_LOAD(c + 1);
      blk_sync();
      { const int k = t & 127, part = t >> 7; float gv[16];
#pragma unroll
        for (int j = 0; j < 16; ++j) gv[j] = Gm[(part * 16 + j) * 128 + k];
#pragma unroll
        for (int j = 1; j < 16; ++j) gv[j] *= gv[j - 1];
        PT[part * 128 + k] = gv[15];
        blk_sync();
        float pre = 1.f;
#pragma unroll
        for (int q = 0; q < 3; ++q) pre *= (q < part) ? PT[q * 128 + k] : 1.f;
#pragma unroll
        for (int j = 0; j < 16; ++j) Gm[(part * 16 + j) * 128 + k] = gv[j] * pre;
      }
      blk_sync();
#pragma unroll
      for (int hh = 0; hh < 2; ++hh) {
        const int k0 = (t & 15) * 8 + hh * 4;
        const f32x4 p31 = *(const LAS f32x4*)(Gm + 31 * 128 + k0), p63 = *(const LAS f32x4*)(Gm + 63 * 128 + k0);
        f32x4 ip31;
#pragma unroll
        for (int e = 0; e < 4; ++e) ip31[e] = fdiv(1.f, p31[e]);
#pragma unroll
        for (int i = 0; i < 2; ++i) { const int v = t + NT * i, j = v >> 4;
          const f32x4 pc = *(const LAS f32x4*)(Gm + j * 128 + k0);
          const unsigned kw0 = hh ? lfv[i].z : lfv[i].x, kw1 = hh ? lfv[i].w : lfv[i].y, qw0 = hh ? qv[i].z : qv[i].x, qw1 = hh ? qv[i].w : qv[i].y;
          const f32x4 k4 = (f32x4){bflo(kw0), bfhi(kw0), bflo(kw1), bfhi(kw1)}, q4 = (f32x4){bflo(qw0), bfhi(qw0), bflo(qw1), bfhi(qw1)};
          f32x4 kip;
#pragma unroll
          for (int e = 0; e < 4; ++e) kip[e] = fdiv(k4[e], pc[e]);
          const f32x4 qg = q4 * pc;
          const int off = (j * LD + k0) * 2;
          lds_store_bf16x4(QRm + off, qg * ip31); lds_store_bf16x4(KRm + off, kip * p31); lds_store_bf16x4(QGm + off, qg); lds_store_bf16x4(KEm + off, kip * p63); }
      }
      blk_sync();
      const int TI = wid & 3, TJ = wid >> 2;
      if (lat && TI <= ((2 * TJ + 1) | 1)) {
        f32x4 at[2] = {(f32x4){0.f, 0.f, 0.f, 0.f}, (f32x4){0.f, 0.f, 0.f, 0.f}};
        { bf16x8 af[4], b0[4], b1[4];
#pragma unroll
          for (int q = 0; q < 4; ++q) { af[q] = frag_row(KRm, LD, 16 * TI, 32 * q, lane); b0[q] = frag_row(QRm, LD, 16 * (2 * TJ), 32 * q, lane); b1[q] = frag_row(QRm, LD, 16 * (2 * TJ + 1), 32 * q, lane); }
          PIN12(af[0], af[1], af[2], af[3], b0[0], b0[1], b0[2], b0[3], b1[0], b1[1], b1[2], b1[3]);
#pragma unroll
          for (int q = 0; q < 4; ++q) { at[0] = mfma16(af[q], b0[q], at[0]); at[1] = mfma16(af[q], b1[q], at[1]); } }
#pragma unroll
        for (int j = 0; j < 2; ++j) { const int s = 16 * TI + 4 * fq, l = 16 * (2 * TJ + j) + fr; f32x4 m;
#pragma unroll
          for (int e = 0; e < 4; ++e) m[e] = (s + e <= l) ? at[j][e] : 0.f;
          lds_store_bf16x4(ATm + (l * LDV + s) * 2, m); }
      }
      const int KI = wid & 3, VJ = wid >> 2;
      f32x4 SN[2][2];
#pragma unroll
      for (int i = 0; i < 2; ++i) { const f32x4 dec = *(const LAS f32x4*)(Gm + 63 * 128 + 16 * (2 * KI + i) + 4 * fq);
#pragma unroll
        for (int j = 0; j < 2; ++j) SN[i][j] = ST[i][j] * dec; }
      { bf16x8 af[2][2], bfm[2][2];
#pragma unroll
        for (int q = 0; q < 2; ++q)
#pragma unroll
          for (int i = 0; i < 2; ++i) { af[q][i] = frag_tr(KEm, LD, 16 * (2 * KI + i), 32 * q, lane); bfm[q][i] = frag_tr(Vm, LDV, 16 * (2 * VJ + i), 32 * q, lane); }
        PIN8(af[0][0], af[0][1], af[1][0], af[1][1], bfm[0][0], bfm[0][1], bfm[1][0], bfm[1][1]);
#pragma unroll
        for (int q = 0; q < 2; ++q)
#pragma unroll
          for (int i = 0; i < 2; ++i)
#pragma unroll
            for (int j = 0; j < 2; ++j) SN[i][j] = mfma16(af[q][i], bfm[q][j], SN[i][j]); }
#pragma unroll
      for (int i = 0; i < 2; ++i)
#pragma unroll
        for (int j = 0; j < 2; ++j) ST[i][j] = SN[i][j];
      blk_sync();
      if (lat) { const int VI = wid & 3; f32x4 o[2] = {(f32x4){0.f, 0.f, 0.f, 0.f}, (f32x4){0.f, 0.f, 0.f, 0.f}};
        for (int q = 0; q <= TJ; ++q) { const bf16x8 af = frag_tr(Vm, LDV, 16 * VI, 32 * q, lane);
#pragma unroll
          for (int j = 0; j < 2; ++j) o[j] = mfma16(af, frag_row(ATm, LDV, 16 * (2 * TJ + j), 32 * q, lane), o[j]); }
        { bf16x8 af[4], b0[4], b1[4];
#pragma unroll
          for (int q = 0; q < 4; ++q) { af[q] = frag_row(Sb, LD, 16 * VI, 32 * q, lane); b0[q] = frag_row(QGm, LD, 16 * (2 * TJ), 32 * q, lane); b1[q] = frag_row(QGm, LD, 16 * (2 * TJ + 1), 32 * q, lane); }
          PIN12(af[0], af[1], af[2], af[3], b0[0], b0[1], b0[2], b0[3], b1[0], b1[1], b1[2], b1[3]);
#pragma unroll
          for (int q = 0; q < 4; ++q) { o[0] = mfma16(af[q], b0[q], o[0]); o[1] = mfma16(af[q], b1[q], o[1]); } }
#pragma unroll
        for (int j = 0; j < 2; ++j) { const int l = 16 * (2 * TJ + j) + fr; u32x2 w; w.x = pk2(o[j][0], o[j][1]); w.y = pk2(o[j][2], o[j][3]);
          *(u32x2*)(Od + (size_t)hg_row(b, d, c * 64 + l) * 1024 + h * 128 + vh * 64 + 16 * VI + 4 * fq) = w; }
      }
      blk_sync();
#pragma unroll
      for (int i = 0; i < 2; ++i)
#pragma unroll
        for (int j = 0; j < 2; ++j) lds_store_bf16x4(Sb + ((16 * (2 * VJ + j) + fr) * LD + 16 * (2 * KI + i) + 4 * fq) * 2, ST[i][j]);
    }
  }
}


constexpr int MODL_SC = 0, MODL_PART = (NB + 1) * DM * 4;
static_assert(MODL_PART + 32 * (NB + 1) * 48 * 4 <= LDS_BYTES, "mod LDS map");
DEV void ph_mod2(const P& p, LAS unsigned char* lds, int bid, int G) {
  const int t = tidx();
  LAS float* SC = (LAS float*)(lds + MODL_SC); LAS float* PART = (LAS float*)(lds + MODL_PART);
  if (bid == 0 && t < 64) ((int*)(p.ws + WS_CTL))[t] = 0;
  if (bid == 0) for (int i = t; i < 1024; i += NT) ((float*)(p.ws + WS_LB))[i] = fdiv(1.f, 1.f + fexp(p.in[I_HGLB][i] - p.in[I_HGLB][1024 + i]));
  for (int i = t; i < (NB + 1) * DM; i += NT) { const int r = i / DM, k = i % DM; SC[i] = siluf_(r < NB ? p.in[I_C][r * DM + k] : p.in[I_CCTX][k]); }
  blk_sync();
  for (int cg = bid; cg < 2 * 6144 / 48; cg += G) {
    const int l = cg / 128, col0 = (cg % 128) * 48;
    if (t < 384) { const int c4 = t % 12, ks = t / 12; const float* W = p.in[I_MODW] + (size_t)l * DM * 6144 + col0 + 4 * c4;
      f32x4 acc[NB + 1];
#pragma unroll
      for (int r = 0; r <= NB; ++r) acc[r] = (f32x4){0.f, 0.f, 0.f, 0.f};
#pragma unroll
      for (int k8 = 0; k8 < 32; k8 += 16) { f32x4 w[16];
#pragma unroll
        for (int kk = 0; kk < 16; ++kk) w[kk] = *(const f32x4*)(W + (size_t)(ks * 32 + k8 + kk) * 6144);
#pragma unroll
        for (int kk = 0; kk < 16; ++kk) { const int k = ks * 32 + k8 + kk;
#pragma unroll
          for (int r = 0; r <= NB; ++r) acc[r] += w[kk] * SC[r * DM + k]; } }
#pragma unroll
      for (int r = 0; r <= NB; ++r) *(LAS f32x4*)(PART + (ks * (NB + 1) + r) * 48 + 4 * c4) = acc[r];
    }
    blk_sync();
    if (t < (NB + 1) * 48) { const int r = t / 48, c = t % 48; float s = 0.f;
#pragma unroll 8
      for (int ks = 0; ks < 32; ++ks) s += PART[(ks * (NB + 1) + r) * 48 + c];
      ((float*)(p.ws + WS_MODV))[(size_t)(l * (NB + 1) + r) * 6144 + col0 + c] = s + p.in[I_MODB][l * 6144 + col0 + c]; }
    blk_sync();
  }
}

constexpr int CVT_LDT = 72;
template <class Src> DEV void cvt_tiles(LAS unsigned char* lds, bf16_t* Bt, int N, int K, int ldw, const Src& src, int first, int step) {
  const int t = tidx(), lane = t & 63, wid = t >> 6; const int ntn = N / 64, ntk = K / 256;
  for (int tile = first; tile < ntn * ntk; tile += step) {
    const int n0 = (tile % ntn) * 64, k0 = (tile / ntn) * 256;
    f32x4 v[8];
#pragma unroll
    for (int i = 0; i < 8; ++i) { const int kk = (t >> 4) + 32 * i, n4 = (t & 15) * 4; const float* s = src(n0 + n4);
      v[i] = (f32x4){0.f, 0.f, 0.f, 0.f}; if (s) v[i] = *(const f32x4*)(s + (size_t)(k0 + kk) * ldw); }
#pragma unroll
    for (int i = 0; i < 8; ++i) { const int kk = (t >> 4) + 32 * i, n4 = (t & 15) * 4; u32x2 o; o.x = pk2(v[i][0], v[i][1]); o.y = pk2(v[i][2], v[i][3]); *(LAS u32x2*)(lds + (kk * CVT_LDT + n4) * 2) = o; }
    blk_sync();
#pragma unroll
    for (int g = 0; g < 4; ++g) { const bf16x8 f = frag_tr(lds, CVT_LDT, 16 * g, 32 * wid, lane);
      *(bf16x8*)(Bt + (size_t)(n0 + 16 * g + (lane & 15)) * K + k0 + 32 * wid + 8 * (lane >> 4)) = f; }
    blk_sync();
  }
}
DEV void ph_convert_dense2(const P& p, LAS unsigned char* lds, int bid, int G) {
  cvt_tiles(lds, (bf16_t*)(p.ws + WS_WIN0), N0P, 1024, AB_IN, SrcWin0{p.in[I_ABIN]}, bid, G);
  cvt_tiles(lds, (bf16_t*)(p.ws + WS_WOUT0), 1024, 2048, 1024, SrcId{p.in[I_ABOUT]}, bid, G);
  cvt_tiles(lds, (bf16_t*)(p.ws + WS_WHGI), 5120, 1024, HG_IN, SrcId{p.in[I_HGIN]}, bid, G);
  cvt_tiles(lds, (bf16_t*)(p.ws + WS_WHGO), 1024, 1024, 1024, SrcId{p.in[I_HGOUT]}, bid, G);
}
DEV void ph_convert_moe2(const P& p, int l, LAS unsigned char* lds, int rank, int nconv) {
  if (rank < 0) return;
  for (int e = 0; e < NE; ++e) { const size_t eo = (size_t)(l * NE + e); const int first = (rank + nconv - (e * 16) % nconv) % nconv;
    cvt_tiles(lds, (bf16_t*)(p.ws + WS_WGU) + (size_t)e * 1024 * 1024, 1024, 1024, DE, SrcGU{p.in[I_WG] + eo * DM * DE, p.in[I_WU] + eo * DM * DE}, first, nconv);
    cvt_tiles(lds, (bf16_t*)(p.ws + WS_WDT) + (size_t)e * 1024 * 512, 1024, 512, DM, SrcId{p.in[I_WD] + eo * DE * DM}, (first + 64) % nconv, nconv); }
}

template <int LWX> DEV float wsumT(float v) { if constexpr (LWX == 1) return v; else return bwsum(v); }
DEV float reduce16_scatter(const float (&v)[16], int lane) {
  float a[8], b[4], c[2];
  { const bool hi = (lane & 32) != 0;
#pragma unroll
    for (int j = 0; j < 8; ++j) { const float mine = hi ? v[8 + j] : v[j], other = hi ? v[j] : v[8 + j]; a[j] = mine + wshfl(other, lane ^ 32); } }
  { const bool hi = (lane & 16) != 0;
#pragma unroll
    for (int j = 0; j < 4; ++j) { const float mine = hi ? a[4 + j] : a[j], other = hi ? a[j] : a[4 + j]; b[j] = mine + wshfl(other, lane ^ 16); } }
  { const bool hi = (lane & 8) != 0;
#pragma unroll
    for (int j = 0; j < 2; ++j) { const float mine = hi ? b[2 + j] : b[j], other = hi ? b[j] : b[2 + j]; c[j] = mine + wshfl(other, lane ^ 8); } }
  float d;
  { const bool hi = (lane & 4) != 0; const float mine = hi ? c[1] : c[0], other = hi ? c[0] : c[1]; d = mine + wshfl(other, lane ^ 4); }
  d += wshfl(d, lane ^ 2); d += wshfl(d, lane ^ 1);
  return d;
}
constexpr int RT_OFF_RW = 0, RT_OFF_LG = 16 * 1024 * 4, RT_OFF_LE = RT_OFF_LG + 8 * 2 * 16 * 4;
template <int LWX> DEV void norm_tokens(const P& p, int l, int mb, bool from_input, int comb, bool route, int r_begin, int r_end, int wave, int nwaves, int lane, LAS unsigned char* lds) {
  constexpr int NV = DM / 4 / LWX;
  bf16_t* H = (bf16_t*)(p.ws + WS_H);
  const float* g = p.in[mb == 0 ? I_NMIXG : I_NFFNG] + l * DM;
  const bf16_t* YS = (const bf16_t*)(p.ws + WS_YS);
  f32x4 pa[NV], pb[NV], pg5[NV]; int cur_mr = -1;
  for (long r0 = r_begin + 2 * wave; r0 < r_end; r0 += 2 * nwaves) {
    f32x4 xv[2][NV]; float ss[2];
#pragma unroll
    for (int q = 0; q < 2; ++q) { const long r = r0 + q; const int mr = tok_modrow((int)r); float* xc = xcur_row(p, (int)r); const float* x = from_input ? xin_row(p, (int)r) : xc;
      if (mr != cur_mr) { cur_mr = mr; const float* sh = modv(p, l, mr, mb), *sc = modv(p, l, mr, mb + 1);
#pragma unroll
        for (int i = 0; i < NV; ++i) { const int k = 4 * (lane + LWX * i); pa[i] = *(const f32x4*)(g + k) * (*(const f32x4*)(sc + k) + 1.f); pb[i] = *(const f32x4*)(sh + k); pg5[i] = comb >= 0 ? *(const f32x4*)(modv(p, comb, mr, 5) + k) : (f32x4){0.f, 0.f, 0.f, 0.f}; } }
      ss[q] = 0.f;
#pragma unroll
      for (int i = 0; i < NV; ++i) { const int k = 4 * (lane + LWX * i); f32x4 v = *(const f32x4*)(x + k);
        if (comb >= 0) { const u32x2 a = *(const u32x2*)(YS + (size_t)(2 * r) * DM + k), b = *(const u32x2*)(YS + (size_t)(2 * r + 1) * DM + k);
          v += pg5[i] * ((f32x4){bflo(a.x), bfhi(a.x), bflo(a.y), bfhi(a.y)} + (f32x4){bflo(b.x), bfhi(b.x), bflo(b.y), bfhi(b.y)}); }
        xv[q][i] = v; ss[q] += v[0] * v[0] + v[1] * v[1] + v[2] * v[2] + v[3] * v[3]; } }
    if (comb >= 0) {
#pragma unroll
      for (int q = 0; q < 2; ++q) { float* xc = xcur_row(p, (int)(r0 + q));
#pragma unroll
        for (int i = 0; i < NV; ++i) *(f32x4*)(xc + 4 * (lane + LWX * i)) = xv[q][i]; } }
#pragma unroll
    for (int q = 0; q < 2; ++q) { const long r = r0 + q;
      const float rstd = frsqrt(wsumT<LWX>(ss[q]) / DM + EPS);
#pragma unroll
      for (int i = 0; i < NV; ++i) { const int k = 4 * (lane + LWX * i);
        const f32x4 h = xv[q][i] * rstd * pa[i] + pb[i];
        u32x2 o; o.x = pk2(h[0], h[1]); o.y = pk2(h[2], h[3]); *(u32x2*)(H + (size_t)r * DM + k) = o; xv[q][i] = h; } }
    if constexpr (LWX == 64) if (route) {
      float lg[2][NE];
#pragma unroll
      for (int e = 0; e < NE; ++e) { lg[0][e] = 0.f; lg[1][e] = 0.f; }
      const LAS float* RWt = (const LAS float*)(lds + RT_OFF_RW);
#pragma unroll
      for (int i = 0; i < NV; ++i) { int k = 4 * (lane + LWX * i);
#pragma unroll
        for (int e = 0; e < NE; ++e) {
          const f32x4 w = *(const LAS f32x4*)(RWt + e * DM + k); const f32x4 a = xv[0][i] * w, b = xv[1][i] * w;
          lg[0][e] += (a[0] + a[1]) + (a[2] + a[3]); lg[1][e] += (b[0] + b[1]) + (b[2] + b[3]);
          if ((e & 3) == 3) OPAQUE_ACC8(k, lg[0][e - 3], lg[0][e - 2], lg[0][e - 1], lg[0][e], lg[1][e - 3], lg[1][e - 2], lg[1][e - 1], lg[1][e]); } }
      LAS float* LG = (LAS float*)(lds + RT_OFF_LG) + wave * 32;
#pragma unroll
      for (int q = 0; q < 2; ++q) { const float tot = reduce16_scatter(lg[q], lane); if ((lane & 3) == 0) LG[q * 16 + (lane >> 2)] = tot; }
      wave_sync();
      if (lane < 2) { const int q = lane; const long r = r0 + q; float s[NE], sel[NE];
#pragma unroll
        for (int e4 = 0; e4 < 4; ++e4) { const f32x4 v = *(const LAS f32x4*)(LG + q * 16 + 4 * e4);
#pragma unroll
          for (int j = 0; j < 4; ++j) { s[4 * e4 + j] = sigmoidf_(v[j]); sel[4 * e4 + j] = s[4 * e4 + j] + p.in[I_RB][4 * e4 + j]; } }
        int bg = 0; float bgs = -1e30f;
#pragma unroll
        for (int gq = 0; gq < 4; ++gq) {
          float m1 = -1e30f, m2 = -1e30f;
#pragma unroll
          for (int i = 0; i < 4; ++i) { const float v = sel[gq * 4 + i]; if (v > m1) { m2 = m1; m1 = v; } else if (v > m2) m2 = v; }
          const float gs = m1 + m2;
          if (gs > bgs) { bgs = gs; bg = gq; }
        }
        int i1 = 0, i2 = 0; float v1 = -1e30f, v2 = -1e30f; float s1 = 0.f, s2 = 0.f;
#pragma unroll
        for (int gq = 0; gq < 4; ++gq) if (gq == bg) {
#pragma unroll
          for (int i = 0; i < 4; ++i) { const float v = sel[gq * 4 + i]; if (v > v1) { v1 = v; i1 = i; s1 = s[gq * 4 + i]; } }
#pragma unroll
          for (int i = 0; i < 4; ++i) { const float v = sel[gq * 4 + i]; if (i != i1 && v > v2) { v2 = v; i2 = i; s2 = s[gq * 4 + i]; } }
        }
        int* EI = (int*)(p.ws + WS_EIDX); float* EW = (float*)(p.ws + WS_EW); LAS int* LE = (LAS int*)(lds + RT_OFF_LE);
        const int e1 = bg * 4 + i1, e2 = bg * 4 + i2;
        EI[r * 2] = e1; EI[r * 2 + 1] = e2;
        const float inv = fdiv(1.f, s1 + s2);
        EW[r * 2] = s1 * inv; EW[r * 2 + 1] = s2 * inv;
        LE[2 * (r - r_begin)] = e1; LE[2 * (r - r_begin) + 1] = e2; LAS float* LWt = (LAS float*)(LE + 256); LWt[2 * (r - r_begin)] = s1 * inv; LWt[2 * (r - r_begin) + 1] = s2 * inv;
      }
      wave_sync();
    }
  }
}
HD void ph_norm2(const P& p, int l, int mb, bool from_input, int ntok, int comb, long tid, long nth) {
  const int nblk = (int)(nth / NT), blk = (int)(tid / NT), wpb = NT / LW, tpb = ((ntok + nblk - 1) / nblk + 1) & ~1, rb = blk * tpb, re = rb + tpb < ntok ? rb + tpb : ntok;
  if (rb < re) norm_tokens<LW>(p, l, mb, from_input, comb, false, rb, re, (int)((tid % NT) / LW), wpb, LANE, nullptr);
}
DEV void ph_norm_route(const P& p, int l, int ntok, LAS unsigned char* lds, int bid, int G) {
  const int t = tidx(); LAS int* LE = (LAS int*)(lds + RT_OFF_LE);
  const int tpb = ((ntok + G - 1) / G + 1) & ~1, rb = bid * tpb, re = rb + tpb < ntok ? rb + tpb : ntok;
  { LAS float* RWt = (LAS float*)(lds + RT_OFF_RW); f32x4 rw[2][4];
#pragma unroll
    for (int i = 0; i < 2; ++i)
#pragma unroll
      for (int q = 0; q < 4; ++q) rw[i][q] = *(const f32x4*)(p.in[I_RW] + (size_t)(t + NT * i) * NE + 4 * q);
#pragma unroll
    for (int i = 0; i < 2; ++i)
#pragma unroll
      for (int q = 0; q < 4; ++q)
#pragma unroll
        for (int e = 0; e < 4; ++e) RWt[(4 * q + e) * DM + t + NT * i] = rw[i][q][e]; }
  blk_sync();
  if (rb < re) norm_tokens<64>(p, l, 3, false, -1, true, rb, re, t >> 6, NT / 64, t & 63, lds);
  blk_sync();
  { LAS int* WC = (LAS int*)(lds + RT_OFF_LG);
    const LAS float* LWt = (const LAS float*)(LE + 256); const int ns = 2 * (re - rb), wv = t >> 6, ln = t & 63;
    const int e = (rb < re && t < ns) ? LE[t] : -1; int rank = 0;
#pragma unroll
    for (int q = 0; q < NE; ++q) { const unsigned long long m = wballot(e == q); if (e == q) rank = __builtin_popcountll(m & ((1ull << ln) - 1ull)); if (ln == 0) WC[wv * NE + q] = __builtin_popcountll(m); }
    blk_sync();
    if (t < NE) { int tot = 0;
#pragma unroll
      for (int w = 0; w < NT / 64; ++w) tot += WC[w * NE + t];
      WC[128 + t] = tot > 0 ? atomicAdd((int*)(p.ws + WS_CTL) + l * NE + t, tot) : 0; }
    blk_sync();
    if (e >= 0) { int pos = WC[128 + e] + rank; for (int w = 0; w < wv; ++w) pos += WC[w * NE + e];
      ((int*)(p.ws + WS_RSLOT))[(size_t)e * MOE_CAP + pos] = 2 * rb + t; ((float*)(p.ws + WS_RW))[(size_t)e * MOE_CAP + pos] = LWt[t]; } }
  blk_sync();
}

HD void ph_conv5b(const P& p, long tid, long nth) {
  const bf16_t* XR = (const bf16_t*)(p.ws + WS_XR); bf16_t* XBC = (bf16_t*)(p.ws + WS_XBC);
  for (long it = tid; it < (long)(TT / 8) * 256; it += nth) {
    const int c = (int)(it & 255) * 8, r0 = (int)(it >> 8) * 8;
    int t0, L; tok_pos(r0, t0, L);
    u32x4 win[12];
#pragma unroll
    for (int k = 0; k < 12; ++k) { const int tt = t0 + k - 2; const bool ok = tt >= 0 && tt < L; const int tc = tt < 0 ? 0 : (tt >= L ? L - 1 : tt);
      u32x4 v = *(const u32x4*)(XR + (size_t)(r0 - t0 + tc) * 2048 + c); v.x = ok ? v.x : 0u; v.y = ok ? v.y : 0u; v.z = ok ? v.z : 0u; v.w = ok ? v.w : 0u; win[k] = v; }
    f32x4 w0[5], w1[5];
#pragma unroll
    for (int k = 0; k < 5; ++k) { w0[k] = *(const f32x4*)(p.in[I_SCW] + k * 2048 + c); w1[k] = *(const f32x4*)(p.in[I_SCW] + k * 2048 + c + 4); }
    const f32x4 b0 = *(const f32x4*)(p.in[I_SCB] + c), b1 = *(const f32x4*)(p.in[I_SCB] + c + 4);
#pragma unroll
    for (int j = 0; j < 8; ++j) {
      f32x4 a0 = b0, a1 = b1;
#pragma unroll
      for (int k = 0; k < 5; ++k) { a0 += bf4lo(win[j + k]) * w0[k]; a1 += bf4hi(win[j + k]) * w1[k]; }
      store_bf16x8(XBC + (size_t)(r0 + j) * 2048 + c, silu4(a0), silu4(a1));
    }
  }
}

constexpr int CF_TILES = TL / 64 + TC / 32;
DEV void ph_cf_fused(const P& p, LAS unsigned char* lds, int bid, int G) {
  const int t = tidx(), lane = t & 63, grp = t >> 6;
  const bf16_t* U = (const bf16_t*)(p.ws + WS_U); bf16_t* OC = (bf16_t*)(p.ws + WS_XR);
  for (int tile = bid; tile < CF_TILES; tile += G) {
    int row0, nout, wlo, whi;
    if (tile < TL / 64) { row0 = tile * 64; nout = 64; wlo = row0; whi = row0 + 64; }
    else { const int q = tile - TL / 64; row0 = TL + q * 32; nout = 32; const int seg0 = TL + (q * 32 / CTX) * CTX; wlo = row0 - 15 < seg0 ? seg0 : row0 - 15; whi = row0 + 32 + 15 > seg0 + CTX ? seg0 + CTX : row0 + 32 + 15; }
    const int nw = whi - wlo;
    { u32x4 xr[16];
#pragma unroll
      for (int i = 0; i < 16; ++i) { int v = (t + NT * i) & 4095; const int sl = i >> 3; v = v < nw * 64 ? v : nw * 64 - 1; xr[i] = *(const u32x4*)(U + (size_t)(wlo + (v >> 6)) * 1024 + sl * 512 + (v & 63) * 8); }
#pragma unroll
      for (int i = 0; i < 16; ++i) { const int v = (t + NT * i) & 4095, sl = i >> 3; if (v < nw * 64) *(LAS u32x4*)(lds + sl * 65536 + (v >> 6) * 1024 + (v & 63) * 16) = xr[i]; } }
    blk_sync();
#pragma unroll
    for (int sl = 0; sl < 2; ++sl) {
      const int ch = sl * 512 + t; LAS unsigned char* slab = lds + sl * 65536;
      unsigned WE[16], WO[16];
      { float w[32];
#pragma unroll
        for (int j = 0; j < 31; ++j) w[j] = p.in[I_CFW][j * 1024 + ch];
        w[31] = 0.f;
#pragma unroll
        for (int q = 0; q < 16; ++q) { WE[q] = pk2(q ? w[2 * q - 1] : 0.f, w[2 * q]); WO[q] = pk2(w[2 * q], w[2 * q + 1]); } }
      unsigned X[48];
#pragma unroll
      for (int w = 0; w < 48; ++w) { const int r0_ = row0 + 2 * w - 16, r1_ = r0_ + 1; const bool ok0 = r0_ >= wlo && r0_ < whi, ok1 = r1_ >= wlo && r1_ < whi;
        const int c0 = r0_ < wlo ? wlo : (r0_ >= whi ? whi - 1 : r0_), c1 = r1_ < wlo ? wlo : (r1_ >= whi ? whi - 1 : r1_);
        const unsigned lo = *(const LAS bf16_t*)(slab + (c0 - wlo) * 1024 + t * 2), hi = *(const LAS bf16_t*)(slab + (c1 - wlo) * 1024 + t * 2);
        X[w] = (ok0 ? lo : 0u) | ((ok1 ? hi : 0u) << 16); }
      blk_sync();
      const float cb = p.in[I_CFB][ch];
#pragma unroll
      for (int l = 0; l < 64; l += 2) {
        float ae = cb, ao = cb;
#pragma unroll
        for (int q = 0; q < 16; ++q) { ae = dot2bf(X[l / 2 + q], WE[q], ae); ao = dot2bf(X[l / 2 + 1 + q], WO[q], ao); }
        const unsigned pr = pk2(ae, ao);
        *(LAS bf16_t*)(slab + l * 1024 + t * 2) = (bf16_t)(pr & 0xffffu); *(LAS bf16_t*)(slab + (l + 1) * 1024 + t * 2) = (bf16_t)(pr >> 16);
      }
    }
    blk_sync();
    {
      for (int i0 = 0; i0 < nout / 8; i0 += 2) {
        f32x4 a[2][4], g4[4], b4[4]; float s[2], q[2]; int lc = lane * 8; OPAQUE_INT(lc);
#pragma unroll
        for (int k = 0; k < 4; ++k) { const int c = (k >> 1) * 512 + lc + (k & 1) * 4; g4[k] = *(const f32x4*)(p.in[I_CFLG] + c); b4[k] = *(const f32x4*)(p.in[I_CFLB] + c); }
#pragma unroll
        for (int u = 0; u < 2; ++u) { const int l = grp + 8 * (i0 + u);
          const u32x4 v0 = *(const LAS u32x4*)(lds + l * 1024 + lane * 16), v1 = *(const LAS u32x4*)(lds + 65536 + l * 1024 + lane * 16);
          a[u][0] = bf4lo(v0); a[u][1] = bf4hi(v0); a[u][2] = bf4lo(v1); a[u][3] = bf4hi(v1); s[u] = 0.f;
#pragma unroll
          for (int k = 0; k < 4; ++k) s[u] += (a[u][k][0] + a[u][k][1]) + (a[u][k][2] + a[u][k][3]); }
#pragma unroll
        for (int u = 0; u < 2; ++u) s[u] = bwsum(s[u]) * (1.f / 1024.f);
#pragma unroll
        for (int u = 0; u < 2; ++u) { q[u] = 0.f;
#pragma unroll
          for (int k = 0; k < 4; ++k) { a[u][k] -= s[u]; q[u] += (a[u][k][0] * a[u][k][0] + a[u][k][1] * a[u][k][1]) + (a[u][k][2] * a[u][k][2] + a[u][k][3] * a[u][k][3]); } }
#pragma unroll
        for (int u = 0; u < 2; ++u) q[u] = frsqrt(bwsum(q[u]) * (1.f / 1024.f) + EPS);
#pragma unroll
        for (int u = 0; u < 2; ++u) { const int l = grp + 8 * (i0 + u);
#pragma unroll
          for (int sl = 0; sl < 2; ++sl) store_bf16x8(OC + (size_t)(row0 + l) * 2048 + 1024 + sl * 512 + lane * 8, silu4(a[u][2 * sl] * q[u] * g4[2 * sl] + b4[2 * sl]), silu4(a[u][2 * sl + 1] * q[u] * g4[2 * sl + 1] + b4[2 * sl + 1])); }
      } }
    blk_sync();
  }
}

HD void ph_ssd_readout3(const P& p, long tid, long nth) {
  constexpr int NV = 1024 / 8 / LW;
  const bf16_t* Y0 = (const bf16_t*)(p.ws + WS_Y); const bf16_t* Y1 = Y0 + (size_t)TT * 1024; const bf16_t* Z = (const bf16_t*)(p.ws + WS_Z); bf16_t* OC = (bf16_t*)(p.ws + WS_XR);
  const int lane = LANE;
  f32x4 gn0[NV], gn1[NV];
#pragma unroll
  for (int i = 0; i < NV; ++i) { const int k = 8 * (lane + LW * i); gn0[i] = *(const f32x4*)(p.in[I_SSDG] + k); gn1[i] = *(const f32x4*)(p.in[I_SSDG] + k + 4); }
  for (long r = tid / LW; r < TT; r += nth / LW) {
    f32x4 v0[NV], v1[NV]; float ss = 0.f;
#pragma unroll
    for (int i = 0; i < NV; ++i) { const size_t o = (size_t)r * 1024 + 8 * (lane + LW * i); const u32x4 a = *(const u32x4*)(Y0 + o), b = *(const u32x4*)(Y1 + o), z = *(const u32x4*)(Z + o);
      v0[i] = (bf4lo(a) + bf4lo(b)) * silu4(bf4lo(z)); v1[i] = (bf4hi(a) + bf4hi(b)) * silu4(bf4hi(z));
      ss += (v0[i][0] * v0[i][0] + v0[i][1] * v0[i][1]) + (v0[i][2] * v0[i][2] + v0[i][3] * v0[i][3]) + (v1[i][0] * v1[i][0] + v1[i][1] * v1[i][1]) + (v1[i][2] * v1[i][2] + v1[i][3] * v1[i][3]); }
    const float rstd = frsqrt(wsum(ss) / 1024.f + EPS);
#pragma unroll
    for (int i = 0; i < NV; ++i) { const int k = 8 * (lane + LW * i); store_bf16x8(OC + (size_t)r * 2048 + k, v0[i] * rstd * gn0[i], v1[i] * rstd * gn1[i]); }
  }
}
HD void ph_hg_readout3(const P& p, long tid, long nth) {
  constexpr int GL = LW >= 16 ? 16 : 1;
  constexpr int NV = 16 / GL;
  const bf16_t* O0 = (const bf16_t*)(p.ws + WS_O); const bf16_t* O1 = O0 + (size_t)TL * 1024; const bf16_t* P1 = (const bf16_t*)(p.ws + WS_P1); bf16_t* RO = (bf16_t*)(p.ws + WS_H);
  const int sub = (int)(tid % GL);
  f32x4 hn0[NV], hn1[NV];
#pragma unroll
  for (int i = 0; i < NV; ++i) { const int vv = 8 * (sub + GL * i); hn0[i] = *(const f32x4*)(p.in[I_HGNG] + vv); hn1[i] = *(const f32x4*)(p.in[I_HGNG] + vv + 4); }
  for (long it = tid / GL; it < (long)TL * 8; it += nth / GL) {
    const size_t base = (size_t)(it >> 3) * 1024 + (it & 7) * 128;
    f32x4 v0[NV], v1[NV]; float ss = 0.f;
#pragma unroll
    for (int i = 0; i < NV; ++i) { const size_t o = base + 8 * (sub + GL * i); const u32x4 a = *(const u32x4*)(O0 + o), b = *(const u32x4*)(O1 + o);
      v0[i] = bf4lo(a) + bf4lo(b); v1[i] = bf4hi(a) + bf4hi(b);
      ss += (v0[i][0] * v0[i][0] + v0[i][1] * v0[i][1]) + (v0[i][2] * v0[i][2] + v0[i][3] * v0[i][3]) + (v1[i][0] * v1[i][0] + v1[i][1] * v1[i][1]) + (v1[i][2] * v1[i][2] + v1[i][3] * v1[i][3]); }
    ss = gsum16(ss);
    const float rstd = frsqrt(ss / 128.f + EPS);
#pragma unroll
    for (int i = 0; i < NV; ++i) { const int vv = 8 * (sub + GL * i); const u32x4 gt = *(const u32x4*)(P1 + (size_t)(it >> 3) * 5120 + 1024 + (it & 7) * 128 + vv);
      store_bf16x8(RO + base + vv, v0[i] * rstd * hn0[i] * silu4(bf4lo(gt)), v1[i] * rstd * hn1[i] * silu4(bf4hi(gt))); }
  }
}
HD void ph_final2(const P& p, long tid, long nth) {
  constexpr int NV = DM / 4 / LW;
  const bf16_t* YS = (const bf16_t*)(p.ws + WS_YS); const int lane = LANE;
  f32x4 fg[NV];
#pragma unroll
  for (int i = 0; i < NV; ++i) fg[i] = *(const f32x4*)(p.in[I_FNG] + 4 * (lane + LW * i));
  for (long r = tid / LW; r < TL; r += nth / LW) {
    float* x = p.out + (size_t)r * DM; const float* g5 = modv(p, 1, tok_modrow((int)r), 5); f32x4 xv[NV]; float ss = 0.f;
#pragma unroll
    for (int i = 0; i < NV; ++i) { const int k = 4 * (lane + LW * i); const u32x2 a = *(const u32x2*)(YS + (size_t)(2 * r) * DM + k), b = *(const u32x2*)(YS + (size_t)(2 * r + 1) * DM + k);
      const f32x4 v = *(const f32x4*)(x + k) + *(const f32x4*)(g5 + k) * ((f32x4){bflo(a.x), bfhi(a.x), bflo(a.y), bfhi(a.y)} + (f32x4){bflo(b.x), bfhi(b.x), bflo(b.y), bfhi(b.y)});
      xv[i] = v; ss += v[0] * v[0] + v[1] * v[1] + v[2] * v[2] + v[3] * v[3]; }
    const float rstd = frsqrt(wsum(ss) / DM + EPS);
#pragma unroll
    for (int i = 0; i < NV; ++i) { const int k = 4 * (lane + LW * i); *(f32x4*)(x + k) = xv[i] * rstd * fg[i]; }
  }
}

#define OUTPROJ0_CVT_N(G) (((TT / 256) * 4 > (G) && (TT / 256) * 4 < 2 * (G)) ? 2 * (G) - (TT / 256) * 4 : (G))
#define OUTPROJ0_CVT_RANK(bid, G) (((TT / 256) * 4 > (G) && (TT / 256) * 4 < 2 * (G)) ? (bid) - ((TT / 256) * 4 - (G)) : (bid))
#define PROGRAM(T, B, SYNC) \
  B(ph_mod2(p, LDSP, bid, G)) B(ph_convert_dense2(p, LDSP, bid, G)) SYNC \
  T(ph_norm2(p, 0, 0, true, TT, -1, tid, nth)) SYNC \
  B(ph_gemm_inproj0(p, lds, bid, G)) SYNC \
  T(ph_conv5b(p, tid, nth)) SYNC \
  B(ph_ssd_chunked(p, LDSP, bid, G)) B(ph_cf_fused(p, LDSP, bid, G)) SYNC \
  T(ph_ssd_readout3(p, tid, nth)) SYNC \
  B(ph_gemm_outproj0(p, lds, bid, G)) B(ph_convert_moe2(p, 0, LDSP, OUTPROJ0_CVT_RANK(bid, G), OUTPROJ0_CVT_N(G))) SYNC \
  B(ph_norm_route(p, 0, TT, LDSP, bid, G)) SYNC \
  B(ph_gemm_moe1(p, 0, lds, bid, G)) SYNC \
  B(ph_gemm_moe2(p, 0, lds, bid, G)) SYNC \
  T(ph_norm2(p, 1, 0, false, TT, 0, tid, nth)) SYNC \
  B(ph_gemm_inproj1(p, lds, bid, G)) SYNC \
  B(ph_hg_chunked(p, LDSP, bid, G)) SYNC \
  T(ph_hg_readout3(p, tid, nth)) SYNC \
  B(ph_gemm_outproj1(p, lds, bid, G)) SYNC \
  B(ph_norm_route(p, 1, TL, LDSP, bid, G)) B(ph_convert_moe2(p, 1, LDSP, bid, G)) SYNC \
  B(ph_gemm_moe1(p, 1, lds, bid, G)) SYNC \
  B(ph_gemm_moe2(p, 1, lds, bid, G)) SYNC \
  T(ph_final2(p, tid, nth))

#ifndef CPU_TEST
#define XB_TMO      128
#define XB_XCNT(j)  (256  + 64 * (j))
#define XB_XSUB(j)  (1280 + 64 * (j))
#define XB_XGEN(j)  (2304 + 64 * (j))
#define XB_TOP      3328
#define XB_TOPGEN   3392
#define XCD_BAR_WORDS 3456
#define XB_SPIN_CAP (1u << 18)

__device__ __forceinline__ unsigned xb_ld(unsigned* p)              { return __hip_atomic_load(p, __ATOMIC_RELAXED, __HIP_MEMORY_SCOPE_AGENT); }
__device__ __forceinline__ unsigned xb_add(unsigned* p, unsigned v) { return __hip_atomic_fetch_add(p, v, __ATOMIC_RELAXED, __HIP_MEMORY_SCOPE_AGENT); }
__device__ __forceinline__ unsigned xb_xcc_id() { return (unsigned)__builtin_amdgcn_s_getreg((3 << 11) | 20) & 0xFu; }
#define XB_SPIN(cond, bar) do { unsigned _sp = 0; while (cond) { __builtin_amdgcn_s_sleep(1); \
    if ((++_sp & 255u) == 0u) { if (xb_ld(&(bar)[XB_TMO])) break; if (_sp > XB_SPIN_CAP) { atomicAdd(&(bar)[XB_TMO], 1u); break; } } } } while (0)

struct XcdBarrier {
    unsigned* bar; unsigned x;
    volatile LAS unsigned* st;
};

__device__ __forceinline__ XcdBarrier xcd_barrier_post(unsigned* bar, volatile LAS unsigned* st) {
    XcdBarrier b; b.bar = bar; b.x = xb_xcc_id(); b.st = st;
    if (threadIdx.x == 0) (void)xb_add(&bar[XB_XCNT(b.x)], 1u);
    return b;
}
__device__ __forceinline__ void xcd_barrier_complete(unsigned* bar, unsigned x, unsigned& nloc, unsigned& nx) {
    const unsigned G = gridDim.x * gridDim.y * gridDim.z;
    unsigned sum, cnt, mine, sp = 0u;
    for (;;) {
        sum = 0u; cnt = 0u; mine = 0u;
#pragma unroll
        for (unsigned j = 0; j < 16; ++j) { const unsigned c = xb_ld(&bar[XB_XCNT(j)]); sum += c; cnt += (c > 0u) ? 1u : 0u; mine = (j == x) ? c : mine; }
        if (sum == G) break;
        __builtin_amdgcn_s_sleep(1);
        if ((++sp & 255u) == 0u) { if (xb_ld(&bar[XB_TMO])) break; if (sp > XB_SPIN_CAP) { atomicAdd(&bar[XB_TMO], 1u); break; } }
    }
    nloc = mine > 0u ? mine : 1u; nx = cnt > 0u ? cnt : 1u;
}

__device__ __forceinline__ void xcd_barrier(const XcdBarrier& b) {
    asm volatile("s_waitcnt vmcnt(0)" ::: "memory");
    __syncthreads();
    if (threadIdx.x == 0) {
        unsigned* bar = b.bar;
        __builtin_amdgcn_s_waitcnt(0);
        unsigned nloc = b.st[0], nx = b.st[1];
        if (nloc == 0u) { xcd_barrier_complete(bar, b.x, nloc, nx); b.st[0] = nloc; b.st[1] = nx; }
        const unsigned old = xb_add(&bar[XB_XSUB(b.x)], 1u);
        const unsigned gen = old / nloc;
        if (old + 1u == (gen + 1u) * nloc) {
            __builtin_amdgcn_fence(__ATOMIC_RELEASE, "agent");
            asm volatile("s_waitcnt vmcnt(0)" ::: "memory");
            const unsigned og = xb_add(&bar[XB_TOP], 1u);
            const unsigned tg = og / nx;
            if (og + 1u == (tg + 1u) * nx) xb_add(&bar[XB_TOPGEN], 1u);
            else XB_SPIN(xb_ld(&bar[XB_TOPGEN]) == tg, bar);
            __builtin_amdgcn_fence(__ATOMIC_ACQUIRE, "agent");
            xb_add(&bar[XB_XGEN(b.x)], 1u);
            asm volatile("s_waitcnt vmcnt(0)" ::: "memory");
        } else {
            XB_SPIN(xb_ld(&bar[XB_XGEN(b.x)]) == gen, bar);
            __builtin_amdgcn_fence(__ATOMIC_ACQUIRE, "agent");
            asm volatile("s_waitcnt vmcnt(0)" ::: "memory");
        }
    }
    __syncthreads();
}

#endif

#ifndef CPU_TEST
__global__ void __launch_bounds__(NT) mega(P p) {
  extern __shared__ __attribute__((aligned(16))) unsigned char lds[];
  const long nth = (long)gridDim.x * NT;
  const int bid = blockIdx.x, G = gridDim.x;
#define LDSP ((LAS unsigned char*)lds)
#define T_(stmt_) { const long tid = (long)blockIdx.x * NT + tidx(); stmt_; }
#define B_(stmt_) stmt_;
  volatile LAS unsigned* xb_st = (volatile LAS unsigned*)(LDSP + LDS_BYTES - 64);
  if (threadIdx.x < 2) xb_st[threadIdx.x] = 0u;
  __syncthreads();
  const XcdBarrier xbar = xcd_barrier_post((unsigned*)(p.ws + WS_BAR), xb_st);
#define S_ xcd_barrier(xbar);
  PROGRAM(T_, B_, S_)
}

extern "C" void kernel_launch(void* const* d_in, const int* in_sizes, int n_in, void* d_out, int out_size,
                              void* d_ws, size_t ws_size, hipStream_t stream) {
  static int grid_blocks = 0;
  if (!grid_blocks) {
    int dev = 0, cus = 0, per_cu = 0;
    (void)hipGetDevice(&dev);
    (void)hipDeviceGetAttribute(&cus, hipDeviceAttributeMultiprocessorCount, dev);
    (void)hipFuncSetAttribute((const void*)mega, hipFuncAttributeMaxDynamicSharedMemorySize, LDS_BYTES);
    (void)hipOccupancyMaxActiveBlocksPerMultiprocessor(&per_cu, (const void*)mega, NT, LDS_BYTES);
    if (per_cu < 1) per_cu = 1;
    grid_blocks = cus * per_cu;
    if (n_in != N_IN || out_size != TL * DM || ws_size < WS_NEED) { fprintf(stderr, "kernel_launch: bad sizes n_in=%d out=%d ws=%zu need=%zu\n", n_in, out_size, ws_size, (size_t)WS_NEED); grid_blocks = -1; }
  }
  if (grid_blocks < 0) return;
  P p{};
  for (int i = 0; i < N_IN; ++i) p.in[i] = (const float*)d_in[i];
  p.out = (float*)d_out; p.ws = (unsigned char*)d_ws;
  (void)hipMemsetAsync((unsigned char*)d_ws + WS_BAR, 0, (size_t)XCD_BAR_WORDS * 4, stream);
  void* args[] = {&p};
  hipError_t e = hipLaunchCooperativeKernel((const void*)mega, dim3(grid_blocks), dim3(NT), args, LDS_BYTES, stream);
  if (e != hipSuccess) fprintf(stderr, "cooperative launch failed: %s (grid %d)\n", hipGetErrorString(e), grid_blocks);
}
#endif
```

```cpp
#ifndef CPU_TEST
#include <hip/hip_runtime.h>
#include <hip/hip_cooperative_groups.h>
namespace cg = cooperative_groups;
#define HD __host__ __device__ __forceinline__
#define DEV __device__ __forceinline__
#else
#define HD inline
#define DEV inline
#endif
#include <cstdio>
#include <cstdint>
#include <cmath>

#ifndef CFG_B
#define CFG_B 8
#define CFG_SEQ 2048
#define CFG_CTX 256
#endif
constexpr int NB = CFG_B, SEQ = CFG_SEQ, CTX = CFG_CTX, DM = 1024, GW = 64, ROWS = SEQ / GW;
constexpr int TL = NB * SEQ, TC = NB * CTX, TT = TL + TC;
constexpr int AB_IN = 5152, HG_IN = 5120, NE = 16, DE = 512;
constexpr float EPS = 1e-6f;
constexpr int NT = 512;
constexpr int LDS_BYTES = 147456;
static_assert(SEQ % 256 == 0 && CTX % 256 == 0, "token tiles of 256 must not straddle sequences");

typedef unsigned short bf16_t;
typedef float f32x4 __attribute__((ext_vector_type(4)));
typedef unsigned u32x4 __attribute__((ext_vector_type(4)));
typedef unsigned u32x2 __attribute__((ext_vector_type(2)));
HD float bf2f(bf16_t h) { unsigned u = (unsigned)h << 16; return __builtin_bit_cast(float, u); }
HD unsigned f2bfu(float f) { unsigned u = __builtin_bit_cast(unsigned, f); return (u + 0x7fffu + ((u >> 16) & 1u)) >> 16; }
HD bf16_t f2bf(float f) { return (bf16_t)f2bfu(f); }
#if defined(__HIP_DEVICE_COMPILE__)
typedef float f32x2_t __attribute__((ext_vector_type(2)));
typedef __bf16 bf16x2_t __attribute__((ext_vector_type(2)));
DEV unsigned pk2(float lo, float hi) { return __builtin_bit_cast(unsigned, __builtin_convertvector((f32x2_t){lo, hi}, bf16x2_t)); }
#else
HD unsigned pk2(float lo, float hi) { return f2bfu(lo) | (f2bfu(hi) << 16); }
#endif
HD unsigned f2e4m3_sw(float x) { const unsigned s = x < 0.f ? 0x80u : 0u; float a = fabsf(x); if (!(a < 448.f)) a = 448.f; if (a < 0.0009765625f) return s;
  int e; (void)frexpf(a, &e); e -= 1; if (e < -6) e = -6; const float step = ldexpf(1.f, e - 3); float q = rintf(a / step); if (q >= 16.f) { q = 8.f; e += 1; }
  if (e == -6 && q < 8.f) return s | (unsigned)q; return s | ((unsigned)(e + 7) << 3) | ((unsigned)q - 8u); }
HD float e4m32f(unsigned b) { const unsigned e = (b >> 3) & 15u, m = b & 7u; const float v = e ? (1.f + m * 0.125f) * ldexpf(1.f, (int)e - 7) : m * 0.001953125f; return (b & 0x80u) ? -v : v; }
#if defined(__HIP_DEVICE_COMPILE__)
DEV unsigned pk4_fp8(float a, float b, float c, float d) { const unsigned p = __builtin_amdgcn_cvt_pk_fp8_f32(__builtin_amdgcn_fmed3f(a, -448.f, 448.f), __builtin_amdgcn_fmed3f(b, -448.f, 448.f), 0, false);
  return __builtin_amdgcn_cvt_pk_fp8_f32(__builtin_amdgcn_fmed3f(c, -448.f, 448.f), __builtin_amdgcn_fmed3f(d, -448.f, 448.f), p, true); }
#else
HD unsigned pk4_fp8(float a, float b, float c, float d) { return f2e4m3_sw(a) | (f2e4m3_sw(b) << 8) | (f2e4m3_sw(c) << 16) | (f2e4m3_sw(d) << 24); }
#endif
constexpr int IN1_F8 = 12;
constexpr bool FP8_OUT0 = true, FP8_OUT1 = true;
HD void store_fp8x8(unsigned char* dst, f32x4 a, f32x4 b) { u32x2 w; w.x = pk4_fp8(a[0], a[1], a[2], a[3]); w.y = pk4_fp8(b[0], b[1], b[2], b[3]); *(u32x2*)dst = w; }
HD float bflo(unsigned w) { return __builtin_bit_cast(float, w << 16); }
HD float bfhi(unsigned w) { return __builtin_bit_cast(float, w & 0xffff0000u); }
HD f32x4 bf4lo(u32x4 v) { return (f32x4){bflo(v.x), bfhi(v.x), bflo(v.y), bfhi(v.y)}; }
HD f32x4 bf4hi(u32x4 v) { return (f32x4){bflo(v.z), bfhi(v.z), bflo(v.w), bfhi(v.w)}; }
HD void store_bf16x8(bf16_t* dst, f32x4 a, f32x4 b) { u32x4 w; w.x = pk2(a[0], a[1]); w.y = pk2(a[2], a[3]); w.z = pk2(b[0], b[1]); w.w = pk2(b[2], b[3]); *(u32x4*)dst = w; }
template <bool F8> HD void store_act8(bf16_t* base, size_t idx, f32x4 a, f32x4 b) { if constexpr (F8) store_fp8x8((unsigned char*)base + idx, a, b); else store_bf16x8(base + idx, a, b); }
#ifndef CPU_TEST
#define CHUNK_FENCE() asm volatile("" ::: "memory")
#define NT_LOAD4(p) __builtin_nontemporal_load((const f32x4*)(p))
#define NT_LOADU4(p) __builtin_nontemporal_load((const u32x4*)(p))
#define NT_LOADU2(p) __builtin_nontemporal_load((const u32x2*)(p))
#define NT_STORE4(p, v) __builtin_nontemporal_store((v), (f32x4*)(p))
#define OPAQUE_INT(v) asm volatile("" : "+v"(v))
#define OPAQUE_ACC8(k, a0, a1, a2, a3, a4, a5, a6, a7) asm volatile("" : "+v"(k), "+v"(a0), "+v"(a1), "+v"(a2), "+v"(a3), "+v"(a4), "+v"(a5), "+v"(a6), "+v"(a7))
constexpr int LW = 64;
DEV int tidx() { int t = threadIdx.x; asm volatile("" : "+v"(t)); return t; }
#define LANE (tidx() & 63)
DEV float wsum(float v) { for (int o = 32; o; o >>= 1) v += __shfl_xor(v, o); return v; }
DEV float gsum16(float v) { for (int o = 8; o; o >>= 1) v += __shfl_xor(v, o); return v; }
DEV int atomic_inc_int(int* p) { return atomicAdd(p, 1); }
#else
inline int tidx() { return emu_tid(); }
#define CHUNK_FENCE()
#define NT_LOAD4(p) (*(const f32x4*)(p))
#define NT_LOADU4(p) (*(const u32x4*)(p))
#define NT_LOADU2(p) (*(const u32x2*)(p))
#define NT_STORE4(p, v) (*(f32x4*)(p) = (v))
#define OPAQUE_INT(v)
#define OPAQUE_ACC8(k, a0, a1, a2, a3, a4, a5, a6, a7)
constexpr int LW = 1;
#define LANE 0
inline float wsum(float v) { return v; }
inline float gsum16(float v) { return v; }
inline int atomic_inc_int(int* p) { return __atomic_fetch_add(p, 1, __ATOMIC_RELAXED); }
inline int atomicAdd(int* p, int v) { return __atomic_fetch_add(p, v, __ATOMIC_RELAXED); }
#endif
#if defined(__HIP_DEVICE_COMPILE__)
DEV float fexp(float x) { return __expf(x); }
DEV float flog(float x) { return __logf(x); }
DEV float fdiv(float a, float b) { return a * __builtin_amdgcn_rcpf(b); }
DEV float frsqrt(float x) { return __builtin_amdgcn_rsqf(x); }
#else
HD float fexp(float x) { return expf(x); }
HD float flog(float x) { return logf(x); }
HD float fdiv(float a, float b) { return a / b; }
HD float frsqrt(float x) { return 1.f / sqrtf(x); }
#endif
HD float sigmoidf_(float x) { return fdiv(1.f, 1.f + fexp(-x)); }
HD float siluf_(float x) { return fdiv(x, 1.f + fexp(-x)); }
HD float softplusf_(float x) { return x > 20.f ? x : flog(1.f + fexp(x)); }

enum { I_X, I_C, I_CTX, I_CCTX, I_MODW, I_MODB, I_NMIXG, I_NFFNG, I_RW, I_RB, I_WG, I_WU, I_WD, I_ABIN, I_SCW, I_SCB, I_DTB, I_ALOG, I_SSDD, I_SSDG,
       I_CFW, I_CFB, I_CFLG, I_CFLB, I_ABOUT, I_HGIN, I_HGLB, I_HGNG, I_HGOUT, I_FNG, N_IN };

constexpr size_t al256(size_t x) { return (x + 255) & ~(size_t)255; }
constexpr int NROWS_MAX = 2 * TT + NE * 256;
constexpr int N0P = 5376;
constexpr size_t WS_CTL = 0;
constexpr size_t WS_BAR = 1024;
constexpr size_t WS_MOECNT = 1024 + 3456 * 4;
static_assert(NROWS_MAX / 256 <= 160 && WS_MOECNT + 2 * 160 * 4 <= 16384, "MoE hand-off counters");
constexpr size_t WS_LB = 16384;
constexpr size_t WS_MODV = 16384 + 4096;
constexpr size_t WS_DT = al256(WS_MODV + (size_t)2 * (NB + 1) * 6144 * 4);
constexpr size_t WS_EIDX = al256(WS_DT + (size_t)TT * 32 * 4);
constexpr size_t WS_EW = al256(WS_EIDX + (size_t)TT * 2 * 4);
constexpr size_t WS_EPOS = al256(WS_EW + (size_t)TT * 2 * 4);
constexpr int MOE_CAP = TT;
constexpr size_t WS_RSLOT = al256(WS_EPOS + (size_t)TT * 2 * 4);
constexpr size_t WS_RW = al256(WS_RSLOT + (size_t)NE * MOE_CAP * 4);
constexpr size_t WS_WIN0 = al256(WS_RW + (size_t)NE * MOE_CAP * 4);
constexpr size_t WS_WOUT0 = al256(WS_WIN0 + (size_t)N0P * 1024 * 2);
constexpr size_t WS_WHGI = al256(WS_WOUT0 + (size_t)1024 * 2048 * 2);
constexpr size_t WS_WHGO = al256(WS_WHGI + (size_t)5120 * 1024 * 2);
constexpr size_t WS_XB = al256(WS_WHGO + (size_t)1024 * 1024 * 2);
static_assert((size_t)TT * DM * 2 <= (size_t)TL * DM * 4, "the bf16 activation scratch H lives in d_out until the final phase");
static_assert(CFG_B != 8 || (size_t)TT * DM * 3 <= (size_t)TL * DM * 4, "the e4m3 copy of H (layer-1 in-proj) sits behind the bf16 rows in d_out");
constexpr size_t WS_R = al256(WS_XB + (size_t)TT * DM * 2);
constexpr size_t WS_Z = WS_R;
constexpr size_t WS_XR = al256(WS_Z + (size_t)TT * 1024 * 2);
constexpr size_t WS_U = al256(WS_XR + (size_t)TT * 2048 * 2);
constexpr size_t WS_XBC = al256(WS_U + (size_t)TT * 1024 * 2);
constexpr size_t WS_Y = al256(WS_XBC + (size_t)TT * 2048 * 2);
constexpr size_t WS_END0 = al256(WS_Y + (size_t)TT * 1024 * 4);
constexpr size_t WS_ACT = WS_R;
constexpr size_t WS_WGU = WS_XBC > al256(WS_ACT + (size_t)NROWS_MAX * 512 * 2) ? WS_XBC : al256(WS_ACT + (size_t)NROWS_MAX * 512 * 2);
constexpr size_t WS_WDT = al256(WS_WGU + (size_t)NE * 1024 * 1024 * 2);
constexpr size_t WS_YS = al256(WS_WDT + (size_t)NE * 1024 * 512 * 2);
constexpr size_t WS_ENDM = al256(WS_YS + (size_t)2 * TT * 1024 * 2);
static_assert(WS_ACT + (size_t)NROWS_MAX * 512 * 2 <= WS_WGU && (CFG_B != 8 || WS_WGU == WS_XBC), "MoE map");
constexpr size_t WS_P1 = WS_R;
constexpr size_t WS_O = al256(WS_P1 + (size_t)TT * 5120 * 2);
constexpr size_t WS_END1 = al256(WS_O + (size_t)TL * 1024 * 4);
constexpr size_t cmax(size_t a, size_t b) { return a > b ? a : b; }
constexpr size_t WS_YS1 = al256(WS_ACT + (size_t)NROWS_MAX * 512 * 2);
constexpr size_t WS_W1 = cmax(WS_END1, al256(WS_YS1 + (size_t)2 * TT * 1024 * 2));
constexpr size_t WS_END1B = al256(WS_W1 + (size_t)NE * (1024 * 1024 + 1024 * 512));
HD size_t ws_wgu(int l) { return l ? WS_W1 : WS_WGU; }
HD size_t ws_wdt(int l) { return l ? WS_W1 + (size_t)NE * 1024 * 1024 : WS_WDT; }
HD size_t ws_ys(int l) { return l ? WS_YS1 : WS_YS; }
constexpr size_t WS_NEED = cmax(cmax(WS_END0, WS_END1B), cmax(WS_ENDM, WS_END1));
static_assert(WS_YS >= WS_O || true, "");

struct P { const float* in[N_IN]; float* out; unsigned char* ws; };

HD int tok_modrow(int r) { return r < TL ? r / SEQ : NB; }
HD const float* xin_row(const P& p, int r) { return r < TL ? p.in[I_X] + (size_t)r * DM : p.in[I_CTX] + (size_t)(r - TL) * DM; }
HD bf16_t* xcur_row(const P& p, int r) { return (bf16_t*)(p.ws + WS_XB) + (size_t)r * DM; }
HD f32x4 ld_bf4(const bf16_t* q) { const u32x2 w = *(const u32x2*)q; return (f32x4){bflo(w.x), bfhi(w.x), bflo(w.y), bfhi(w.y)}; }
HD void st_bf4(bf16_t* q, f32x4 v) { u32x2 w; w.x = pk2(v[0], v[1]); w.y = pk2(v[2], v[3]); *(u32x2*)q = w; }
HD const float* modv(const P& p, int l, int row, int m) { return (const float*)(p.ws + WS_MODV) + ((size_t)(l * (NB + 1) + row) * 6 + m) * DM; }

struct SrcWin0 { const float* W; HD const float* operator()(int n) const {
    if (n < 3072) return W + n;
    if (n < 5120) { const int m = n - 3072, t = m >> 8, w = m & 255; return w < 128 ? W + 3104 + t * 128 + w : W + 4128 + t * 128 + (w - 128); }
    if (n < 5152) return W + 3072 + (n - 5120);
    return nullptr; } };
struct SrcId { const float* W; HD const float* operator()(int n) const { return W + n; } };
struct SrcGU { const float* Wg; const float* Wu; HD const float* operator()(int n) const { const int t = n >> 8, w = n & 255; return w < 128 ? Wg + t * 128 + w : Wu + t * 128 + (w - 128); } };


HD int moe_base(const int* CNT, int e) { int b = 0; for (int i = 0; i < NE; ++i) if (i < e) b += (CNT[i] + 255) & ~255; return b; }

typedef short bf16x8 __attribute__((ext_vector_type(8)));
typedef short s16x4 __attribute__((ext_vector_type(4)));
#ifndef CPU_TEST
#define LAS __attribute__((address_space(3)))
DEV void blk_sync() { asm volatile("s_waitcnt lgkmcnt(0)" ::: "memory"); __builtin_amdgcn_s_barrier(); asm volatile("" ::: "memory"); }
DEV float wshfl(float v, int src) { return __shfl(v, src); }
DEV unsigned long long wballot(bool pred) { return __ballot(pred); }
DEV void wave_sync() { asm volatile("s_waitcnt lgkmcnt(0)" ::: "memory"); __builtin_amdgcn_wave_barrier(); asm volatile("" ::: "memory"); }
DEV float bwsum(float v) { for (int o = 32; o; o >>= 1) v += __shfl_xor(v, o); return v; }
DEV f32x4 mfma16(bf16x8 a, bf16x8 b, f32x4 c) { return __builtin_amdgcn_mfma_f32_16x16x32_bf16(a, b, c, 0, 0, 0); }
DEV s16x4 lds_tr4(const LAS unsigned char* p) { return __builtin_amdgcn_ds_read_tr16_b64_v4i16((LAS s16x4*)p); }
#else
#define LAS
inline void blk_sync() { emu_block_barrier(); }
inline float wshfl(float v, int src) { return emu_shfl(v, src); }
inline unsigned long long wballot(bool pred) { return emu_ballot(pred); }
inline void wave_sync() { emu_wave_barrier(); }
inline float bwsum(float v) { for (int o = 32; o; o >>= 1) v += emu_shfl(v, (emu_tid() & 63) ^ o); return v; }
inline f32x4 mfma16(bf16x8 a, bf16x8 b, f32x4 c) { return emu_mfma_16x16x32(a, b, c); }
inline s16x4 lds_tr4(const unsigned char* p) { return emu_tr_read(p); }
#endif
#ifndef CPU_TEST
#define PIN4(a, b, c, d) asm volatile("" : "+v"(a), "+v"(b), "+v"(c), "+v"(d))
#define PIN8(a, b, c, d, e, f, g, h) asm volatile("" : "+v"(a), "+v"(b), "+v"(c), "+v"(d), "+v"(e), "+v"(f), "+v"(g), "+v"(h))
#define PIN12(a, b, c, d, e, f, g, h, i, j, k, l) asm volatile("" : "+v"(a), "+v"(b), "+v"(c), "+v"(d), "+v"(e), "+v"(f), "+v"(g), "+v"(h), "+v"(i), "+v"(j), "+v"(k), "+v"(l))
#else
#define PIN4(a, b, c, d)
#define PIN8(a, b, c, d, e, f, g, h)
#define PIN12(a, b, c, d, e, f, g, h, i, j, k, l)
#endif
DEV bf16x8 frag_row(const LAS unsigned char* m, int ld, int R0, int K0, int lane) { return *(const LAS bf16x8*)(m + ((R0 + (lane & 15)) * ld + K0 + 8 * (lane >> 4)) * 2); }
DEV bf16x8 frag_tr(const LAS unsigned char* m, int ld, int R0, int K0, int lane) {
  const int fq = lane >> 4, qq = (lane & 15) >> 2, pp = lane & 3;
  const LAS unsigned char* a = m + ((K0 + 8 * fq + qq) * ld + R0 + 4 * pp) * 2;
  const s16x4 lo = lds_tr4(a), hi = lds_tr4(a + 4 * ld * 2);
  return (bf16x8){lo[0], lo[1], lo[2], lo[3], hi[0], hi[1], hi[2], hi[3]};
}
#if defined(__HIP_DEVICE_COMPILE__)
DEV float dot2bf(unsigned a, unsigned b, float c) { return __builtin_amdgcn_fdot2_f32_bf16(__builtin_bit_cast(bf16x2_t, a), __builtin_bit_cast(bf16x2_t, b), c, false); }
#else
HD float dot2bf(unsigned a, unsigned b, float c) { return c + bflo(a) * bflo(b) + bfhi(a) * bfhi(b); }
#endif
DEV void store_lds8(LAS unsigned char* p, f32x4 a, f32x4 b) { u32x4 w; w.x = pk2(a[0], a[1]); w.y = pk2(a[2], a[3]); w.z = pk2(b[0], b[1]); w.w = pk2(b[2], b[3]); *(LAS u32x4*)p = w; }
DEV void lds_store_bf16x4(LAS unsigned char* p, f32x4 v) { u32x2 w; w.x = pk2(v[0], v[1]); w.y = pk2(v[2], v[3]); *(LAS u32x2*)p = w; }

namespace pg8 {
typedef short bf16x8 __attribute__((ext_vector_type(8)));
typedef int i32x8 __attribute__((ext_vector_type(8)));
constexpr int BM = 256, BK = 64, HALF = 128, HTB = HALF * BK * 2, STAGE_BYTES = 8 * HTB, NXCD = 8, WGM = 4;
HD int lds_byte(int r, int c) { const int st = (r >> 4) * 2 + (c >> 5), rr = r & 15, cc = c & 31, ob = rr * 64 + cc * 2; return st * 1024 + (ob ^ (((ob >> 9) & 1) << 5)); }
HD void stage_rc(int b, int& R, int& C) { const int st = b / 1024, sb = b % 1024, swz = sb ^ (((sb >> 9) & 1) << 5); R = (st >> 1) * 16 + swz / 64; C = (st & 1) * 32 + (swz % 64) / 2; }
HD int perm32(int rho) { const int n = rho >> 4, i = rho & 15; return 8 * (i >> 2) + 4 * n + (i & 3); }
struct Unit { int pm, pn; const bf16_t* Bt; const int* rs; const float* rw; int nvalid; };
struct Gemm { const bf16_t* A; int K; };
constexpr int FP8_WSCALE_LOG2 = 6;

HD void tile_order(int L, int nM, int nN, int& pm, int& pn) {
  const int nwg = nM * nN; int wgid = L;
  { const int q = nwg / NXCD, r = nwg % NXCD, xcd = wgid % NXCD, off = wgid / NXCD; wgid = (xcd < r ? xcd * (q + 1) : r * (q + 1) + (xcd - r) * q) + off; }
  const int nig = WGM * nN, gid = wgid / nig, fm = gid * WGM, gsz = (nM - fm) < WGM ? (nM - fm) : WGM;
  pm = fm + ((wgid % nig) % gsz); pn = (wgid % nig) / gsz;
}

#ifndef CPU_TEST
#define PG8_LAS __attribute__((address_space(3)))
#define PG8_GLDS(gp, lp) __builtin_amdgcn_global_load_lds((const unsigned*)(gp), (PG8_LAS unsigned*)(lp), 16, 0, 0)
#define PG8_WAIT_V(n) asm volatile("s_waitcnt vmcnt(" #n ")" ::: "memory")
#define PG8_WAIT_L(n) asm volatile("s_waitcnt lgkmcnt(" #n ")" ::: "memory")
#define PG8_BAR __builtin_amdgcn_s_barrier()
#define PG8_SCHED __builtin_amdgcn_sched_barrier(0)
#define PG8_PRIO(n) __builtin_amdgcn_s_setprio(n)
#define PG8_UNIFORM(x) __builtin_amdgcn_readfirstlane(x)
#define PG8_MFMA(a, b, c) __builtin_amdgcn_mfma_f32_16x16x32_bf16(a, b, c, 0, 0, 0)
DEV f32x4 mfma8_inplace(i32x8 w, i32x8 x, f32x4 c) { const int sc = 127 - FP8_WSCALE_LOG2 / 2;
  asm volatile("v_mfma_scale_f32_16x16x128_f8f6f4 %0, %1, %2, %0, %3, %3 op_sel_hi:[0,0,0]" : "+v"(c) : "v"(w), "v"(x), "v"(sc)); return c; }
#define PG8_MFMA8(w, x, c) mfma8_inplace(w, x, c)
#define PG8_MFMA_DRAIN asm volatile("s_nop 15\n\ts_nop 15\n\ts_nop 15" ::: "memory")
#else
#define PG8_LAS
#define PG8_GLDS(gp, lp) emu_global_load_lds16((const void*)(gp), (void*)(lp))
#define PG8_WAIT_V(n)
#define PG8_WAIT_L(n)
#define PG8_BAR emu_block_barrier()
#define PG8_SCHED
#define PG8_PRIO(n)
#define PG8_UNIFORM(x) (x)
#define PG8_MFMA(a, b, c) emu_mfma_16x16x32(a, b, c)
#define PG8_MFMA8(w, x, c) emu_mfma_scale_16x16x128(w, x, c, 127 - FP8_WSCALE_LOG2 / 2, 127 - FP8_WSCALE_LOG2 / 2)
#define PG8_MFMA_DRAIN
#endif
#ifndef CPU_TEST
#define PG8_GAS __attribute__((address_space(1)))
DEV void st_wt8(void* p, unsigned lo, unsigned hi) { __hip_atomic_store((PG8_GAS unsigned long long*)p, ((unsigned long long)hi << 32) | lo, __ATOMIC_RELAXED, __HIP_MEMORY_SCOPE_AGENT); }
DEV void cnt_bump(unsigned* c) { (void)__hip_atomic_fetch_add((PG8_GAS unsigned*)c, 1u, __ATOMIC_RELAXED, __HIP_MEMORY_SCOPE_AGENT); }
DEV void cnt_wait(unsigned* c, unsigned want) {
  if (PG8_UNIFORM(tidx() >> 6) == 0) { unsigned sp = 0;
    while ((unsigned)__builtin_amdgcn_readfirstlane(__hip_atomic_load((PG8_GAS unsigned*)c, __ATOMIC_RELAXED, __HIP_MEMORY_SCOPE_AGENT)) < want) { __builtin_amdgcn_s_sleep(1); if (++sp > (1u << 20)) break; }
    __builtin_amdgcn_fence(__ATOMIC_ACQUIRE, "agent"); asm volatile("s_waitcnt vmcnt(0)" ::: "memory"); }
  PG8_BAR;
}
#else
inline void st_wt8(void* p, unsigned lo, unsigned hi) { ((unsigned*)p)[0] = lo; ((unsigned*)p)[1] = hi; }
inline void cnt_bump(unsigned* c) { __atomic_fetch_add(c, 1u, __ATOMIC_SEQ_CST); }
inline void cnt_wait(unsigned* c, unsigned want) { if (__atomic_load_n(c, __ATOMIC_SEQ_CST) < want && emu_tid() == 0) fprintf(stderr, "cnt_wait: tile not ready (%u < %u)\n", *c, want); PG8_BAR; }
#endif
template <class Epi, class Sched, bool GATHER = false, bool ALIGN_EPI = true, bool SP2 = true, bool FP8 = false>
DEV void gemm_phase(PG8_LAS unsigned char* lds, const Gemm g, const Sched& S, const Epi& E) {
    const int tid = tidx(), wid = PG8_UNIFORM(tid >> 6), lane = tid & 63, wr = wid >> 2, wc = wid & 3, fr = lane & 15, fq = lane >> 4;
    const int K = g.K, nt = K / BK;
    unsigned voffA[2], voffB[2]; int stR[2], stC[2];
#pragma unroll
    for (int i = 0; i < 2; ++i) { int R, C; stage_rc(tid * 16 + i * 8192, R, C); const int Rb = Epi::PERM ? ((R & ~31) + perm32(R & 31)) : R; stR[i] = R; stC[i] = C;
        voffA[i] = (unsigned)(R * K + C) * 2u; voffB[i] = (unsigned)(Rb * K + C) * 2u; }
    const size_t kstep = (size_t)(BK * 2);
    const size_t hstep = (size_t)HALF * K * 2;
    const size_t tstep = 2 * hstep;
    const unsigned ldsw = (unsigned)wid * 1024u;
    const int aoff = lds_byte(wr * 64 + fr, fq * 8), boff = lds_byte(wc * 32 + fr, fq * 8);
    const int aoff8a = lds_byte(wr * 64 + fr, fq * 16), boff8a = lds_byte(wc * 32 + fr, fq * 16); constexpr int aoff8b = 16, boff8b = 16;
#define PG8_SA(b, h) (((b) * 2 + (h)) * HTB)
#define PG8_SB(b, h) ((4 + (b) * 2 + (h)) * HTB)
#define PG8_STAGE(bufoff, gbase, voff) do { _Pragma("unroll") for (int _i = 0; _i < 2; ++_i) \
        PG8_GLDS((const char*)(gbase) + (voff)[_i], lds + (bufoff) + ldsw + _i * 8192); } while (0)
#define PG8_STAGE_A(bufoff, h, kb, vg0, vg1) do { if constexpr (GATHER) { if (h) PG8_STAGE(bufoff, kb, vg1); else PG8_STAGE(bufoff, kb, vg0); } else PG8_STAGE(bufoff, (kb) + (h) * hstep, voffA); } while (0)
#define PG8_ROWOFFS(U, v0, v1) do { if constexpr (GATHER) { _Pragma("unroll") for (int _i = 0; _i < 2; ++_i) { \
        const int l0_ = stR[_i], l1_ = HALF + stR[_i]; const int s0_ = l0_ < (U).nvalid ? (U).rs[l0_] : 0, s1_ = l1_ < (U).nvalid ? (U).rs[l1_] : 0; \
        v0[_i] = (unsigned)((s0_ >> 1) * K + stC[_i]) * 2u; v1[_i] = (unsigned)((s1_ >> 1) * K + stC[_i]) * 2u; } } } while (0)
#define PG8_LDA(dst, b, h) do { if constexpr (FP8) { _Pragma("unroll") for (int m = 0; m < 4; ++m) { const u32x4 lo_ = *(const PG8_LAS u32x4*)(lds + PG8_SA(b, h) + aoff8a + m * 2048), hi_ = *(const PG8_LAS u32x4*)(lds + PG8_SA(b, h) + aoff8a + aoff8b + m * 2048); \
          dst##8[m] = __builtin_bit_cast(i32x8, __builtin_shufflevector(lo_, hi_, 0, 1, 2, 3, 4, 5, 6, 7)); } } \
        else { _Pragma("unroll") for (int m = 0; m < 4; ++m) _Pragma("unroll") for (int k = 0; k < 2; ++k) dst[m][k] = *(const PG8_LAS bf16x8*)(lds + PG8_SA(b, h) + aoff + m * 2048 + k * 1024); } } while (0)
#define PG8_LDB(dst, b, h) do { if constexpr (FP8) { _Pragma("unroll") for (int n = 0; n < 2; ++n) { const u32x4 lo_ = *(const PG8_LAS u32x4*)(lds + PG8_SB(b, h) + boff8a + n * 2048), hi_ = *(const PG8_LAS u32x4*)(lds + PG8_SB(b, h) + boff8a + boff8b + n * 2048); \
          dst##8[n] = __builtin_bit_cast(i32x8, __builtin_shufflevector(lo_, hi_, 0, 1, 2, 3, 4, 5, 6, 7)); } } \
        else { _Pragma("unroll") for (int n = 0; n < 2; ++n) _Pragma("unroll") for (int k = 0; k < 2; ++k) dst[n][k] = *(const PG8_LAS bf16x8*)(lds + PG8_SB(b, h) + boff + n * 2048 + k * 1024); } } while (0)
#define PG8_MMA(ai, bj, At, Bt) do { PG8_PRIO(1); if constexpr (FP8) { _Pragma("unroll") for (int m = 0; m < 4; ++m) _Pragma("unroll") for (int n = 0; n < 2; ++n) \
          acc[ai][bj][m][n] = PG8_MFMA8(Bt##8[n], At##8[m], acc[ai][bj][m][n]); } \
        else { _Pragma("unroll") for (int m = 0; m < 4; ++m) _Pragma("unroll") for (int n = 0; n < 2; ++n) _Pragma("unroll") for (int k = 0; k < 2; ++k) \
          acc[ai][bj][m][n] = PG8_MFMA(Bt[n][k], At[m][k], acc[ai][bj][m][n]); } PG8_PRIO(0); } while (0)
    Unit cur, nxt; int ui = 0;
    if (!S.next(0, cur)) return;
    f32x4 acc[2][2][4][2];
#pragma unroll
    for (int a = 0; a < 2; ++a)
#pragma unroll
        for (int b = 0; b < 2; ++b)
#pragma unroll
            for (int m = 0; m < 4; ++m)
#pragma unroll
                for (int n = 0; n < 2; ++n) acc[a][b][m][n] = (f32x4){0.f, 0.f, 0.f, 0.f};
    bf16x8 At[4][2], B0[2][2], B1[2][2]; i32x8 At8[4], B08[2], B18[2];
    unsigned cv0[2] = {0u, 0u}, cv1[2] = {0u, 0u}, nv0[2] = {0u, 0u}, nv1[2] = {0u, 0u};
    PG8_ROWOFFS(cur, cv0, cv1);
    const char* cA = GATHER ? (const char*)g.A : (const char*)g.A + (size_t)cur.pm * tstep; const char* cB = (const char*)cur.Bt + (size_t)cur.pn * tstep;
    if constexpr (SP2) {
        PG8_STAGE(PG8_SB(0, 0), cB, voffB); PG8_STAGE(PG8_SB(0, 1), cB + hstep, voffB); PG8_STAGE_A(PG8_SA(0, 0), 0, cA, cv0, cv1); PG8_STAGE_A(PG8_SA(0, 1), 1, cA, cv0, cv1);
        if (wr == 1) PG8_BAR;
        PG8_WAIT_V(2); PG8_BAR;
        PG8_STAGE(PG8_SB(1, 0), cB + kstep, voffB); PG8_STAGE_A(PG8_SA(1, 0), 0, cA + kstep, cv0, cv1); PG8_STAGE(PG8_SB(1, 1), cB + hstep + kstep, voffB);
        PG8_WAIT_V(6); PG8_BAR;
    } else {
        PG8_STAGE(PG8_SB(0, 0), cB, voffB); PG8_STAGE_A(PG8_SA(0, 0), 0, cA, cv0, cv1); PG8_STAGE(PG8_SB(0, 1), cB + hstep, voffB); PG8_STAGE_A(PG8_SA(0, 1), 1, cA, cv0, cv1);
        if (wr == 1) PG8_BAR;
        PG8_WAIT_V(4); PG8_BAR;
        PG8_STAGE(PG8_SB(1, 0), cB + kstep, voffB); PG8_STAGE_A(PG8_SA(1, 0), 0, cA + kstep, cv0, cv1); PG8_STAGE(PG8_SB(1, 1), cB + hstep + kstep, voffB);
        PG8_WAIT_V(6); PG8_BAR;
    }
    for (;;) {
        const bool has_next = S.next(ui + 1, nxt);
        if (has_next) PG8_ROWOFFS(nxt, nv0, nv1);
        else { nv0[0] = cv0[0]; nv0[1] = cv0[1]; nv1[0] = cv1[0]; nv1[1] = cv1[1]; }
        const char* nA = has_next ? (GATHER ? (const char*)g.A : (const char*)g.A + (size_t)nxt.pm * tstep) : cA; const char* nB = has_next ? (const char*)nxt.Bt + (size_t)nxt.pn * tstep : cB;
        for (int t = 0; t < nt; t += 2) {
            const bool last = (t == nt - 2);
            const char* a1 = cA + (size_t)(t + 1) * kstep;
            const char* a2 = last ? nA : cA + (size_t)(t + 2) * kstep; const char* b2 = last ? nB : cB + (size_t)(t + 2) * kstep;
            const char* a3 = a2 + kstep; const char* b3 = b2 + kstep;
            unsigned w0[2], w1[2];
            w0[0] = last ? nv0[0] : cv0[0]; w0[1] = last ? nv0[1] : cv0[1]; w1[0] = last ? nv1[0] : cv1[0]; w1[1] = last ? nv1[1] : cv1[1];
            if constexpr (SP2) {
            PG8_LDB(B0, 0, 0); PG8_LDB(B1, 0, 1); PG8_SCHED; PG8_LDA(At, 0, 0); PG8_STAGE_A(PG8_SA(1, 1), 1, a1, cv0, cv1);
            PG8_WAIT_V(8); PG8_WAIT_L(0); PG8_BAR; PG8_MMA(0, 0, At, B0); PG8_MMA(0, 1, At, B1); PG8_BAR; PG8_SCHED;
            PG8_LDA(At, 0, 1); PG8_STAGE(PG8_SB(0, 0), b2, voffB); PG8_STAGE(PG8_SB(0, 1), b2 + hstep, voffB); PG8_STAGE_A(PG8_SA(0, 0), 0, a2, w0, w1);
            PG8_WAIT_V(8); PG8_WAIT_L(0); PG8_BAR; PG8_MMA(1, 0, At, B0); PG8_MMA(1, 1, At, B1); PG8_BAR; PG8_SCHED;
            PG8_LDB(B0, 1, 0); PG8_LDB(B1, 1, 1); PG8_SCHED; PG8_LDA(At, 1, 0); PG8_STAGE_A(PG8_SA(0, 1), 1, a2, w0, w1);
            PG8_WAIT_V(8); PG8_WAIT_L(0); PG8_BAR; PG8_MMA(0, 0, At, B0); PG8_MMA(0, 1, At, B1); PG8_BAR; PG8_SCHED;
            PG8_LDA(At, 1, 1); PG8_STAGE(PG8_SB(1, 0), b3, voffB); PG8_STAGE(PG8_SB(1, 1), b3 + hstep, voffB); PG8_STAGE_A(PG8_SA(1, 0), 0, a3, w0, w1);
            PG8_WAIT_V(8); PG8_WAIT_L(0); PG8_BAR; PG8_MMA(1, 0, At, B0); PG8_MMA(1, 1, At, B1); PG8_BAR; PG8_SCHED;
            } else {
            PG8_LDB(B0, 0, 0); PG8_SCHED; PG8_LDA(At, 0, 0); PG8_STAGE_A(PG8_SA(1, 1), 1, a1, cv0, cv1);
            PG8_WAIT_L(8); PG8_BAR; PG8_WAIT_L(0); PG8_MMA(0, 0, At, B0); PG8_BAR; PG8_SCHED;
            PG8_LDB(B1, 0, 1); PG8_STAGE(PG8_SB(0, 0), b2, voffB);
            PG8_BAR; PG8_WAIT_L(0); PG8_MMA(0, 1, At, B1); PG8_BAR;
            PG8_LDA(At, 0, 1); PG8_STAGE_A(PG8_SA(0, 0), 0, a2, w0, w1);
            PG8_BAR; PG8_WAIT_L(0); PG8_MMA(1, 0, At, B0); PG8_BAR; PG8_SCHED;
            PG8_STAGE(PG8_SB(0, 1), b2 + hstep, voffB);
            PG8_WAIT_V(6); PG8_BAR; PG8_MMA(1, 1, At, B1); PG8_BAR;
            PG8_LDB(B0, 1, 0); PG8_SCHED; PG8_LDA(At, 1, 0); PG8_STAGE_A(PG8_SA(0, 1), 1, a2, w0, w1);
            PG8_WAIT_L(8); PG8_BAR; PG8_WAIT_L(0); PG8_MMA(0, 0, At, B0); PG8_BAR; PG8_SCHED;
            PG8_LDB(B1, 1, 1); PG8_STAGE(PG8_SB(1, 0), b3, voffB);
            PG8_BAR; PG8_WAIT_L(0); PG8_MMA(0, 1, At, B1); PG8_BAR;
            PG8_LDA(At, 1, 1); PG8_STAGE_A(PG8_SA(1, 0), 0, a3, w0, w1);
            PG8_BAR; PG8_WAIT_L(0); PG8_MMA(1, 0, At, B0); PG8_BAR; PG8_SCHED;
            PG8_STAGE(PG8_SB(1, 1), b3 + hstep, voffB);
            PG8_WAIT_V(6); PG8_BAR; PG8_MMA(1, 1, At, B1); PG8_BAR;
            }
        }
        if constexpr (ALIGN_EPI) { if (wr == 0) PG8_BAR; }
        if constexpr (FP8) PG8_MFMA_DRAIN;
        if constexpr (FP8) { const int t2 = tidx(), w2 = PG8_UNIFORM(t2 >> 6); E(acc, cur, w2 >> 2, w2 & 3, t2 & 15, (t2 & 63) >> 4); }
        else E(acc, cur, wr, wc, fr, fq);
        if constexpr (Epi::SIGNAL) { PG8_WAIT_V(0); PG8_BAR; if (tidx() == 0) E.signal(cur); }
        if (!has_next) break;
#pragma unroll
        for (int a = 0; a < 2; ++a)
#pragma unroll
            for (int b = 0; b < 2; ++b)
#pragma unroll
                for (int m = 0; m < 4; ++m)
#pragma unroll
                    for (int n = 0; n < 2; ++n) acc[a][b][m][n] = (f32x4){0.f, 0.f, 0.f, 0.f};
        cur = nxt; cA = nA; cB = nB; ++ui; cv0[0] = nv0[0]; cv0[1] = nv0[1]; cv1[0] = nv1[0]; cv1[1] = nv1[1];
        if constexpr (ALIGN_EPI) { if (wr == 1) PG8_BAR; }
    }
    PG8_WAIT_V(0);
    if constexpr (!ALIGN_EPI) { if (wr == 0) PG8_BAR; }
    PG8_BAR;
#undef PG8_SA
#undef PG8_SB
#undef PG8_STAGE
#undef PG8_STAGE_A
#undef PG8_ROWOFFS
#undef PG8_LDA
#undef PG8_LDB
#undef PG8_MMA
}
#ifdef CPU_TEST
template <class Epi, class Sched> void gemm_phase_ref(const Gemm g, const Sched& S, const Epi& E) {
  Unit u;
  for (int ui = 0; S.next(ui, u); ++ui)
    for (int wid = 0; wid < 8; ++wid) for (int lane = 0; lane < 64; ++lane) {
      const int wr = wid >> 2, wc = wid & 3, fr = lane & 15, fq = lane >> 4;
      f32x4 acc[2][2][4][2];
      for (int ai = 0; ai < 2; ++ai) for (int bj = 0; bj < 2; ++bj) for (int m = 0; m < 4; ++m) for (int n = 0; n < 2; ++n) for (int i = 0; i < 4; ++i) {
        const size_t row = (size_t)u.pm * 256 + ai * 128 + wr * 64 + m * 16 + fr;
        const size_t col = (size_t)u.pn * 256 + bj * 128 + wc * 32 + (Epi::PERM ? 8 * fq + 4 * n + i : 16 * n + 4 * fq + i);
        const bf16_t* a = g.A + row * g.K, *b = u.Bt + col * g.K; float s = 0.f;
        for (int k = 0; k < g.K; ++k) s += bf2f(a[k]) * bf2f(b[k]);
        acc[ai][bj][m][n][i] = s;
      }
      E(acc, u, wr, wc, fr, fq);
    }
}
#define GEMM_RUN(lds, g, S, E) do { if (tidx() == 0) pg8::gemm_phase_ref(g, S, E); } while (0)
#define GEMM_RUN_GATHER(lds, g, S, E) pg8::gemm_phase<decltype(E), decltype(S), true>((unsigned char*)(lds), g, S, E)
#define GEMM_RUN_FP8(lds, g, S, E) pg8::gemm_phase<decltype(E), decltype(S), false, true, true, true>((unsigned char*)(lds), g, S, E)
#define GEMM_RUN_GATHER_FP8(lds, g, S, E) pg8::gemm_phase<decltype(E), decltype(S), true, true, true, true>((unsigned char*)(lds), g, S, E)
#else
#define GEMM_RUN(lds, g, S, E) pg8::gemm_phase<decltype(E), decltype(S), false>((PG8_LAS unsigned char*)(lds), g, S, E)
#define GEMM_RUN_GATHER(lds, g, S, E) pg8::gemm_phase<decltype(E), decltype(S), true>((PG8_LAS unsigned char*)(lds), g, S, E)
#define GEMM_RUN_FP8(lds, g, S, E) pg8::gemm_phase<decltype(E), decltype(S), false, true, true, true>((PG8_LAS unsigned char*)(lds), g, S, E)
#define GEMM_RUN_GATHER_FP8(lds, g, S, E) pg8::gemm_phase<decltype(E), decltype(S), true, true, true, true>((PG8_LAS unsigned char*)(lds), g, S, E)
#endif
}
using pg8::Unit; using pg8::Gemm; using pg8::FP8_WSCALE_LOG2;

struct DenseOrder { int nM, nN, G, c; const bf16_t* Bt;
  HD bool next(int i, Unit& u) const { const long L = (long)i * G + c; if (L >= (long)nM * nN) return false; pg8::tile_order((int)L, nM, nN, u.pm, u.pn); u.Bt = Bt; u.rs = nullptr; u.rw = nullptr; u.nvalid = 256; return true; } };
struct Inproj1Order { int G, c; const bf16_t* Bt; int p0, p1;
  HD bool next(int i, Unit& u) const { const long L = (long)i * G + c; const int cp0 = p0 > 8 ? p0 : 8, n1 = (TL / 256) * (p1 - p0), n2 = p1 > cp0 ? (TC / 256) * (p1 - cp0) : 0; if (L >= n1 + n2) return false;
    if (L < n1) { pg8::tile_order((int)L, TL / 256, p1 - p0, u.pm, u.pn); u.pn += p0; } else { const int q = (int)L - n1; u.pm = TL / 256 + q % (TC / 256); u.pn = cp0 + q / (TC / 256); }
    u.Bt = Bt; u.rs = nullptr; u.rw = nullptr; u.nvalid = 256; return true; }
  HD int count() const { const int cp0 = p0 > 8 ? p0 : 8; return (TL / 256) * (p1 - p0) + (p1 > cp0 ? (TC / 256) * (p1 - cp0) : 0); } };
struct MoeOrder { int G, c; const int* CNT; const bf16_t* Bt; size_t estride; const int* RS; const float* RW;
  HD bool next(int i, Unit& u) const { int ntile = 0;
    for (int q = 0; q < NE; ++q) ntile += (CNT[q] + 255) >> 8;
    const bool full = (G % 8 == 0) && ((long)(i + 1) * G <= (long)ntile * 4);
    const long L = (long)i * G + (full ? (c % 8) * (G / 8) + c / 8 : c); const int t = (int)(L >> 2); int tb = 0, e = -1, j = 0, ce = 0;
    for (int q = 0; q < NE; ++q) { const int cq = CNT[q], nt = (cq + 255) >> 8; if (e < 0 && t < tb + nt) { e = q; j = t - tb; ce = cq; } tb += nt; }
    if (e < 0) return false; u.pm = t; u.pn = (int)(L & 3); u.Bt = Bt + (size_t)e * estride;
    u.rs = RS + (size_t)e * MOE_CAP + 256 * j; u.rw = RW + (size_t)e * MOE_CAP + 256 * j; u.nvalid = ce - 256 * j < 256 ? ce - 256 * j : 256; return true; } };

struct MoeOrderWait { MoeOrder base; unsigned* CNT;
  DEV bool next(int i, Unit& u) const { if (!base.next(i, u)) return false; pg8::cnt_wait(CNT + u.pm, 4u); return true; } };
HD f32x4 silu4(f32x4 v) { return (f32x4){siluf_(v[0]), siluf_(v[1]), siluf_(v[2]), siluf_(v[3])}; }
HD f32x4 sigm4(f32x4 v) { return (f32x4){sigmoidf_(v[0]), sigmoidf_(v[1]), sigmoidf_(v[2]), sigmoidf_(v[3])}; }
struct EpiInproj0 { static constexpr bool SIGNAL = false; static constexpr bool PERM = true; bf16_t* Z; bf16_t* XR; bf16_t* U; float* DT; const float* dtb;
  HD void operator()(const f32x4 (&acc)[2][2][4][2], const Unit& u, int wr, int wc, int fr, int fq) const {
#pragma unroll
    for (int ai = 0; ai < 2; ++ai)
#pragma unroll
      for (int m = 0; m < 4; ++m) {
        const size_t row = (size_t)u.pm * 256 + ai * 128 + wr * 64 + m * 16 + fr; const int cl = wc * 32 + 8 * fq;
        if (u.pn < 12) { bf16_t* base = u.pn < 4 ? Z + row * 1024 + u.pn * 256 : XR + row * 2048 + (u.pn - 4) * 256;
#pragma unroll
          for (int bj = 0; bj < 2; ++bj) store_bf16x8(base + bj * 128 + cl, acc[ai][bj][m][0], acc[ai][bj][m][1]); }
        else if (u.pn < 20) store_bf16x8(U + row * 1024 + (u.pn - 12) * 128 + cl, acc[ai][0][m][0] * sigm4(acc[ai][1][m][0]), acc[ai][0][m][1] * sigm4(acc[ai][1][m][1]));
        else if (wc == 0) {
#pragma unroll
          for (int n = 0; n < 2; ++n)
#pragma unroll
            for (int i = 0; i < 4; ++i) { const int j = 8 * fq + 4 * n + i; DT[row * 32 + j] = softplusf_(acc[ai][0][m][n][i] + dtb[j]); } }
      }
  } };
struct EpiResid { static constexpr bool SIGNAL = false; static constexpr bool PERM = false; const P* p; int l; bool from_input;
  HD void operator()(const f32x4 (&acc)[2][2][4][2], const Unit& u, int wr, int wc, int fr, int fq) const {
    const float* gate = modv(*p, l, tok_modrow(u.pm * 256), 2) + u.pn * 256 + wc * 32 + 4 * fq;
    f32x4 g4[2][2];
#pragma unroll
    for (int bj = 0; bj < 2; ++bj)
#pragma unroll
      for (int n = 0; n < 2; ++n) g4[bj][n] = *(const f32x4*)(gate + bj * 128 + 16 * n);
#pragma unroll
    for (int ai = 0; ai < 2; ++ai)
#pragma unroll
      for (int m = 0; m < 4; ++m) {
        const int row = u.pm * 256 + ai * 128 + wr * 64 + m * 16 + fr;
        const float* bin = xin_row(*p, row); bf16_t* dst = xcur_row(*p, row);
#pragma unroll
        for (int bj = 0; bj < 2; ++bj)
#pragma unroll
          for (int n = 0; n < 2; ++n) { const int c = u.pn * 256 + bj * 128 + wc * 32 + 16 * n + 4 * fq;
            const f32x4 base = from_input ? NT_LOAD4(bin + c) : ld_bf4(dst + c);
            st_bf4(dst + c, base + g4[bj][n] * acc[ai][bj][m][n]); }
      }
  } };
struct EpiMoe1 { static constexpr bool SIGNAL = true; static constexpr bool PERM = true; unsigned char* ACT; unsigned* CNT;
  HD void operator()(const f32x4 (&acc)[2][2][4][2], const Unit& u, int wr, int wc, int fr, int fq) const {
#pragma unroll
    for (int ai = 0; ai < 2; ++ai)
#pragma unroll
      for (int m = 0; m < 4; ++m) { const size_t row = (size_t)u.pm * 256 + ai * 128 + wr * 64 + m * 16 + fr;
        const f32x4 a = silu4(acc[ai][0][m][0]) * acc[ai][1][m][0], b = silu4(acc[ai][0][m][1]) * acc[ai][1][m][1];
        u32x2 o; o.x = pk4_fp8(a[0], a[1], a[2], a[3]); o.y = pk4_fp8(b[0], b[1], b[2], b[3]);
        pg8::st_wt8(ACT + row * 512 + u.pn * 128 + wc * 32 + 8 * fq, o.x, o.y); }
  }
  HD void signal(const Unit& u) const { pg8::cnt_bump(CNT + u.pm); } };
struct EpiMoe2 { static constexpr bool SIGNAL = false; static constexpr bool PERM = true; bf16_t* YS;
  HD void operator()(const f32x4 (&acc)[2][2][4][2], const Unit& u, int wr, int wc, int fr, int fq) const {
#pragma unroll
    for (int ai = 0; ai < 2; ++ai)
#pragma unroll
      for (int m = 0; m < 4; ++m) { const int li = ai * 128 + wr * 64 + m * 16 + fr;
        if (li < u.nvalid) { const int slot = u.rs[li]; const float w = u.rw[li]; bf16_t* dst = YS + (size_t)slot * 1024 + u.pn * 256 + wc * 32 + 8 * fq;
#pragma unroll
          for (int bj = 0; bj < 2; ++bj) store_bf16x8(dst + bj * 128, acc[ai][bj][m][0] * w, acc[ai][bj][m][1] * w); } }
  } };
struct EpiInproj1 { static constexpr bool SIGNAL = false; static constexpr bool PERM = true; bf16_t* P1; const float* lbt;
  HD void operator()(const f32x4 (&acc)[2][2][4][2], const Unit& u, int wr, int wc, int fr, int fq) const {
#pragma unroll
    for (int bj = 0; bj < 2; ++bj) { const int c = u.pn * 256 + bj * 128 + wc * 32 + 8 * fq;
      f32x4 lb0 = {0.f, 0.f, 0.f, 0.f}, lb1 = {0.f, 0.f, 0.f, 0.f};
      if (u.pn >= 12) { lb0 = *(const f32x4*)(lbt + (c & 1023)); lb1 = *(const f32x4*)(lbt + (c & 1023) + 4); }
#pragma unroll
      for (int ai = 0; ai < 2; ++ai)
#pragma unroll
        for (int m = 0; m < 4; ++m) { const size_t row = (size_t)u.pm * 256 + ai * 128 + wr * 64 + m * 16 + fr; f32x4 v0 = acc[ai][bj][m][0], v1 = acc[ai][bj][m][1];
          if (u.pn < 4) { v0 = silu4(v0); v1 = silu4(v1); }
          else if (u.pn >= 12) {
#pragma unroll
            for (int i = 0; i < 4; ++i) { v0[i] = (1.f - lb0[i]) * sigmoidf_(-v0[i]); v1[i] = (1.f - lb1[i]) * sigmoidf_(-v1[i]); } }
          store_bf16x8(P1 + row * 5120 + c, v0, v1); } }
  } };

DEV void ph_gemm_inproj0(const P& p, void* lds, int bid, int G) {
  Gemm g{(const bf16_t*)p.out, 1024}; DenseOrder S{TT / 256, N0P / 256, G, bid, (const bf16_t*)(p.ws + WS_WIN0)};
  EpiInproj0 E{(bf16_t*)(p.ws + WS_Z), (bf16_t*)(p.ws + WS_XR), (bf16_t*)(p.ws + WS_U), (float*)(p.ws + WS_DT), p.in[I_DTB]};
  GEMM_RUN(lds, g, S, E);
}
DEV void ph_gemm_outproj0(const P& p, void* lds, int bid, int G) {
  static_assert(FP8_OUT0, "OCAT in d_out assumes the e4m3 format");
  Gemm g{(const bf16_t*)p.out, FP8_OUT0 ? 1024 : 2048}; DenseOrder S{TT / 256, 4, G, bid, (const bf16_t*)(p.ws + WS_WOUT0)}; EpiResid E{&p, 0, true};
  if constexpr (FP8_OUT0) { GEMM_RUN_FP8(lds, g, S, E); } else { GEMM_RUN(lds, g, S, E); }
}
DEV void ph_gemm_moe1(const P& p, int l, void* lds, int bid, int G) {
  Gemm g{(const bf16_t*)p.out, 512}; MoeOrder S{G, bid, (const int*)(p.ws + WS_CTL) + l * NE, (const bf16_t*)(p.ws + ws_wgu(l)), (size_t)1024 * 1024 / 2, (const int*)(p.ws + WS_RSLOT), (const float*)(p.ws + WS_RW)};
  EpiMoe1 E{(unsigned char*)(p.ws + WS_ACT), (unsigned*)(p.ws + WS_MOECNT) + l * 160};
  GEMM_RUN_GATHER_FP8(lds, g, S, E);
}
DEV void ph_gemm_moe2(const P& p, int l, void* lds, int bid, int G) {
  const int* CNT = (const int*)(p.ws + WS_CTL) + l * NE; int n1 = 0;
  for (int q = 0; q < NE; ++q) n1 += 4 * ((CNT[q] + 255) >> 8);
  const int c2 = (bid + G - n1 % G) % G;
  Gemm g{(const bf16_t*)(p.ws + WS_ACT), 256}; MoeOrderWait S{MoeOrder{G, c2, CNT, (const bf16_t*)(p.ws + ws_wdt(l)), (size_t)1024 * 512 / 2, (const int*)(p.ws + WS_RSLOT), (const float*)(p.ws + WS_RW)}, (unsigned*)(p.ws + WS_MOECNT) + l * 160};
  EpiMoe2 E{(bf16_t*)(p.ws + ws_ys(l))};
  GEMM_RUN_FP8(lds, g, S, E);
}
DEV void ph_gemm_inproj1(const P& p, void* lds, int bid, int G) {
  EpiInproj1 E{(bf16_t*)(p.ws + WS_P1), (const float*)(p.ws + WS_LB)};
  Gemm g{(const bf16_t*)p.out, 1024}; Inproj1Order S{G, bid, (const bf16_t*)(p.ws + WS_WHGI), IN1_F8, 20};
  GEMM_RUN(lds, g, S, E);
  if constexpr (IN1_F8 > 0) {
    Gemm g8{(const bf16_t*)((const unsigned char*)p.out + (size_t)TT * DM * 2), 512}; Inproj1Order S8{G, (bid + G - S.count() % G) % G, (const bf16_t*)(p.ws + WS_WHGI), 0, IN1_F8};
    GEMM_RUN_FP8(lds, g8, S8, E);
  }
}
DEV void ph_gemm_outproj1(const P& p, void* lds, int bid, int G) {
  Gemm g{(const bf16_t*)p.out, FP8_OUT1 ? 512 : 1024}; DenseOrder S{TL / 256, 4, G, bid, (const bf16_t*)(p.ws + WS_WHGO)}; EpiResid E{&p, 1, false};
  if constexpr (FP8_OUT1) { GEMM_RUN_FP8(lds, g, S, E); } else { GEMM_RUN(lds, g, S, E); }
}

HD void tok_pos(int r, int& t, int& L) { if (r < TL) { t = r % SEQ; L = SEQ; } else { t = (r - TL) % CTX; L = CTX; } }


constexpr int SSD_LD = 136, SSD_LDX = 72;
constexpr int SSD_OFF_C = 0, SSD_OFF_B = SSD_OFF_C + 128 * SSD_LD * 2, SSD_OFF_X = SSD_OFF_B + 128 * SSD_LD * 2, SSD_OFF_XW = SSD_OFF_X + 128 * SSD_LDX * 2,
              SSD_OFF_S = SSD_OFF_XW + 128 * SSD_LDX * 2, SSD_OFF_F = SSD_OFF_S + 64 * SSD_LD * 2, SSD_LDS_END = SSD_OFF_F + 2 * 520 * 4;
static_assert(SSD_LDS_END <= LDS_BYTES - 64, "SSD LDS map");
DEV void ph_ssd_chunked(const P& p, LAS unsigned char* lds, int bid, int G) {
  const int t = tidx(), wid = PG8_UNIFORM(t >> 6), lane = t & 63, fr = lane & 15, fq = lane >> 4;
  constexpr int LD = SSD_LD, LDX = SSD_LDX;
  LAS unsigned char* Cm = lds + SSD_OFF_C; LAS unsigned char* Bm = lds + SSD_OFF_B; LAS unsigned char* Xm = lds + SSD_OFF_X; LAS unsigned char* XWm = lds + SSD_OFF_XW; LAS unsigned char* Sb = lds + SSD_OFF_S;
  LAS float* fab = (LAS float*)(lds + SSD_OFF_F);
  const bf16_t* XBC = (const bf16_t*)(p.ws + WS_XBC); const float* DT = (const float*)(p.ws + WS_DT);
  constexpr int NCH = (CTX + SEQ) / 128;
  for (int u = bid; u < NB * 32; u += G) {
    const int b = u >> 5, d = (u >> 4) & 1, h = u & 15, g = h >> 2, sgn = d ? -1 : 1;
    const float a = -fexp(p.in[I_ALOG][d * 16 + h]), Dk = p.in[I_SSDD][h];
    bf16_t* Yd = (bf16_t*)(p.ws + WS_Y) + (size_t)d * TT * 1024;
    f32x4 ST[2][2];
#pragma unroll
    for (int i = 0; i < 2; ++i)
#pragma unroll
      for (int j = 0; j < 2; ++j) ST[i][j] = (f32x4){0.f, 0.f, 0.f, 0.f};
    blk_sync();
    for (int i = t; i < 64 * LD / 2; i += NT) ((LAS unsigned*)Sb)[i] = 0u;
    u32x4 nC[4], nB[4], nX[2]; float ndt0 = 0.f, ndt1 = 0.f;
#define SSD_R0(cc) ((cc) * 128 < CTX ? TL + b * CTX + (d ? CTX - 1 - (cc) * 128 : (cc) * 128) : b * SEQ + (d ? SEQ - 1 - ((cc) * 128 - CTX) : ((cc) * 128 - CTX)))
#define SSD_LOAD(cc) do { const int r0_ = SSD_R0(cc); \
      _Pragma("unroll") for (int i_ = 0; i_ < 4; ++i_) { const int v_ = t + NT * i_; const bf16_t* s_ = XBC + (size_t)(r0_ + sgn * (v_ >> 4)) * 2048 + g * 128 + (v_ & 15) * 8; nC[i_] = *(const u32x4*)(s_ + 1536); nB[i_] = *(const u32x4*)(s_ + 1024); } \
      _Pragma("unroll") for (int i_ = 0; i_ < 2; ++i_) { const int v_ = t + NT * i_; nX[i_] = *(const u32x4*)(XBC + (size_t)(r0_ + sgn * (v_ >> 3)) * 2048 + h * 64 + (v_ & 7) * 8); } \
      if (wid == 0) { ndt0 = DT[(size_t)(r0_ + sgn * (2 * lane)) * 32 + d * 16 + h]; ndt1 = DT[(size_t)(r0_ + sgn * (2 * lane + 1)) * 32 + d * 16 + h]; } } while (0)
    SSD_LOAD(0);
#define SSD_TABLE(dst) do { if (wid == 0) { LAS float* f_ = (dst); const int j0 = 2 * lane; const float dt0 = ndt0, dt1 = ndt1, la0 = dt0 * a, la1 = dt1 * a; float ps = la0 + la1; \
      _Pragma("unroll") for (int o = 1; o < 64; o <<= 1) { const float n_ = wshfl(ps, lane - o); if (lane >= o) ps += n_; } \
      const float end = wshfl(ps, 63), ac0 = ps - la1, ac1 = ps; \
      f_[j0] = dt0; f_[j0 + 1] = dt1; f_[128 + j0] = ac0; f_[129 + j0] = ac1; f_[256 + j0] = dt0 * fexp(end - ac0); f_[257 + j0] = dt1 * fexp(end - ac1); \
      f_[384 + j0] = fexp(ac0); f_[385 + j0] = fexp(ac1); if (lane == 0) f_[512] = fexp(end); } } while (0)
    SSD_TABLE(fab);
    for (int c = 0; c < NCH; ++c) {
      const int s0 = c * 128;
      const int r0 = s0 < CTX ? TL + b * CTX + (d ? CTX - 1 - s0 : s0) : b * SEQ + (d ? SEQ - 1 - (s0 - CTX) : (s0 - CTX));
      u32x4 xv[2];
#pragma unroll
      for (int i = 0; i < 4; ++i) { const int v = t + NT * i, row = v >> 4, c16 = v & 15; *(LAS u32x4*)(Cm + row * LD * 2 + c16 * 16) = nC[i]; *(LAS u32x4*)(Bm + row * LD * 2 + c16 * 16) = nB[i]; }
#pragma unroll
      for (int i = 0; i < 2; ++i) { const int v = t + NT * i, row = v >> 3, c8 = v & 7; xv[i] = nX[i]; *(LAS u32x4*)(Xm + row * LDX * 2 + c8 * 16) = xv[i]; }
      if (c + 1 < NCH) SSD_LOAD(c + 1);
      LAS float* fa = fab + (c & 1) * 520;
      blk_sync();
#pragma unroll
      for (int i = 0; i < 2; ++i) { const int v = t + NT * i, row = v >> 3, c8 = v & 7; const float w = fa[256 + row]; u32x4 o;
        o.x = pk2(bflo(xv[i].x) * w, bfhi(xv[i].x) * w); o.y = pk2(bflo(xv[i].y) * w, bfhi(xv[i].y) * w); o.z = pk2(bflo(xv[i].z) * w, bfhi(xv[i].z) * w); o.w = pk2(bflo(xv[i].w) * w, bfhi(xv[i].w) * w);
        *(LAS u32x4*)(XWm + row * LDX * 2 + c8 * 16) = o; }
      const int I1 = (0x22331100 >> (4 * wid)) & 3, J1 = (0x01011010 >> (4 * wid)) & 1;
      f32x4 cb[2][4];
#pragma unroll
      for (int i = 0; i < 2; ++i)
#pragma unroll
        for (int j = 0; j < 4; ++j) cb[i][j] = (f32x4){0.f, 0.f, 0.f, 0.f};
      if (2 * I1 <= ((4 * J1 + 3) | 1)) {
#pragma unroll
        for (int q = 0; q < 4; ++q) {
          bf16x8 af[2], bfm[4];
#pragma unroll
          for (int i = 0; i < 2; ++i) af[i] = frag_row(Bm, LD, 16 * (2 * I1 + i), 32 * q, lane);
#pragma unroll
          for (int j = 0; j < 4; ++j) bfm[j] = frag_row(Cm, LD, 16 * (4 * J1 + j), 32 * q, lane);
#pragma unroll
          for (int i = 0; i < 2; ++i)
#pragma unroll
            for (int j = 0; j < 4; ++j) if (2 * I1 + i <= ((4 * J1 + j) | 1)) cb[i][j] = mfma16(af[i], bfm[j], cb[i][j]);
        }
      }
      blk_sync();
      const int NI = wid & 3, PJ = wid >> 2;
      { const float dec = fa[512];
#pragma unroll
        for (int i = 0; i < 2; ++i)
#pragma unroll
          for (int j = 0; j < 2; ++j) ST[i][j] *= dec;
#pragma unroll
        for (int q = 0; q < 4; ++q) {
          bf16x8 af[2], bfm[2];
#pragma unroll
          for (int i = 0; i < 2; ++i) af[i] = frag_tr(Bm, LD, 16 * (2 * NI + i), 32 * q, lane);
#pragma unroll
          for (int j = 0; j < 2; ++j) bfm[j] = frag_tr(XWm, LDX, 16 * (2 * PJ + j), 32 * q, lane);
#pragma unroll
          for (int i = 0; i < 2; ++i)
#pragma unroll
            for (int j = 0; j < 2; ++j) ST[i][j] = mfma16(af[i], bfm[j], ST[i][j]);
        }
      }
      blk_sync();
#pragma unroll
      for (int i = 0; i < 2; ++i)
#pragma unroll
        for (int j = 0; j < 4; ++j) if (2 * I1 + i <= ((4 * J1 + j) | 1)) {
          const int s = 16 * (2 * I1 + i) + 4 * fq, l = 16 * (4 * J1 + j) + fr; const float al = fa[128 + l];
          const f32x4 as = *(const LAS f32x4*)(fa + 128 + s), ds = *(const LAS f32x4*)(fa + s); f32x4 m;
#pragma unroll
          for (int e = 0; e < 4; ++e) m[e] = (s + e <= l) ? cb[i][j][e] * fexp(al - as[e]) * ds[e] : 0.f;
          lds_store_bf16x4(Bm + (l * LD + s) * 2, m);
        }
      blk_sync();
      { const int PI = wid & 1, JJ = wid >> 1;
        f32x4 yd[2][2], yo[2][2];
#pragma unroll
        for (int i = 0; i < 2; ++i)
#pragma unroll
          for (int j = 0; j < 2; ++j) { yd[i][j] = (f32x4){0.f, 0.f, 0.f, 0.f}; yo[i][j] = (f32x4){0.f, 0.f, 0.f, 0.f}; }
        for (int q = 0; q <= JJ; ++q) {
          bf16x8 af[2], bfm[2];
#pragma unroll
          for (int i = 0; i < 2; ++i) af[i] = frag_tr(Xm, LDX, 16 * (2 * PI + i), 32 * q, lane);
#pragma unroll
          for (int j = 0; j < 2; ++j) bfm[j] = frag_row(Bm, LD, 16 * (2 * JJ + j), 32 * q, lane);
#pragma unroll
          for (int i = 0; i < 2; ++i)
#pragma unroll
            for (int j = 0; j < 2; ++j) yd[i][j] = mfma16(af[i], bfm[j], yd[i][j]);
        }
#pragma unroll
        for (int q = 0; q < 4; ++q) {
          bf16x8 af[2], bfm[2];
#pragma unroll
          for (int i = 0; i < 2; ++i) af[i] = frag_row(Sb, LD, 16 * (2 * PI + i), 32 * q, lane);
#pragma unroll
          for (int j = 0; j < 2; ++j) bfm[j] = frag_row(Cm, LD, 16 * (2 * JJ + j), 32 * q, lane);
#pragma unroll
          for (int i = 0; i < 2; ++i)
#pragma unroll
            for (int j = 0; j < 2; ++j) yo[i][j] = mfma16(af[i], bfm[j], yo[i][j]);
        }
#pragma unroll
        for (int i = 0; i < 2; ++i)
#pragma unroll
          for (int j = 0; j < 2; ++j) { const int pb = 16 * (2 * PI + i) + 4 * fq, l = 16 * (2 * JJ + j) + fr; const float e = fa[384 + l];
            f32x4 y = yd[i][j] + yo[i][j] * e;
            if (d == 0) { const u32x2 xs = *(const LAS u32x2*)(Xm + (l * LDX + pb) * 2); y += (f32x4){bflo(xs.x), bfhi(xs.x), bflo(xs.y), bfhi(xs.y)} * Dk; }
            u32x2 o; o.x = pk2(y[0], y[1]); o.y = pk2(y[2], y[3]); *(u32x2*)(Yd + (size_t)(r0 + sgn * l) * 1024 + h * 64 + pb) = o; }
      }
      blk_sync();
      if (c + 1 < NCH) SSD_TABLE(fab + ((c + 1) & 1) * 520);
#pragma unroll
      for (int i = 0; i < 2; ++i)
#pragma unroll
        for (int j = 0; j < 2; ++j) lds_store_bf16x4(Sb + ((16 * (2 * PJ + j) + fr) * LD + 16 * (2 * NI + i) + 4 * fq) * 2, ST[i][j]);
    }
  }
}


constexpr int HG_LD = 136, HG_LDV = 72;
constexpr int HG_OFF_G = 0, HG_OFF_QR = HG_OFF_G + 64 * 128 * 4, HG_OFF_KR = HG_OFF_QR + 64 * HG_LD * 2, HG_OFF_QG = HG_OFF_KR + 64 * HG_LD * 2, HG_OFF_KE = HG_OFF_QG + 64 * HG_LD * 2,
              HG_OFF_V = HG_OFF_KE + 64 * HG_LD * 2, HG_OFF_AT = HG_OFF_V + 64 * HG_LDV * 2, HG_OFF_S = HG_OFF_AT + 64 * HG_LDV * 2, HG_LDS_END = HG_OFF_S + 64 * HG_LD * 2;
static_assert(HG_LDS_END <= LDS_BYTES, "HGRN2 LDS map");
HD int hg_row(int b, int d, int s) { if (s < CTX) return TL + b * CTX + (d ? CTX - 1 - s : s); int tp = s - CTX; if (d) tp = SEQ - 1 - tp; return b * SEQ + (tp % ROWS) * GW + tp / ROWS; }
DEV void ph_hg_chunked(const P& p, LAS unsigned char* lds, int bid, int G) {
  const int t = tidx(), wid = PG8_UNIFORM(t >> 6), lane = t & 63, fr = lane & 15, fq = lane >> 4;
  constexpr int LD = HG_LD, LDV = HG_LDV;
  LAS float* Gm = (LAS float*)(lds + HG_OFF_G); LAS unsigned char* QRm = lds + HG_OFF_QR; LAS unsigned char* KRm = lds + HG_OFF_KR; LAS unsigned char* QGm = lds + HG_OFF_QG; LAS unsigned char* KEm = lds + HG_OFF_KE;
  LAS unsigned char* Vm = lds + HG_OFF_V; LAS unsigned char* ATm = lds + HG_OFF_AT; LAS unsigned char* Sb = lds + HG_OFF_S; LAS float* PT = (LAS float*)ATm;
  const bf16_t* P1 = (const bf16_t*)(p.ws + WS_P1);
  constexpr int NCH = (CTX + SEQ) / 64;
  for (int u = bid; u < NB * 32; u += G) {
    const int b = u >> 5, d = (u >> 4) & 1, h = (u >> 1) & 7, vh = u & 1;
    bf16_t* Od = (bf16_t*)(p.ws + WS_O) + (size_t)d * TL * 1024;
    f32x4 ST[2][2];
#pragma unroll
    for (int i = 0; i < 2; ++i)
#pragma unroll
      for (int j = 0; j < 2; ++j) ST[i][j] = (f32x4){0.f, 0.f, 0.f, 0.f};
    blk_sync();
    for (int i = t; i < 64 * LD / 2; i += NT) ((LAS unsigned*)Sb)[i] = 0u;
    u32x4 nlf[2], nq[2], nv;
#define HG_LOAD(cc) do { _Pragma("unroll") for (int i_ = 0; i_ < 2; ++i_) { const int v_ = t + NT * i_; const bf16_t* s_ = P1 + (size_t)hg_row(b, d, (cc) * 64 + (v_ >> 4)) * 5120 + h * 128 + (v_ & 15) * 8; \
        nlf[i_] = *(const u32x4*)(s_ + 3072 + d * 1024); nq[i_] = ((cc) * 64 >= CTX) ? *(const u32x4*)s_ : (u32x4){0u, 0u, 0u, 0u}; } \
      nv = *(const u32x4*)(P1 + (size_t)hg_row(b, d, (cc) * 64 + (t >> 3)) * 5120 + 2048 + h * 128 + vh * 64 + (t & 7) * 8); } while (0)
    HG_LOAD(0);
    for (int c = 0; c < NCH; ++c) {
      const bool lat = c * 64 >= CTX;
      u32x4 lfv[2], qv[2];
#pragma unroll
      for (int i = 0; i < 2; ++i) { const int v = t + NT * i, j = v >> 4, c16 = v & 15; lfv[i] = nlf[i]; qv[i] = nq[i];
        LAS float* gp = Gm + j * 128 + c16 * 8;
        *(LAS f32x4*)gp = 1.f - (f32x4){bflo(lfv[i].x), bfhi(lfv[i].x), bflo(lfv[i].y), bfhi(lfv[i].y)}; *(LAS f32x4*)(gp + 4) = 1.f - (f32x4){bflo(lfv[i].z), bfhi(lfv[i].z), bflo(lfv[i].w), bfhi(lfv[i].w)}; }
      { const int j = t >> 3, c8 = t & 7; *(LAS u32x4*)(Vm + (j * LDV + c8 * 8) * 2) = nv; }
      if (c + 1 < NCH) HG_LOAD(c + 1);
      blk_sync();
      { const int k = t & 127, part = t >> 7; float gv[16];
#pragma unroll
        for (int j = 0; j < 16; ++j) gv[j] = Gm[(part * 16 + j) * 128 + k];
#pragma unroll
        for (int j = 1; j < 16; ++j) gv[j] *= gv[j - 1];
        PT[part * 128 + k] = gv[15];
        blk_sync();
        float pre = 1.f;
#pragma unroll
        for (int q = 0; q < 3; ++q) pre *= (q < part) ? PT[q * 128 + k] : 1.f;
#pragma unroll
        for (int j = 0; j < 16; ++j) Gm[(part * 16 + j) * 128 + k] = gv[j] * pre;
      }
      blk_sync();
#pragma unroll
      for (int hh = 0; hh < 2; ++hh) {
        const int k0 = (t & 15) * 8 + hh * 4;
        const f32x4 p31 = *(const LAS f32x4*)(Gm + 31 * 128 + k0), p63 = *(const LAS f32x4*)(Gm + 63 * 128 + k0);
        f32x4 ip31;
#pragma unroll
        for (int e = 0; e < 4; ++e) ip31[e] = fdiv(1.f, p31[e]);
#pragma unroll
        for (int i = 0; i < 2; ++i) { const int v = t + NT * i, j = v >> 4;
          const f32x4 pc = *(const LAS f32x4*)(Gm + j * 128 + k0);
          const unsigned kw0 = hh ? lfv[i].z : lfv[i].x, kw1 = hh ? lfv[i].w : lfv[i].y, qw0 = hh ? qv[i].z : qv[i].x, qw1 = hh ? qv[i].w : qv[i].y;
          const f32x4 k4 = (f32x4){bflo(kw0), bfhi(kw0), bflo(kw1), bfhi(kw1)}, q4 = (f32x4){bflo(qw0), bfhi(qw0), bflo(qw1), bfhi(qw1)};
          f32x4 kip;
#pragma unroll
          for (int e = 0; e < 4; ++e) kip[e] = fdiv(k4[e], pc[e]);
          const f32x4 qg = q4 * pc;
          const int off = (j * LD + k0) * 2;
          lds_store_bf16x4(QRm + off, qg * ip31); lds_store_bf16x4(KRm + off, kip * p31); lds_store_bf16x4(QGm + off, qg); lds_store_bf16x4(KEm + off, kip * p63); }
      }
      blk_sync();
      const int TI = wid & 3, TJ = wid >> 2;
      if (lat && TI <= ((2 * TJ + 1) | 1)) {
        f32x4 at[2] = {(f32x4){0.f, 0.f, 0.f, 0.f}, (f32x4){0.f, 0.f, 0.f, 0.f}};
        { bf16x8 af[4], b0[4], b1[4];
#pragma unroll
          for (int q = 0; q < 4; ++q) { af[q] = frag_row(KRm, LD, 16 * TI, 32 * q, lane); b0[q] = frag_row(QRm, LD, 16 * (2 * TJ), 32 * q, lane); b1[q] = frag_row(QRm, LD, 16 * (2 * TJ + 1), 32 * q, lane); }
          PIN12(af[0], af[1], af[2], af[3], b0[0], b0[1], b0[2], b0[3], b1[0], b1[1], b1[2], b1[3]);
#pragma unroll
          for (int q = 0; q < 4; ++q) { at[0] = mfma16(af[q], b0[q], at[0]); at[1] = mfma16(af[q], b1[q], at[1]); } }
#pragma unroll
        for (int j = 0; j < 2; ++j) { const int s = 16 * TI + 4 * fq, l = 16 * (2 * TJ + j) + fr; f32x4 m;
#pragma unroll
          for (int e = 0; e < 4; ++e) m[e] = (s + e <= l) ? at[j][e] : 0.f;
          lds_store_bf16x4(ATm + (l * LDV + s) * 2, m); }
      }
      const int KI = wid & 3, VJ = wid >> 2;
      f32x4 SN[2][2];
#pragma unroll
      for (int i = 0; i < 2; ++i) { const f32x4 dec = *(const LAS f32x4*)(Gm + 63 * 128 + 16 * (2 * KI + i) + 4 * fq);
#pragma unroll
        for (int j = 0; j < 2; ++j) SN[i][j] = ST[i][j] * dec; }
      { bf16x8 af[2][2], bfm[2][2];
#pragma unroll
        for (int q = 0; q < 2; ++q)
#pragma unroll
          for (int i = 0; i < 2; ++i) { af[q][i] = frag_tr(KEm, LD, 16 * (2 * KI + i), 32 * q, lane); bfm[q][i] = frag_tr(Vm, LDV, 16 * (2 * VJ + i), 32 * q, lane); }
        PIN8(af[0][0], af[0][1], af[1][0], af[1][1], bfm[0][0], bfm[0][1], bfm[1][0], bfm[1][1]);
#pragma unroll
        for (int q = 0; q < 2; ++q)
#pragma unroll
          for (int i = 0; i < 2; ++i)
#pragma unroll
            for (int j = 0; j < 2; ++j) SN[i][j] = mfma16(af[q][i], bfm[q][j], SN[i][j]); }
#pragma unroll
      for (int i = 0; i < 2; ++i)
#pragma unroll
        for (int j = 0; j < 2; ++j) ST[i][j] = SN[i][j];
      blk_sync();
      if (lat) { const int VI = wid & 3; f32x4 o[2] = {(f32x4){0.f, 0.f, 0.f, 0.f}, (f32x4){0.f, 0.f, 0.f, 0.f}};
        for (int q = 0; q <= TJ; ++q) { const bf16x8 af = frag_tr(Vm, LDV, 16 * VI, 32 * q, lane);
#pragma unroll
          for (int j = 0; j < 2; ++j) o[j] = mfma16(af, frag_row(ATm, LDV, 16 * (2 * TJ + j), 32 * q, lane), o[j]); }
        { bf16x8 af[4], b0[4], b1[4];
#pragma unroll
          for (int q = 0; q < 4; ++q) { af[q] = frag_row(Sb, LD, 16 * VI, 32 * q, lane); b0[q] = frag_row(QGm, LD, 16 * (2 * TJ), 32 * q, lane); b1[q] = frag_row(QGm, LD, 16 * (2 * TJ + 1), 32 * q, lane); }
          PIN12(af[0], af[1], af[2], af[3], b0[0], b0[1], b0[2], b0[3], b1[0], b1[1], b1[2], b1[3]);
#pragma unroll
          for (int q = 0; q < 4; ++q) { o[0] = mfma16(af[q], b0[q], o[0]); o[1] = mfma16(af[q], b1[q], o[1]); } }
#pragma unroll
        for (int j = 0; j < 2; ++j) { const int l = 16 * (2 * TJ + j) + fr; u32x2 w; w.x = pk2(o[j][0], o[j][1]); w.y = pk2(o[j][2], o[j][3]);
          *(u32x2*)(Od + (size_t)hg_row(b, d, c * 64 + l) * 1024 + h * 128 + vh * 64 + 16 * VI + 4 * fq) = w; }
      }
      blk_sync();
#pragma unroll
      for (int i = 0; i < 2; ++i)
#pragma unroll
        for (int j = 0; j < 2; ++j) lds_store_bf16x4(Sb + ((16 * (2 * VJ + j) + fr) * LD + 16 * (2 * KI + i) + 4 * fq) * 2, ST[i][j]);
    }
  }
}


constexpr int MODL_SC = 0, MODL_PART = (NB + 1) * DM * 4;
static_assert(MODL_PART + 32 * (NB + 1) * 48 * 4 <= LDS_BYTES, "mod LDS map");
DEV void ph_mod2(const P& p, LAS unsigned char* lds, int bid, int G) {
  const int t = tidx();
  LAS float* SC = (LAS float*)(lds + MODL_SC); LAS float* PART = (LAS float*)(lds + MODL_PART);
  if (bid == 0 && t < 64) ((int*)(p.ws + WS_CTL))[t] = 0;
  if (bid == 0) for (int i = t; i < 1024; i += NT) ((float*)(p.ws + WS_LB))[i] = fdiv(1.f, 1.f + fexp(p.in[I_HGLB][i] - p.in[I_HGLB][1024 + i]));
  for (int i = t; i < (NB + 1) * DM; i += NT) { const int r = i / DM, k = i % DM; SC[i] = siluf_(r < NB ? p.in[I_C][r * DM + k] : p.in[I_CCTX][k]); }
  blk_sync();
  for (int cg = bid; cg < 2 * 6144 / 48; cg += G) {
    const int l = cg / 128, col0 = (cg % 128) * 48;
    if (t < 384) { const int c4 = t % 12, ks = t / 12; const float* W = p.in[I_MODW] + (size_t)l * DM * 6144 + col0 + 4 * c4;
      f32x4 acc[NB + 1];
#pragma unroll
      for (int r = 0; r <= NB; ++r) acc[r] = (f32x4){0.f, 0.f, 0.f, 0.f};
#pragma unroll
      for (int k8 = 0; k8 < 32; k8 += 16) { f32x4 w[16];
#pragma unroll
        for (int kk = 0; kk < 16; ++kk) w[kk] = NT_LOAD4(W + (size_t)(ks * 32 + k8 + kk) * 6144);
#pragma unroll
        for (int kk = 0; kk < 16; ++kk) { const int k = ks * 32 + k8 + kk;
#pragma unroll
          for (int r = 0; r <= NB; ++r) acc[r] += w[kk] * SC[r * DM + k]; } }
#pragma unroll
      for (int r = 0; r <= NB; ++r) *(LAS f32x4*)(PART + (ks * (NB + 1) + r) * 48 + 4 * c4) = acc[r];
    }
    blk_sync();
    if (t < (NB + 1) * 48) { const int r = t / 48, c = t % 48; float s = 0.f;
#pragma unroll 8
      for (int ks = 0; ks < 32; ++ks) s += PART[(ks * (NB + 1) + r) * 48 + c];
      ((float*)(p.ws + WS_MODV))[(size_t)(l * (NB + 1) + r) * 6144 + col0 + c] = s + p.in[I_MODB][l * 6144 + col0 + c]; }
    blk_sync();
  }
}

constexpr int CVT_LDT = 72;
template <class Src> DEV void cvt_tiles(LAS unsigned char* lds, bf16_t* Bt, int N, int K, int ldw, const Src& src, int first, int step) {
  const int t = tidx(), lane = t & 63, wid = t >> 6; const int ntn = N / 64, ntk = K / 256;
  for (int tile = first; tile < ntn * ntk; tile += step) {
    const int n0 = (tile % ntn) * 64, k0 = (tile / ntn) * 256;
    f32x4 v[8];
#pragma unroll
    for (int i = 0; i < 8; ++i) { const int kk = (t >> 4) + 32 * i, n4 = (t & 15) * 4; const float* s = src(n0 + n4);
      v[i] = (f32x4){0.f, 0.f, 0.f, 0.f}; if (s) v[i] = NT_LOAD4(s + (size_t)(k0 + kk) * ldw); }
#pragma unroll
    for (int i = 0; i < 8; ++i) { const int kk = (t >> 4) + 32 * i, n4 = (t & 15) * 4; u32x2 o; o.x = pk2(v[i][0], v[i][1]); o.y = pk2(v[i][2], v[i][3]); *(LAS u32x2*)(lds + (kk * CVT_LDT + n4) * 2) = o; }
    blk_sync();
#pragma unroll
    for (int g = 0; g < 4; ++g) { const bf16x8 f = frag_tr(lds, CVT_LDT, 16 * g, 32 * wid, lane);
      *(bf16x8*)(Bt + (size_t)(n0 + 16 * g + (lane & 15)) * K + k0 + 32 * wid + 8 * (lane >> 4)) = f; }
    blk_sync();
  }
}
template <class Src> DEV void cvt_tiles_fp8(LAS unsigned char* lds, unsigned char* Bt, int N, int K, int ldw, const Src& src, int first, int step) {
  const int t = tidx(), lane = t & 63, wid = t >> 6; const int ntn = N / 64, ntk = K / 256; const float sc = (float)(1 << FP8_WSCALE_LOG2);
  for (int tile = first; tile < ntn * ntk; tile += step) {
    const int n0 = (tile % ntn) * 64, k0 = (tile / ntn) * 256;
    f32x4 va[4], vb[4];
#pragma unroll
    for (int i = 0; i < 4; ++i) { const int q = (t >> 4) + 32 * i, n4 = (t & 15) * 4; const float* s = src(n0 + n4);
      va[i] = NT_LOAD4(s + (size_t)(k0 + 2 * q) * ldw); vb[i] = NT_LOAD4(s + (size_t)(k0 + 2 * q + 1) * ldw); }
#pragma unroll
    for (int i = 0; i < 4; ++i) { const int q = (t >> 4) + 32 * i, n4 = (t & 15) * 4; const f32x4 a = va[i] * sc, b = vb[i] * sc; u32x2 o;
      o.x = pk4_fp8(a[0], b[0], a[1], b[1]); o.y = pk4_fp8(a[2], b[2], a[3], b[3]); *(LAS u32x2*)(lds + (q * CVT_LDT + n4) * 2) = o; }
    blk_sync();
#pragma unroll
    for (int gg = 0; gg < 2; ++gg) { const int g = 2 * (wid >> 2) + gg; const bf16x8 f = frag_tr(lds, CVT_LDT, 16 * g, 32 * (wid & 3), lane);
      *(bf16x8*)(Bt + (size_t)(n0 + 16 * g + (lane & 15)) * K + k0 + 64 * (wid & 3) + 16 * (lane >> 4)) = f; }
    blk_sync();
  }
}
DEV void ph_convert_dense2(const P& p, LAS unsigned char* lds, int bid, int G) {
  constexpr int T0 = (N0P / 64) * (1024 / 256);
  const int f0 = bid, f1 = ((bid - T0) % G + G) % G;
  cvt_tiles(lds, (bf16_t*)(p.ws + WS_WIN0), N0P, 1024, AB_IN, SrcWin0{p.in[I_ABIN]}, f0, G);
  if constexpr (FP8_OUT0) cvt_tiles_fp8(lds, (unsigned char*)(p.ws + WS_WOUT0), 1024, 2048, 1024, SrcId{p.in[I_ABOUT]}, f1, G);
  else cvt_tiles(lds, (bf16_t*)(p.ws + WS_WOUT0), 1024, 2048, 1024, SrcId{p.in[I_ABOUT]}, f1, G);
}
DEV void cvt_dense_l1_rank(const P& p, LAS unsigned char* lds, int rank, int nconv) {
  constexpr int T2a = (5120 - IN1_F8 * 256) / 64 * 4, T2b = IN1_F8 * 256 / 64 * 4;
  const int f2 = rank, f2b = ((rank - T2a) % nconv + nconv) % nconv, f3 = ((rank - T2a - T2b) % nconv + nconv) % nconv;
  cvt_tiles(lds, (bf16_t*)(p.ws + WS_WHGI) + (size_t)IN1_F8 * 256 * 1024, 5120 - IN1_F8 * 256, 1024, HG_IN, SrcId{p.in[I_HGIN] + IN1_F8 * 256}, f2, nconv);
  if constexpr (IN1_F8 > 0) cvt_tiles_fp8(lds, (unsigned char*)(p.ws + WS_WHGI), IN1_F8 * 256, 1024, HG_IN, SrcId{p.in[I_HGIN]}, f2b, nconv);
  if constexpr (FP8_OUT1) cvt_tiles_fp8(lds, (unsigned char*)(p.ws + WS_WHGO), 1024, 1024, 1024, SrcId{p.in[I_HGOUT]}, f3, nconv);
  else cvt_tiles(lds, (bf16_t*)(p.ws + WS_WHGO), 1024, 1024, 1024, SrcId{p.in[I_HGOUT]}, f3, nconv);
}
DEV void ph_convert_dense_l1(const P& p, int l, LAS unsigned char* lds, int bid, int G) {
  const int* CNT = (const int*)(p.ws + WS_CTL) + l * NE; int n1 = 0;
  for (int q = 0; q < NE; ++q) n1 += 4 * ((CNT[q] + 255) >> 8);
  const int r = n1 % G;
  if (2 * r >= G) { cvt_dense_l1_rank(p, lds, bid, G); return; }
  const int nl = G - 2 * r, nconv = 2 * nl + r;
  if (bid >= 2 * r) { cvt_dense_l1_rank(p, lds, 2 * (bid - 2 * r), nconv); cvt_dense_l1_rank(p, lds, 2 * (bid - 2 * r) + 1, nconv); }
  else if (bid >= r) cvt_dense_l1_rank(p, lds, 2 * nl + (bid - r), nconv);
}
DEV void ph_convert_moe2(const P& p, int l, LAS unsigned char* lds, int rank, int nconv, int e0 = 0, int e1 = NE) {
  if (rank < 0) return;
  for (int e = e0; e < e1; ++e) { const size_t eo = (size_t)(l * NE + e); const int first = (rank + nconv - (e * 16) % nconv) % nconv;
    cvt_tiles_fp8(lds, (unsigned char*)(p.ws + ws_wgu(l)) + (size_t)e * 1024 * 1024, 1024, 1024, DE, SrcGU{p.in[I_WG] + eo * DM * DE, p.in[I_WU] + eo * DM * DE}, first, nconv);
    cvt_tiles_fp8(lds, (unsigned char*)(p.ws + ws_wdt(l)) + (size_t)e * 1024 * 512, 1024, 512, DM, SrcId{p.in[I_WD] + eo * DE * DM}, (first + 64) % nconv, nconv); }
}

template <int LWX> DEV float wsumT(float v) { if constexpr (LWX == 1) return v; else return bwsum(v); }
DEV float reduce16_scatter(const float (&v)[16], int lane) {
  float a[8], b[4], c[2];
  { const bool hi = (lane & 32) != 0;
#pragma unroll
    for (int j = 0; j < 8; ++j) { const float mine = hi ? v[8 + j] : v[j], other = hi ? v[j] : v[8 + j]; a[j] = mine + wshfl(other, lane ^ 32); } }
  { const bool hi = (lane & 16) != 0;
#pragma unroll
    for (int j = 0; j < 4; ++j) { const float mine = hi ? a[4 + j] : a[j], other = hi ? a[j] : a[4 + j]; b[j] = mine + wshfl(other, lane ^ 16); } }
  { const bool hi = (lane & 8) != 0;
#pragma unroll
    for (int j = 0; j < 2; ++j) { const float mine = hi ? b[2 + j] : b[j], other = hi ? b[j] : b[2 + j]; c[j] = mine + wshfl(other, lane ^ 8); } }
  float d;
  { const bool hi = (lane & 4) != 0; const float mine = hi ? c[1] : c[0], other = hi ? c[0] : c[1]; d = mine + wshfl(other, lane ^ 4); }
  d += wshfl(d, lane ^ 2); d += wshfl(d, lane ^ 1);
  return d;
}
constexpr int RT_OFF_RW = 0, RT_OFF_LG = 16 * 1024 * 4, RT_OFF_LE = RT_OFF_LG + 8 * 2 * 16 * 4;
template <int LWX> DEV void norm_tokens(const P& p, int l, int mb, bool from_input, int comb, bool route, int r_begin, int r_end, int wave, int nwaves, int lane, LAS unsigned char* lds) {
  constexpr int NV = DM / 4 / LWX;
  bf16_t* H = (bf16_t*)p.out;
  const float* g = p.in[mb == 0 ? I_NMIXG : I_NFFNG] + l * DM;
  const bf16_t* YS = (const bf16_t*)(p.ws + WS_YS);
  f32x4 pa[NV], pb[NV], pg5[NV]; int cur_mr = -1;
  for (long r0 = r_begin + 2 * wave; r0 < r_end; r0 += 2 * nwaves) {
    f32x4 xv[2][NV]; float ss[2];
#pragma unroll
    for (int q = 0; q < 2; ++q) { const long r = r0 + q; const int mr = tok_modrow((int)r); const bf16_t* xc = xcur_row(p, (int)r); const float* x = xin_row(p, (int)r);
      if (mr != cur_mr) { cur_mr = mr; const float* sh = modv(p, l, mr, mb), *sc = modv(p, l, mr, mb + 1);
#pragma unroll
        for (int i = 0; i < NV; ++i) { const int k = 4 * (lane + LWX * i); pa[i] = *(const f32x4*)(g + k) * (*(const f32x4*)(sc + k) + 1.f); pb[i] = *(const f32x4*)(sh + k); pg5[i] = comb >= 0 ? *(const f32x4*)(modv(p, comb, mr, 5) + k) : (f32x4){0.f, 0.f, 0.f, 0.f}; } }
      ss[q] = 0.f;
#pragma unroll
      for (int i = 0; i < NV; ++i) { const int k = 4 * (lane + LWX * i); f32x4 v = from_input ? NT_LOAD4(x + k) : ld_bf4(xc + k);
        if (comb >= 0) { const u32x2 a = NT_LOADU2(YS + (size_t)(2 * r) * DM + k), b = NT_LOADU2(YS + (size_t)(2 * r + 1) * DM + k);
          v += pg5[i] * ((f32x4){bflo(a.x), bfhi(a.x), bflo(a.y), bfhi(a.y)} + (f32x4){bflo(b.x), bfhi(b.x), bflo(b.y), bfhi(b.y)}); }
        xv[q][i] = v; ss[q] += v[0] * v[0] + v[1] * v[1] + v[2] * v[2] + v[3] * v[3]; } }
    if (comb >= 0) {
#pragma unroll
      for (int q = 0; q < 2; ++q) { bf16_t* xc = xcur_row(p, (int)(r0 + q));
#pragma unroll
        for (int i = 0; i < NV; ++i) st_bf4(xc + 4 * (lane + LWX * i), xv[q][i]); } }
#pragma unroll
    for (int q = 0; q < 2; ++q) { const long r = r0 + q;
      const float rstd = frsqrt(wsumT<LWX>(ss[q]) / DM + EPS);
#pragma unroll
      for (int i = 0; i < NV; ++i) { const int k = 4 * (lane + LWX * i);
        const f32x4 h = xv[q][i] * rstd * pa[i] + pb[i];
        if (route) *(unsigned*)((unsigned char*)H + (size_t)r * DM + k) = pk4_fp8(h[0], h[1], h[2], h[3]);
        else { u32x2 o; o.x = pk2(h[0], h[1]); o.y = pk2(h[2], h[3]); *(u32x2*)(H + (size_t)r * DM + k) = o;
          if (IN1_F8 > 0 && l == 1) *(unsigned*)((unsigned char*)H + (size_t)TT * DM * 2 + (size_t)r * DM + k) = pk4_fp8(h[0], h[1], h[2], h[3]); }
        xv[q][i] = h; } }
    if constexpr (LWX == 64) if (route) {
      typedef float f32x2_ __attribute__((ext_vector_type(2)));
      f32x2_ lp[2][NE];
#pragma unroll
      for (int e = 0; e < NE; ++e) { lp[0][e] = (f32x2_){0.f, 0.f}; lp[1][e] = (f32x2_){0.f, 0.f}; }
      const LAS float* RWt = (const LAS float*)(lds + RT_OFF_RW);
#pragma unroll
      for (int i = 0; i < NV; ++i) { int k = 4 * (lane + LWX * i);
        const f32x2_ a0 = {xv[0][i][0], xv[0][i][1]}, a1 = {xv[0][i][2], xv[0][i][3]}, b0 = {xv[1][i][0], xv[1][i][1]}, b1 = {xv[1][i][2], xv[1][i][3]};
#pragma unroll
        for (int e = 0; e < NE; ++e) {
          const f32x4 w = *(const LAS f32x4*)(RWt + e * DM + k); const f32x2_ w0 = {w[0], w[1]}, w1 = {w[2], w[3]};
          lp[0][e] = a0 * w0 + lp[0][e]; lp[0][e] = a1 * w1 + lp[0][e]; lp[1][e] = b0 * w0 + lp[1][e]; lp[1][e] = b1 * w1 + lp[1][e];
          if ((e & 3) == 3) { OPAQUE_ACC8(k, lp[0][e - 3][0], lp[0][e - 3][1], lp[0][e - 2][0], lp[0][e - 2][1], lp[0][e - 1][0], lp[0][e - 1][1], lp[0][e][0], lp[0][e][1]);
            OPAQUE_ACC8(k, lp[1][e - 3][0], lp[1][e - 3][1], lp[1][e - 2][0], lp[1][e - 2][1], lp[1][e - 1][0], lp[1][e - 1][1], lp[1][e][0], lp[1][e][1]); } } }
      float lg[2][NE];
#pragma unroll
      for (int e = 0; e < NE; ++e) { lg[0][e] = lp[0][e][0] + lp[0][e][1]; lg[1][e] = lp[1][e][0] + lp[1][e][1]; }
      LAS float* LG = (LAS float*)(lds + RT_OFF_LG) + wave * 32;
#pragma unroll
      for (int q = 0; q < 2; ++q) { const float tot = reduce16_scatter(lg[q], lane); if ((lane & 3) == 0) LG[q * 16 + (lane >> 2)] = tot; }
      wave_sync();
      if (lane < 2) { const int q = lane; const long r = r0 + q; float s[NE], sel[NE];
#pragma unroll
        for (int e4 = 0; e4 < 4; ++e4) { const f32x4 v = *(const LAS f32x4*)(LG + q * 16 + 4 * e4);
#pragma unroll
          for (int j = 0; j < 4; ++j) { s[4 * e4 + j] = sigmoidf_(v[j]); sel[4 * e4 + j] = s[4 * e4 + j] + p.in[I_RB][4 * e4 + j]; } }
        int bg = 0; float bgs = -1e30f;
#pragma unroll
        for (int gq = 0; gq < 4; ++gq) {
          float m1 = -1e30f, m2 = -1e30f;
#pragma unroll
          for (int i = 0; i < 4; ++i) { const float v = sel[gq * 4 + i]; if (v > m1) { m2 = m1; m1 = v; } else if (v > m2) m2 = v; }
          const float gs = m1 + m2;
          if (gs > bgs) { bgs = gs; bg = gq; }
        }
        int i1 = 0, i2 = 0; float v1 = -1e30f, v2 = -1e30f; float s1 = 0.f, s2 = 0.f;
#pragma unroll
        for (int gq = 0; gq < 4; ++gq) if (gq == bg) {
#pragma unroll
          for (int i = 0; i < 4; ++i) { const float v = sel[gq * 4 + i]; if (v > v1) { v1 = v; i1 = i; s1 = s[gq * 4 + i]; } }
#pragma unroll
          for (int i = 0; i < 4; ++i) { const float v = sel[gq * 4 + i]; if (i != i1 && v > v2) { v2 = v; i2 = i; s2 = s[gq * 4 + i]; } }
        }
        int* EI = (int*)(p.ws + WS_EIDX); float* EW = (float*)(p.ws + WS_EW); LAS int* LE = (LAS int*)(lds + RT_OFF_LE);
        const int e1 = bg * 4 + i1, e2 = bg * 4 + i2;
        EI[r * 2] = e1; EI[r * 2 + 1] = e2;
        const float inv = fdiv(1.f, s1 + s2);
        EW[r * 2] = s1 * inv; EW[r * 2 + 1] = s2 * inv;
        LE[2 * (r - r_begin)] = e1; LE[2 * (r - r_begin) + 1] = e2; LAS float* LWt = (LAS float*)(LE + 256); LWt[2 * (r - r_begin)] = s1 * inv; LWt[2 * (r - r_begin) + 1] = s2 * inv;
      }
      wave_sync();
    }
  }
}
HD void ph_norm2(const P& p, int l, int mb, bool from_input, int ntok, int comb, long tid, long nth) {
  const int nblk = (int)(nth / NT), blk = (int)(tid / NT), wpb = NT / LW, tpb = ((ntok + nblk - 1) / nblk + 1) & ~1, rb = blk * tpb, re = rb + tpb < ntok ? rb + tpb : ntok;
  if (rb < re) norm_tokens<LW>(p, l, mb, from_input, comb, false, rb, re, (int)((tid % NT) / LW), wpb, LANE, nullptr);
}
DEV void ph_norm_route(const P& p, int l, int ntok, LAS unsigned char* lds, int bid, int G) {
  const int t = tidx(); LAS int* LE = (LAS int*)(lds + RT_OFF_LE);
  const int tpb = ((ntok + G - 1) / G + 1) & ~1, rb = bid * tpb, re = rb + tpb < ntok ? rb + tpb : ntok;
  { LAS float* RWt = (LAS float*)(lds + RT_OFF_RW); f32x4 rw[2][4];
#pragma unroll
    for (int i = 0; i < 2; ++i)
#pragma unroll
      for (int q = 0; q < 4; ++q) rw[i][q] = *(const f32x4*)(p.in[I_RW] + (size_t)(t + NT * i) * NE + 4 * q);
#pragma unroll
    for (int i = 0; i < 2; ++i)
#pragma unroll
      for (int q = 0; q < 4; ++q)
#pragma unroll
        for (int e = 0; e < 4; ++e) RWt[(4 * q + e) * DM + t + NT * i] = rw[i][q][e]; }
  blk_sync();
  if (rb < re) norm_tokens<64>(p, l, 3, false, -1, true, rb, re, t >> 6, NT / 64, t & 63, lds);
  blk_sync();
  { LAS int* WC = (LAS int*)(lds + RT_OFF_LG);
    const LAS float* LWt = (const LAS float*)(LE + 256); const int ns = 2 * (re - rb), wv = t >> 6, ln = t & 63;
    const int e = (rb < re && t < ns) ? LE[t] : -1; int rank = 0;
#pragma unroll
    for (int q = 0; q < NE; ++q) { const unsigned long long m = wballot(e == q); if (e == q) rank = __builtin_popcountll(m & ((1ull << ln) - 1ull)); if (ln == 0) WC[wv * NE + q] = __builtin_popcountll(m); }
    blk_sync();
    if (t < NE) { int tot = 0;
#pragma unroll
      for (int w = 0; w < NT / 64; ++w) tot += WC[w * NE + t];
      WC[128 + t] = tot > 0 ? atomicAdd((int*)(p.ws + WS_CTL) + l * NE + t, tot) : 0; }
    blk_sync();
    if (e >= 0) { int pos = WC[128 + e] + rank; for (int w = 0; w < wv; ++w) pos += WC[w * NE + e];
      ((int*)(p.ws + WS_RSLOT))[(size_t)e * MOE_CAP + pos] = 2 * rb + t; ((float*)(p.ws + WS_RW))[(size_t)e * MOE_CAP + pos] = LWt[t]; } }
  blk_sync();
}

HD u32x2 conv5_ld(const bf16_t* XR, int r, int c) { r = r < 0 ? 0 : (r >= TT ? TT - 1 : r); return *(const u32x2*)(XR + (size_t)r * 2048 + c); }
HD void ph_conv5b(const P& p, long tid, long nth) {
  const bf16_t* XR = (const bf16_t*)(p.ws + WS_XR); bf16_t* XBC = (bf16_t*)(p.ws + WS_XBC);
  const int nblk = (int)(nth / NT), blk = (int)(tid / NT), c = (int)(tid % NT) * 4;
  const int gpb = (TT / 8 + nblk - 1) / nblk, g0 = blk * gpb, g1 = g0 + gpb < TT / 8 ? g0 + gpb : TT / 8;
  if (g0 >= g1) return;
  f32x4 w[5];
#pragma unroll
  for (int k = 0; k < 5; ++k) w[k] = *(const f32x4*)(p.in[I_SCW] + k * 2048 + c);
  const f32x4 bias = *(const f32x4*)(p.in[I_SCB] + c);
  u32x2 raw[12];
#pragma unroll
  for (int k = 0; k < 12; ++k) raw[k] = conv5_ld(XR, g0 * 8 + k - 2, c);
  for (int g = g0; g < g1; ++g) {
    const int r0 = g * 8; int t0, L; tok_pos(r0, t0, L);
    u32x2 nxt[8];
#pragma unroll
    for (int k = 0; k < 8; ++k) nxt[k] = conv5_ld(XR, r0 + 10 + k, c);
    f32x4 win[12];
#pragma unroll
    for (int k = 0; k < 12; ++k) { const int tt = t0 + k - 2; const bool ok = tt >= 0 && tt < L; const unsigned x = ok ? raw[k].x : 0u, y = ok ? raw[k].y : 0u; win[k] = (f32x4){bflo(x), bfhi(x), bflo(y), bfhi(y)}; }
#pragma unroll
    for (int j = 0; j < 8; ++j) { f32x4 a = bias;
#pragma unroll
      for (int k = 0; k < 5; ++k) a += win[j + k] * w[k];
      st_bf4(XBC + (size_t)(r0 + j) * 2048 + c, silu4(a)); }
#pragma unroll
    for (int k = 0; k < 4; ++k) raw[k] = raw[8 + k];
#pragma unroll
    for (int k = 0; k < 8; ++k) raw[4 + k] = nxt[k];
  }
}

constexpr int CF_TILES = TL / 64 + TC / 8;
template <int NOUT> DEV void cf_tile(const P& p, LAS unsigned char* lds, int row0, int wlo, int whi) {
  constexpr int NLD = (NOUT + 30 + 7) / 8 < 8 ? (NOUT + 30 + 7) / 8 : 8, NW = NOUT / 2 + 16, UU = NOUT >= 16 ? 2 : 1;
  const int t = tidx(), lane = t & 63, grp = t >> 6;
  const bf16_t* U = (const bf16_t*)(p.ws + WS_U); bf16_t* OC = (bf16_t*)p.out;
  {
    const int nw = whi - wlo;
    { u32x4 xr[2 * NLD];
#pragma unroll
      for (int i = 0; i < 2 * NLD; ++i) { int v = t + NT * (i % NLD); const int sl = i / NLD; v = v < nw * 64 ? v : nw * 64 - 1; xr[i] = NT_LOADU4(U + (size_t)(wlo + (v >> 6)) * 1024 + sl * 512 + (v & 63) * 8); }
#pragma unroll
      for (int i = 0; i < 2 * NLD; ++i) { const int v = t + NT * (i % NLD), sl = i / NLD; if (v < nw * 64) *(LAS u32x4*)(lds + sl * 65536 + (v >> 6) * 1024 + (v & 63) * 16) = xr[i]; } }
    blk_sync();
#pragma unroll
    for (int sl = 0; sl < 2; ++sl) {
      const int ch = sl * 512 + t; LAS unsigned char* slab = lds + sl * 65536;
      unsigned WE[16], WO[16];
      { float w[32];
#pragma unroll
        for (int j = 0; j < 31; ++j) w[j] = p.in[I_CFW][j * 1024 + ch];
        w[31] = 0.f;
#pragma unroll
        for (int q = 0; q < 16; ++q) { WE[q] = pk2(q ? w[2 * q - 1] : 0.f, w[2 * q]); WO[q] = pk2(w[2 * q], w[2 * q + 1]); } }
      unsigned X[NW];
#pragma unroll
      for (int w = 0; w < NW; ++w) { const int r0_ = row0 + 2 * w - 16, r1_ = r0_ + 1; const bool ok0 = r0_ >= wlo && r0_ < whi, ok1 = r1_ >= wlo && r1_ < whi;
        const int c0 = r0_ < wlo ? wlo : (r0_ >= whi ? whi - 1 : r0_), c1 = r1_ < wlo ? wlo : (r1_ >= whi ? whi - 1 : r1_);
        const unsigned lo = *(const LAS bf16_t*)(slab + (c0 - wlo) * 1024 + t * 2), hi = *(const LAS bf16_t*)(slab + (c1 - wlo) * 1024 + t * 2);
        X[w] = (ok0 ? lo : 0u) | ((ok1 ? hi : 0u) << 16); }
      blk_sync();
      const float cb = p.in[I_CFB][ch];
#pragma unroll
      for (int l = 0; l < NOUT; l += 2) {
        float ae = cb, ao = cb;
#pragma unroll
        for (int q = 0; q < 16; ++q) { ae = dot2bf(X[l / 2 + q], WE[q], ae); ao = dot2bf(X[l / 2 + 1 + q], WO[q], ao); }
        const unsigned pr = pk2(ae, ao);
        *(LAS bf16_t*)(slab + l * 1024 + t * 2) = (bf16_t)(pr & 0xffffu); *(LAS bf16_t*)(slab + (l + 1) * 1024 + t * 2) = (bf16_t)(pr >> 16);
      }
    }
    blk_sync();
    {
      for (int i0 = 0; i0 < NOUT / 8; i0 += 2) {
        f32x4 a[2][4], g4[4], b4[4]; float s[2], q[2]; int lc = lane * 8; OPAQUE_INT(lc);
#pragma unroll
        for (int k = 0; k < 4; ++k) { const int c = (k >> 1) * 512 + lc + (k & 1) * 4; g4[k] = *(const f32x4*)(p.in[I_CFLG] + c); b4[k] = *(const f32x4*)(p.in[I_CFLB] + c); }
#pragma unroll
        for (int u = 0; u < UU; ++u) { const int l = grp + 8 * (i0 + u);
          const u32x4 v0 = *(const LAS u32x4*)(lds + l * 1024 + lane * 16), v1 = *(const LAS u32x4*)(lds + 65536 + l * 1024 + lane * 16);
          a[u][0] = bf4lo(v0); a[u][1] = bf4hi(v0); a[u][2] = bf4lo(v1); a[u][3] = bf4hi(v1); s[u] = 0.f;
#pragma unroll
          for (int k = 0; k < 4; ++k) s[u] += (a[u][k][0] + a[u][k][1]) + (a[u][k][2] + a[u][k][3]); }
#pragma unroll
        for (int u = 0; u < UU; ++u) s[u] = bwsum(s[u]) * (1.f / 1024.f);
#pragma unroll
        for (int u = 0; u < UU; ++u) { q[u] = 0.f;
#pragma unroll
          for (int k = 0; k < 4; ++k) { a[u][k] -= s[u]; q[u] += (a[u][k][0] * a[u][k][0] + a[u][k][1] * a[u][k][1]) + (a[u][k][2] * a[u][k][2] + a[u][k][3] * a[u][k][3]); } }
#pragma unroll
        for (int u = 0; u < UU; ++u) q[u] = frsqrt(bwsum(q[u]) * (1.f / 1024.f) + EPS);
#pragma unroll
        for (int u = 0; u < UU; ++u) { const int l = grp + 8 * (i0 + u);
#pragma unroll
          for (int sl = 0; sl < 2; ++sl) store_act8<FP8_OUT0>(OC, (size_t)(row0 + l) * 2048 + 1024 + sl * 512 + lane * 8, silu4(a[u][2 * sl] * q[u] * g4[2 * sl] + b4[2 * sl]), silu4(a[u][2 * sl + 1] * q[u] * g4[2 * sl + 1] + b4[2 * sl + 1])); }
      } }
    blk_sync();
  }
}
DEV void ph_cf_fused(const P& p, LAS unsigned char* lds, int bid, int G) {
  for (int tile = bid; tile < CF_TILES; tile += G) {
    if (tile < TL / 64) cf_tile<64>(p, lds, tile * 64, tile * 64, tile * 64 + 64);
    else { const int q = tile - TL / 64, row0 = TL + q * 8, seg0 = TL + (q * 8 / CTX) * CTX; cf_tile<8>(p, lds, row0, row0 - 15 < seg0 ? seg0 : row0 - 15, row0 + 8 + 15 > seg0 + CTX ? seg0 + CTX : row0 + 8 + 15); }
  }
}

HD void ph_ssd_readout3(const P& p, long tid, long nth) {
  constexpr int NV = 1024 / 8 / LW;
  const bf16_t* Y0 = (const bf16_t*)(p.ws + WS_Y); const bf16_t* Y1 = Y0 + (size_t)TT * 1024; const bf16_t* Z = (const bf16_t*)(p.ws + WS_Z); bf16_t* OC = (bf16_t*)p.out;
  const int lane = LANE;
  f32x4 gn0[NV], gn1[NV];
#pragma unroll
  for (int i = 0; i < NV; ++i) { const int k = 8 * (lane + LW * i); gn0[i] = *(const f32x4*)(p.in[I_SSDG] + k); gn1[i] = *(const f32x4*)(p.in[I_SSDG] + k + 4); }
  for (long r = tid / LW; r < TT; r += nth / LW) {
    f32x4 v0[NV], v1[NV]; float ss = 0.f;
#pragma unroll
    for (int i = 0; i < NV; ++i) { const size_t o = (size_t)r * 1024 + 8 * (lane + LW * i); const u32x4 a = NT_LOADU4(Y0 + o), b = NT_LOADU4(Y1 + o), z = NT_LOADU4(Z + o);
      v0[i] = (bf4lo(a) + bf4lo(b)) * silu4(bf4lo(z)); v1[i] = (bf4hi(a) + bf4hi(b)) * silu4(bf4hi(z));
      ss += (v0[i][0] * v0[i][0] + v0[i][1] * v0[i][1]) + (v0[i][2] * v0[i][2] + v0[i][3] * v0[i][3]) + (v1[i][0] * v1[i][0] + v1[i][1] * v1[i][1]) + (v1[i][2] * v1[i][2] + v1[i][3] * v1[i][3]); }
    const float rstd = frsqrt(wsum(ss) / 1024.f + EPS);
#pragma unroll
    for (int i = 0; i < NV; ++i) { const int k = 8 * (lane + LW * i); store_act8<FP8_OUT0>(OC, (size_t)r * 2048 + k, v0[i] * rstd * gn0[i], v1[i] * rstd * gn1[i]); }
  }
}
HD void ph_hg_readout3(const P& p, long tid, long nth) {
  constexpr int GL = LW >= 16 ? 16 : 1;
  constexpr int NV = 16 / GL;
  const bf16_t* O0 = (const bf16_t*)(p.ws + WS_O); const bf16_t* O1 = O0 + (size_t)TL * 1024; const bf16_t* P1 = (const bf16_t*)(p.ws + WS_P1); bf16_t* RO = (bf16_t*)p.out;
  const int sub = (int)(tid % GL);
  f32x4 hn0[NV], hn1[NV];
#pragma unroll
  for (int i = 0; i < NV; ++i) { const int vv = 8 * (sub + GL * i); hn0[i] = *(const f32x4*)(p.in[I_HGNG] + vv); hn1[i] = *(const f32x4*)(p.in[I_HGNG] + vv + 4); }
  const long step = nth / GL;
  for (long it0 = tid / GL; it0 < (long)TL * 8; it0 += 2 * step) {
    u32x4 ga[2][NV], gb[2][NV], gg[2][NV];
#pragma unroll
    for (int u = 0; u < 2; ++u) { const long it = it0 + u * step < (long)TL * 8 ? it0 + u * step : it0; const size_t base = (size_t)(it >> 3) * 1024 + (it & 7) * 128;
#pragma unroll
      for (int i = 0; i < NV; ++i) { const int vv = 8 * (sub + GL * i); ga[u][i] = NT_LOADU4(O0 + base + vv); gb[u][i] = NT_LOADU4(O1 + base + vv);
        gg[u][i] = *(const u32x4*)(P1 + (size_t)(it >> 3) * 5120 + 1024 + (it & 7) * 128 + vv); } }
#pragma unroll
    for (int u = 0; u < 2; ++u) { const long it = it0 + u * step; if (it >= (long)TL * 8) break; const size_t base = (size_t)(it >> 3) * 1024 + (it & 7) * 128;
      f32x4 v0[NV], v1[NV]; float ss = 0.f;
#pragma unroll
      for (int i = 0; i < NV; ++i) { v0[i] = bf4lo(ga[u][i]) + bf4lo(gb[u][i]); v1[i] = bf4hi(ga[u][i]) + bf4hi(gb[u][i]);
        ss += (v0[i][0] * v0[i][0] + v0[i][1] * v0[i][1]) + (v0[i][2] * v0[i][2] + v0[i][3] * v0[i][3]) + (v1[i][0] * v1[i][0] + v1[i][1] * v1[i][1]) + (v1[i][2] * v1[i][2] + v1[i][3] * v1[i][3]); }
      ss = gsum16(ss);
      const float rstd = frsqrt(ss / 128.f + EPS);
#pragma unroll
      for (int i = 0; i < NV; ++i) { const int vv = 8 * (sub + GL * i);
        store_act8<FP8_OUT1>(RO, base + vv, v0[i] * rstd * hn0[i] * silu4(bf4lo(gg[u][i])), v1[i] * rstd * hn1[i] * silu4(bf4hi(gg[u][i]))); } }
  }
}
HD void ph_final2(const P& p, long tid, long nth) {
  constexpr int NV = DM / 4 / LW;
  const bf16_t* YS = (const bf16_t*)(p.ws + ws_ys(1)); const int lane = LANE;
  f32x4 fg[NV];
#pragma unroll
  for (int i = 0; i < NV; ++i) fg[i] = *(const f32x4*)(p.in[I_FNG] + 4 * (lane + LW * i));
  for (long r = tid / LW; r < TL; r += nth / LW) {
    float* x = p.out + (size_t)r * DM; const float* g5 = modv(p, 1, tok_modrow((int)r), 5); f32x4 xv[NV]; float ss = 0.f;
#pragma unroll
    for (int i = 0; i < NV; ++i) { const int k = 4 * (lane + LW * i); const u32x2 a = NT_LOADU2(YS + (size_t)(2 * r) * DM + k), b = NT_LOADU2(YS + (size_t)(2 * r + 1) * DM + k);
      const f32x4 v = ld_bf4(xcur_row(p, (int)r) + k) + *(const f32x4*)(g5 + k) * ((f32x4){bflo(a.x), bfhi(a.x), bflo(a.y), bfhi(a.y)} + (f32x4){bflo(b.x), bfhi(b.x), bflo(b.y), bfhi(b.y)});
      xv[i] = v; ss += v[0] * v[0] + v[1] * v[1] + v[2] * v[2] + v[3] * v[3]; }
    const float rstd = frsqrt(wsum(ss) / DM + EPS);
#pragma unroll
    for (int i = 0; i < NV; ++i) { const int k = 4 * (lane + LW * i); NT_STORE4(x + k, xv[i] * rstd * fg[i]); }
  }
}

#define OUTPROJ0_CVT_N(G) (((TT / 256) * 4 > (G) && (TT / 256) * 4 < 2 * (G)) ? 2 * (G) - (TT / 256) * 4 : (G))
#define OUTPROJ0_CVT_RANK(bid, G) (((TT / 256) * 4 > (G) && (TT / 256) * 4 < 2 * (G)) ? (bid) - ((TT / 256) * 4 - (G)) : (bid))
#define IN1_NB16 ((TL / 256) * (20 - IN1_F8) + (TC / 256) * (20 - (IN1_F8 > 8 ? IN1_F8 : 8)))
#define IN1_NF8 ((TL / 256) * IN1_F8 + (IN1_F8 > 8 ? (TC / 256) * (IN1_F8 - 8) : 0))
#define IN1_HEAVY(G) ((IN1_NB16 % (G)) + (IN1_NF8 % (G)) < (G) ? (IN1_NB16 % (G)) + (IN1_NF8 % (G)) : 0)
#define IN1_CVT_N(G) ((G) - IN1_HEAVY(G))
#define IN1_CVT_RANK(bid, G) ((bid) - IN1_HEAVY(G))
constexpr int IN1_CVT_E = 16;
#ifndef CPU_TEST
#define MOE_SEAM(SYNC)
#else
#define MOE_SEAM(SYNC) SYNC
#endif
#define PROGRAM(T, B, SYNC) \
  B(ph_mod2(p, LDSP, bid, G)) B(ph_convert_dense2(p, LDSP, bid, G)) SYNC \
  T(ph_norm2(p, 0, 0, true, TT, -1, tid, nth)) SYNC \
  B(ph_gemm_inproj0(p, lds, bid, G)) SYNC \
  B(if ((bid >> 3) & 1) { ph_cf_fused(p, LDSP, bid, G); ph_conv5b(p, (long)bid * NT + tidx(), (long)G * NT); } else { ph_conv5b(p, (long)bid * NT + tidx(), (long)G * NT); ph_cf_fused(p, LDSP, bid, G); }) SYNC \
  B(ph_ssd_chunked(p, LDSP, bid, G)) SYNC \
  T(ph_ssd_readout3(p, tid, nth)) SYNC \
  B(if (OUTPROJ0_CVT_RANK(bid, G) >= 0 && ((bid >> 3) & 1)) { ph_convert_moe2(p, 0, LDSP, OUTPROJ0_CVT_RANK(bid, G), OUTPROJ0_CVT_N(G)); ph_gemm_outproj0(p, lds, bid, G); } \
    else { ph_gemm_outproj0(p, lds, bid, G); ph_convert_moe2(p, 0, LDSP, OUTPROJ0_CVT_RANK(bid, G), OUTPROJ0_CVT_N(G)); }) SYNC \
  B(ph_norm_route(p, 0, TT, LDSP, bid, G)) SYNC \
  B(ph_gemm_moe1(p, 0, lds, bid, G)) MOE_SEAM(SYNC) \
  B(ph_gemm_moe2(p, 0, lds, bid, G)) B(ph_convert_dense_l1(p, 0, LDSP, bid, G)) SYNC \
  T(ph_norm2(p, 1, 0, false, TT, 0, tid, nth)) SYNC \
  B(if (IN1_CVT_RANK(bid, G) >= 0 && ((bid >> 3) & 1)) { ph_convert_moe2(p, 1, LDSP, IN1_CVT_RANK(bid, G), IN1_CVT_N(G), 0, IN1_CVT_E); ph_gemm_inproj1(p, lds, bid, G); } \
    else { ph_gemm_inproj1(p, lds, bid, G); ph_convert_moe2(p, 1, LDSP, IN1_CVT_RANK(bid, G), IN1_CVT_N(G), 0, IN1_CVT_E); }) SYNC \
  B(ph_hg_chunked(p, LDSP, bid, G)) SYNC \
  T(ph_hg_readout3(p, tid, nth)) SYNC \
  B(ph_gemm_outproj1(p, lds, bid, G)) SYNC \
  B(ph_norm_route(p, 1, TL, LDSP, bid, G)) B(ph_convert_moe2(p, 1, LDSP, bid, G, IN1_CVT_E, NE)) SYNC \
  B(ph_gemm_moe1(p, 1, lds, bid, G)) MOE_SEAM(SYNC) \
  B(ph_gemm_moe2(p, 1, lds, bid, G)) SYNC \
  T(ph_final2(p, tid, nth))

#ifndef CPU_TEST
#define XB_TMO      128
#define XB_XCNT(j)  (256  + 64 * (j))
#define XB_XSUB(j)  (1280 + 64 * (j))
#define XB_XGEN(j)  (2304 + 64 * (j))
#define XB_TOP      3328
#define XB_TOPGEN   3392
#define XCD_BAR_WORDS 3456
#define XB_SPIN_CAP (1u << 18)

__device__ __forceinline__ unsigned xb_ld(unsigned* p)              { return __hip_atomic_load(p, __ATOMIC_RELAXED, __HIP_MEMORY_SCOPE_AGENT); }
__device__ __forceinline__ unsigned xb_add(unsigned* p, unsigned v) { return __hip_atomic_fetch_add(p, v, __ATOMIC_RELAXED, __HIP_MEMORY_SCOPE_AGENT); }
__device__ __forceinline__ unsigned xb_xcc_id() { return (unsigned)__builtin_amdgcn_s_getreg((3 << 11) | 20) & 0xFu; }
#define XB_SPIN(cond, bar) do { unsigned _sp = 0; while (cond) { __builtin_amdgcn_s_sleep(1); \
    if ((++_sp & 255u) == 0u) { if (xb_ld(&(bar)[XB_TMO])) break; if (_sp > XB_SPIN_CAP) { atomicAdd(&(bar)[XB_TMO], 1u); break; } } } } while (0)

struct XcdBarrier {
    unsigned* bar; unsigned x;
    volatile LAS unsigned* st;
};

__device__ __forceinline__ XcdBarrier xcd_barrier_post(unsigned* bar, volatile LAS unsigned* st) {
    XcdBarrier b; b.bar = bar; b.x = xb_xcc_id(); b.st = st;
    if (threadIdx.x == 0) (void)xb_add(&bar[XB_XCNT(b.x)], 1u);
    return b;
}
__device__ __forceinline__ void xcd_barrier_complete(unsigned* bar, unsigned x, unsigned& nloc, unsigned& nx) {
    const unsigned G = gridDim.x * gridDim.y * gridDim.z;
    unsigned sum, cnt, mine, sp = 0u;
    for (;;) {
        sum = 0u; cnt = 0u; mine = 0u;
#pragma unroll
        for (unsigned j = 0; j < 16; ++j) { const unsigned c = xb_ld(&bar[XB_XCNT(j)]); sum += c; cnt += (c > 0u) ? 1u : 0u; mine = (j == x) ? c : mine; }
        if (sum == G) break;
        __builtin_amdgcn_s_sleep(1);
        if ((++sp & 255u) == 0u) { if (xb_ld(&bar[XB_TMO])) break; if (sp > XB_SPIN_CAP) { atomicAdd(&bar[XB_TMO], 1u); break; } }
    }
    nloc = mine > 0u ? mine : 1u; nx = cnt > 0u ? cnt : 1u;
}

__device__ __forceinline__ void xcd_barrier(const XcdBarrier& b) {
    asm volatile("s_waitcnt vmcnt(0)" ::: "memory");
    __syncthreads();
    if (threadIdx.x == 0) {
        unsigned* bar = b.bar;
        __builtin_amdgcn_s_waitcnt(0);
        unsigned nloc = b.st[0], nx = b.st[1];
        if (nloc == 0u) { xcd_barrier_complete(bar, b.x, nloc, nx); b.st[0] = nloc; b.st[1] = nx; }
        const unsigned old = xb_add(&bar[XB_XSUB(b.x)], 1u);
        const unsigned gen = old / nloc;
        if (old + 1u == (gen + 1u) * nloc) {
            __builtin_amdgcn_fence(__ATOMIC_RELEASE, "agent");
            asm volatile("s_waitcnt vmcnt(0)" ::: "memory");
            const unsigned og = xb_add(&bar[XB_TOP], 1u);
            const unsigned tg = og / nx;
            if (og + 1u == (tg + 1u) * nx) xb_add(&bar[XB_TOPGEN], 1u);
            else XB_SPIN(xb_ld(&bar[XB_TOPGEN]) == tg, bar);
            __builtin_amdgcn_fence(__ATOMIC_ACQUIRE, "agent");
            xb_add(&bar[XB_XGEN(b.x)], 1u);
            asm volatile("s_waitcnt vmcnt(0)" ::: "memory");
        } else {
            XB_SPIN(xb_ld(&bar[XB_XGEN(b.x)]) == gen, bar);
            __builtin_amdgcn_fence(__ATOMIC_ACQUIRE, "agent");
            asm volatile("s_waitcnt vmcnt(0)" ::: "memory");
        }
    }
    __syncthreads();
}

#endif

#ifndef CPU_TEST
__global__ void __launch_bounds__(NT) mega(P p) {
  extern __shared__ __attribute__((aligned(16))) unsigned char lds[];
  const long nth = (long)gridDim.x * NT;
  const int bid = blockIdx.x, G = gridDim.x;
#define LDSP ((LAS unsigned char*)lds)
#define T_(stmt_) { const long tid = (long)blockIdx.x * NT + tidx(); stmt_; }
#define B_(stmt_) stmt_;
  volatile LAS unsigned* xb_st = (volatile LAS unsigned*)(LDSP + LDS_BYTES - 64);
  if (threadIdx.x < 2) xb_st[threadIdx.x] = 0u;
  __syncthreads();
  const XcdBarrier xbar = xcd_barrier_post((unsigned*)(p.ws + WS_BAR), xb_st);
#define S_ xcd_barrier(xbar);
  PROGRAM(T_, B_, S_)
}

extern "C" void kernel_launch(void* const* d_in, const int* in_sizes, int n_in, void* d_out, int out_size,
                              void* d_ws, size_t ws_size, hipStream_t stream) {
  static int grid_blocks = 0;
  if (!grid_blocks) {
    int dev = 0, cus = 0, per_cu = 0;
    (void)hipGetDevice(&dev);
    (void)hipDeviceGetAttribute(&cus, hipDeviceAttributeMultiprocessorCount, dev);
    (void)hipFuncSetAttribute((const void*)mega, hipFuncAttributeMaxDynamicSharedMemorySize, LDS_BYTES);
    (void)hipOccupancyMaxActiveBlocksPerMultiprocessor(&per_cu, (const void*)mega, NT, LDS_BYTES);
    if (per_cu < 1) per_cu = 1;
    grid_blocks = cus * per_cu;
    if (n_in != N_IN || out_size != TL * DM || ws_size < WS_NEED) { fprintf(stderr, "kernel_launch: bad sizes n_in=%d out=%d ws=%zu need=%zu\n", n_in, out_size, ws_size, (size_t)WS_NEED); grid_blocks = -1; }
  }
  if (grid_blocks < 0) return;
  P p{};
  for (int i = 0; i < N_IN; ++i) p.in[i] = (const float*)d_in[i];
  p.out = (float*)d_out; p.ws = (unsigned char*)d_ws;
  (void)hipMemsetAsync((unsigned char*)d_ws + WS_BAR, 0, (size_t)XCD_BAR_WORDS * 4 + 2 * 160 * 4, stream);
  void* args[] = {&p};
  hipError_t e = hipLaunchCooperativeKernel((const void*)mega, dim3(grid_blocks), dim3(NT), args, LDS_BYTES, stream);
  if (e != hipSuccess) fprintf(stderr, "cooperative launch failed: %s (grid %d)\n", hipGetErrorString(e), grid_blocks);
}
#endif
```
